# Optimizing an MI355X kernel written in HIP

```python
import jax
import jax.numpy as jnp
from jax import lax
import numpy as np


D_MODEL = 1024
BATCH = 4
SEQ = 4096
DEPTH = 1

CHUNK = 64
Q_BLOCK = 128
HEAD_DIM = 64
N_HEADS_A = 8
N_HEADS_B = 8
N_IDX_HEADS = 8
IDX_DIM = 64
MAX_SELECTED_KEYS = 256
ROT_DIM = HEAD_DIM // 4
ROPE_THETA = 500000.0
N_EXPERTS = 32
TOP_K = 4
D_EXPERT = D_MODEL
SWIGLU_LIMIT = 7.0
SWIGLU_ALPHA = 1.702
EXPERT_BLOCK = 256
RMS_EPS = 1e-6
PROJ_WIDTHS = (N_HEADS_A * HEAD_DIM, HEAD_DIM, HEAD_DIM, N_IDX_HEADS * IDX_DIM, IDX_DIM, N_IDX_HEADS, N_HEADS_B * HEAD_DIM, N_HEADS_B * HEAD_DIM, N_HEADS_B * HEAD_DIM, D_MODEL, D_MODEL)
D_PROJ = sum(PROJ_WIDTHS)

kernel_name = 'hybrid_dsa_stickbreak_moe_block'


def split_points():
    pts, acc = [], 0
    for w in PROJ_WIDTHS[:-1]:
        acc += w
        pts.append(acc)
    return pts


def rms_norm(x, g):
    xf = x.astype(jnp.float32)
    y = xf * lax.rsqrt(jnp.mean(xf * xf, axis=-1, keepdims=True) + RMS_EPS)
    return (y * g.astype(jnp.float32)).astype(x.dtype)


def rope_tables(seq):
    pos = jnp.arange(seq, dtype=jnp.float32)
    inv_freq = ROPE_THETA ** (-jnp.arange(0, ROT_DIM, 2, dtype=jnp.float32) / ROT_DIM)
    ang = pos[:, None] * inv_freq[None, :]
    return jnp.cos(ang)[:, None, :], jnp.sin(ang)[:, None, :]


def partial_rope(x, cos, sin):
    half = ROT_DIM // 2
    x1 = x[..., :half].astype(jnp.float32)
    x2 = x[..., half:ROT_DIM].astype(jnp.float32)
    rot = jnp.concatenate([x1 * cos - x2 * sin, x2 * cos + x1 * sin], axis=-1).astype(x.dtype)
    return jnp.concatenate([rot, x[..., ROT_DIM:]], axis=-1)


def to_blocks(a):
    b, s = a.shape[:2]
    return jnp.moveaxis(a.reshape(b, s // Q_BLOCK, Q_BLOCK, *a.shape[2:]), 1, 0)


def from_blocks(a):
    nb, b, qb = a.shape[:3]
    return jnp.moveaxis(a, 0, 1).reshape(b, nb * qb, -1)


def dsa_attention(q, k, v, q_idx, k_idx, w_idx):
    s_len = q.shape[1]
    n_sel = min(MAX_SELECTED_KEYS, s_len // 4)
    key_pos = jnp.arange(s_len)

    def block(args):
        qb, qib, wb, bi = args
        t = bi * Q_BLOCK + jnp.arange(Q_BLOCK)
        limit = (t // CHUNK + 1) * CHUNK
        admissible = key_pos[None, :] < limit[:, None]
        rel = jax.nn.relu(jnp.einsum('bqhd,bsd->bqhs', qib, k_idx) * (IDX_DIM ** -0.5))
        score = jnp.einsum('bqhs,bqh->bqs', rel, wb).astype(jnp.float32)
        score = jnp.where(admissible[None], score, -jnp.inf)
        _, sel = lax.top_k(score, n_sel)
        valid = sel < limit[None, :, None]
        k_sel = jax.vmap(lambda kb, ib: kb[ib])(k, sel)
        v_sel = jax.vmap(lambda vb, ib: vb[ib])(v, sel)
        logits = jnp.einsum('bqhd,bqnd->bqhn', qb, k_sel).astype(jnp.float32) * (HEAD_DIM ** -0.5)
        logits = jnp.where(valid[:, :, None, :], logits, -jnp.inf)
        p = jax.nn.softmax(logits, axis=-1).astype(v.dtype)
        return jnp.einsum('bqhn,bqnd->bqhd', p, v_sel)

    nb = s_len // Q_BLOCK
    out = lax.map(block, (to_blocks(q), to_blocks(q_idx), to_blocks(w_idx), jnp.arange(nb)))
    return from_blocks(out)


def stick_breaking_attention(q, k, v):
    s_len = q.shape[1]
    key_pos = jnp.arange(s_len)

    def block(args):
        qb, bi = args
        t = bi * Q_BLOCK + jnp.arange(Q_BLOCK)
        causal = key_pos[None, :] < t[:, None]
        z = jnp.einsum('bqhd,bshd->bhqs', qb, k).astype(jnp.float32) * (HEAD_DIM ** -0.5)
        log_beta = jax.nn.log_sigmoid(z)
        log_keep = jnp.where(causal, jax.nn.log_sigmoid(-z), 0.0)
        later = lax.cumsum(log_keep, axis=3, reverse=True) - log_keep
        a = jnp.where(causal, jnp.exp(log_beta + later), 0.0).astype(v.dtype)
        return jnp.einsum('bhqs,bshd->bqhd', a, v)

    nb = s_len // Q_BLOCK
    out = lax.map(block, (to_blocks(q), jnp.arange(nb)))
    return from_blocks(out)


def hybrid_mixer(xn, w_in, q_norm_g, k_norm_g, w_proj_a, w_proj_b, w_out, cos, sin):
    b, s, _ = xn.shape
    proj = xn @ w_in
    qa, ka, va, qi, ki, wi, qb, kb, vb, ga, gb = jnp.split(proj, split_points(), axis=-1)
    qa = partial_rope(rms_norm(qa.reshape(b, s, N_HEADS_A, HEAD_DIM), q_norm_g), cos, sin)
    ka = partial_rope(rms_norm(ka.reshape(b, s, 1, HEAD_DIM), k_norm_g), cos, sin)[:, :, 0]
    qi = partial_rope(qi.reshape(b, s, N_IDX_HEADS, IDX_DIM), cos, sin)
    ki = partial_rope(ki.reshape(b, s, 1, IDX_DIM), cos, sin)[:, :, 0]
    wi = wi * (N_IDX_HEADS ** -0.5)
    oa = dsa_attention(qa, ka, va, qi, ki, wi)
    ob = stick_breaking_attention(qb.reshape(b, s, N_HEADS_B, HEAD_DIM), kb.reshape(b, s, N_HEADS_B, HEAD_DIM), vb.reshape(b, s, N_HEADS_B, HEAD_DIM))
    merged = jax.nn.sigmoid(ga) * (oa @ w_proj_a) + jax.nn.sigmoid(gb) * (ob @ w_proj_b)
    return merged @ w_out


def moe_ffn(xf, w_router, b_router, w_gu, b_gu, w_down, b_down):
    n, d = xf.shape
    logits = (xf @ w_router + b_router).astype(jnp.float32)
    top_vals, top_idx = lax.top_k(logits, TOP_K)
    gates = jax.nn.softmax(top_vals, axis=-1)
    m = n * TOP_K
    e_flat = top_idx.reshape(m)
    tok_flat = jnp.repeat(jnp.arange(n, dtype=jnp.int32), TOP_K)
    g_flat = gates.reshape(m)
    order = jnp.argsort(e_flat)
    e_sorted = e_flat[order]
    counts = jnp.bincount(e_flat, length=N_EXPERTS)
    padded = ((counts + EXPERT_BLOCK - 1) // EXPERT_BLOCK) * EXPERT_BLOCK
    start = jnp.cumsum(counts) - counts
    pend = jnp.cumsum(padded)
    pstart = pend - padded
    dest = pstart[e_sorted] + (jnp.arange(m) - start[e_sorted])
    n_blocks = (m + N_EXPERTS * (EXPERT_BLOCK - 1) + EXPERT_BLOCK - 1) // EXPERT_BLOCK
    rows = n_blocks * EXPERT_BLOCK
    tok_buf = jnp.zeros((rows,), jnp.int32).at[dest].set(tok_flat[order])
    gate_buf = jnp.zeros((rows,), xf.dtype).at[dest].set(g_flat[order].astype(xf.dtype))
    block_start = jnp.arange(n_blocks) * EXPERT_BLOCK
    block_expert = jnp.minimum(jnp.sum(pend[None, :] <= block_start[:, None], axis=1), N_EXPERTS - 1)
    x_blocks = xf[tok_buf].reshape(n_blocks, EXPERT_BLOCK, d)

    def expert_block(args):
        xb, e = args
        hgu = xb @ w_gu[e] + b_gu[e]
        gate = jnp.minimum(hgu[:, :D_EXPERT], SWIGLU_LIMIT)
        up = jnp.clip(hgu[:, D_EXPERT:], -SWIGLU_LIMIT, SWIGLU_LIMIT)
        act = (up + 1.0) * gate * jax.nn.sigmoid(SWIGLU_ALPHA * gate)
        return act @ w_down[e] + b_down[e]

    y_blocks = lax.map(expert_block, (x_blocks, block_expert)).reshape(rows, d)
    return jnp.zeros_like(xf).at[tok_buf].add(gate_buf[:, None] * y_blocks)


def setup_inputs(seed: int = 0) -> dict:
    key = jax.random.key(seed)
    ks = jax.random.split(key, 16)

    def normal(k, shape, scale):
        return jax.random.normal(k, shape, jnp.float32) * scale

    L = DEPTH
    wa = N_HEADS_A * HEAD_DIM
    wb = N_HEADS_B * HEAD_DIM
    return {
        'x': normal(ks[0], (BATCH, SEQ, D_MODEL), 1.0),
        'norm_mix_g': 1.0 + normal(ks[1], (L, D_MODEL), 0.02),
        'w_in': normal(ks[2], (L, D_MODEL, D_PROJ), D_MODEL ** -0.5),
        'q_norm_g': 1.0 + normal(ks[3], (L, HEAD_DIM), 0.02),
        'k_norm_g': 1.0 + normal(ks[4], (L, HEAD_DIM), 0.02),
        'w_proj_a': normal(ks[5], (L, wa, D_MODEL), wa ** -0.5),
        'w_proj_b': normal(ks[6], (L, wb, D_MODEL), wb ** -0.5),
        'w_out': normal(ks[7], (L, D_MODEL, D_MODEL), D_MODEL ** -0.5),
        'norm_ffn_g': 1.0 + normal(ks[8], (L, D_MODEL), 0.02),
        'w_router': normal(ks[9], (L, D_MODEL, N_EXPERTS), D_MODEL ** -0.5),
        'b_router': normal(ks[10], (L, N_EXPERTS), 0.01),
        'w_gate_up': normal(ks[11], (L, N_EXPERTS, D_MODEL, 2 * D_EXPERT), D_MODEL ** -0.5),
        'b_gate_up': normal(ks[12], (L, N_EXPERTS, 2 * D_EXPERT), 0.01),
        'w_down': normal(ks[13], (L, N_EXPERTS, D_EXPERT, D_MODEL), D_EXPERT ** -0.5),
        'b_down': normal(ks[14], (L, N_EXPERTS, D_MODEL), 0.01),
    }


def reference(x, norm_mix_g, w_in, q_norm_g, k_norm_g, w_proj_a, w_proj_b, w_out, norm_ffn_g, w_router, b_router, w_gate_up, b_gate_up, w_down, b_down):
    b, s, d = x.shape
    cos, sin = rope_tables(s)
    h = x
    for l in range(DEPTH):
        h = h + hybrid_mixer(rms_norm(h, norm_mix_g[l]), w_in[l], q_norm_g[l], k_norm_g[l], w_proj_a[l], w_proj_b[l], w_out[l], cos, sin)
        hn = rms_norm(h, norm_ffn_g[l]).reshape(b * s, d)
        h = h + moe_ffn(hn, w_router[l], b_router[l], w_gate_up[l], b_gate_up[l], w_down[l], b_down[l]).reshape(b, s, d)
    return h
```

```cpp
#include <hip/hip_runtime.h>
#include <cstdio>
#include <cstdint>
namespace pg8 {
#define PG8_LAS __attribute__((address_space(3)))
typedef unsigned short bf16_t;
typedef short bf16x8 __attribute__((ext_vector_type(8)));
typedef float f32x4 __attribute__((ext_vector_type(4)));
typedef unsigned u32x4 __attribute__((ext_vector_type(4)));
constexpr int BM = 256, BK = 64, HALF = 128, HTB = HALF * BK * 2  , STAGE_BYTES = 8 * HTB, NXCD = 8, WGM = 8;

__host__ __device__ __forceinline__ int lds_byte(int r, int c) { const int st = (r >> 4) * 2 + (c >> 5), rr = r & 15, cc = c & 31, ob = rr * 64 + cc * 2; return st * 1024 + (ob ^ (((ob >> 9) & 1) << 5)); }
__host__ __device__ __forceinline__ void stage_rc(int b, int& R, int& C) { const int st = b / 1024, sb = b % 1024, swz = sb ^ (((sb >> 9) & 1) << 5); R = (st >> 1) * 16 + swz / 64; C = (st & 1) * 32 + (swz % 64) / 2; }
__host__ __device__ __forceinline__ int perm32(int rho) { const int n = rho >> 4, i = rho & 15; return 8 * (i >> 2) + 4 * n + (i & 3); }

struct Unit { int pm, pn, pb, e; };
struct Gemm { const bf16_t* A; const bf16_t* Bt; int M, N, K; };

struct StaticOrder {
    int nM, nN, nwg, G, c;
    __host__ __device__ void init(int M, int N, int G_, int c_) { nM = M / BM; nN = N / BM; nwg = nM * nN; G = G_; c = c_; }
    __host__ __device__ bool next(int i, Unit& u) const {
        const long L = (long)i * G + c; if (L >= nwg) return false;
        int wgid = (int)L; { const int q = nwg / NXCD, r = nwg % NXCD, xcd = wgid % NXCD, off = wgid / NXCD; wgid = (xcd < r ? xcd * (q + 1) : r * (q + 1) + (xcd - r) * q) + off; }
        const int nig = WGM * nN, gid = wgid / nig, fm = gid * WGM, gsz = (nM - fm) < WGM ? (nM - fm) : WGM;
        u.pm = fm + ((wgid % nig) % gsz); u.pn = (wgid % nig) / gsz; u.pb = u.pn; u.e = 0; return true;
    }
    __device__ __forceinline__ void a_ready(const Unit&) const {}
    __device__ __forceinline__ void done(const Unit&) const {}
};


__device__ __forceinline__ unsigned cvt_pk_bf16(float lo, float hi) { unsigned r; asm volatile("v_cvt_pk_bf16_f32 %0, %1, %2" : "=v"(r) : "v"(lo), "v"(hi)); return r; }
__device__ __forceinline__ float bf_lo(unsigned w) { return __uint_as_float(w << 16); }
__device__ __forceinline__ float bf_hi(unsigned w) { return __uint_as_float(w & 0xffff0000u); }
__device__ __forceinline__ float sigmoidf_(float x) { return 1.0f / (1.0f + __expf(-x)); }
__device__ __forceinline__ u32x4 pack8(const f32x4& v0, const f32x4& v1) { u32x4 w; w.x = cvt_pk_bf16(v0[0], v0[1]); w.y = cvt_pk_bf16(v0[2], v0[3]); w.z = cvt_pk_bf16(v1[0], v1[1]); w.w = cvt_pk_bf16(v1[2], v1[3]); return w; }
__device__ __forceinline__ void unpack8(const u32x4& w, f32x4& v0, f32x4& v1) { v0 = (f32x4){bf_lo(w.x), bf_hi(w.x), bf_lo(w.y), bf_hi(w.y)}; v1 = (f32x4){bf_lo(w.z), bf_hi(w.z), bf_lo(w.w), bf_hi(w.w)}; }

struct EpiProj {
    static constexpr bool PERM = true, AFTER_DRAIN = false;
    bf16_t* PROJ; float* SMALLF;
    __device__ __forceinline__ void operator()(const f32x4 (&acc)[2][2][4][2], const Unit& u, int wr, int wc, int fr, int fq) const {
        const int row0 = u.pm * BM + wr * 64 + fr, cl = wc * 32 + 8 * fq;
        if (u.pn < 18) {
            const int mode = (u.pn >= 10) ? 2 : ((u.pn == 4 || u.pn == 5) ? 1 : 0);
#pragma unroll
            for (int ai = 0; ai < 2; ++ai)
#pragma unroll
                for (int m = 0; m < 4; ++m) { bf16_t* rowp = PROJ + (size_t)(row0 + ai * HALF + m * 16) * 4608 + u.pn * BM + cl;
#pragma unroll
                    for (int bj = 0; bj < 2; ++bj) { f32x4 v0 = acc[ai][bj][m][0], v1 = acc[ai][bj][m][1];
                        if (mode == 1) { v0 = v0 * 0.125f; v1 = v1 * 0.125f; }
                        else if (mode == 2) {
#pragma unroll
                            for (int j = 0; j < 4; ++j) { v0[j] = sigmoidf_(v0[j]); v1[j] = sigmoidf_(v1[j]); } }
                        *(u32x4*)(rowp + bj * HALF) = pack8(v0, v1); } }
        } else {
#pragma unroll
            for (int ai = 0; ai < 2; ++ai)
#pragma unroll
                for (int m = 0; m < 4; ++m) { float* rowp = SMALLF + (size_t)(row0 + ai * HALF + m * 16) * 256 + cl;
#pragma unroll
                    for (int bj = 0; bj < 2; ++bj) { *(f32x4*)(rowp + bj * HALF) = acc[ai][bj][m][0]; *(f32x4*)(rowp + bj * HALF + 4) = acc[ai][bj][m][1]; } }
        }
    }
};
template <bool FIRST> struct EpiGate {
    static constexpr bool PERM = true, AFTER_DRAIN = false;
    const bf16_t* PROJ; int goff; bf16_t* MERGED;
    __device__ __forceinline__ void operator()(const f32x4 (&acc)[2][2][4][2], const Unit& u, int wr, int wc, int fr, int fq) const {
        const int row0 = u.pm * BM + wr * 64 + fr, col0 = u.pn * BM + wc * 32 + 8 * fq;
#pragma unroll
        for (int ai = 0; ai < 2; ++ai)
#pragma unroll
            for (int m = 0; m < 4; ++m) { const size_t row = (size_t)(row0 + ai * HALF + m * 16);
#pragma unroll
                for (int bj = 0; bj < 2; ++bj) { const int col = col0 + bj * HALF;
                    const u32x4 gw = *(const u32x4*)(PROJ + row * 4608 + goff + col); f32x4 g0, g1; unpack8(gw, g0, g1);
                    f32x4 v0 = acc[ai][bj][m][0] * g0, v1 = acc[ai][bj][m][1] * g1;
                    bf16_t* mp = MERGED + row * 1024 + col;
                    if (!FIRST) { const u32x4 pw = *(const u32x4*)mp; f32x4 p0, p1; unpack8(pw, p0, p1); v0 = v0 + p0; v1 = v1 + p1; }
                    *(u32x4*)mp = pack8(v0, v1); } }
    }
};
struct EpiOut {
    static constexpr bool PERM = true, AFTER_DRAIN = false;
    const float* X; float* OUT; float* SSQP;
    __device__ __forceinline__ void operator()(const f32x4 (&acc)[2][2][4][2], const Unit& u, int wr, int wc, int fr, int fq) const {
        const int row0 = u.pm * BM + wr * 64 + fr, col0 = u.pn * BM + wc * 32 + 8 * fq;
#pragma unroll
        for (int ai = 0; ai < 2; ++ai)
#pragma unroll
            for (int m = 0; m < 4; ++m) { const size_t row = (size_t)(row0 + ai * HALF + m * 16); float s = 0.f;
#pragma unroll
                for (int bj = 0; bj < 2; ++bj) { const size_t off = row * 1024 + col0 + bj * HALF;
                    const f32x4 x0 = *(const f32x4*)(X + off), x1 = *(const f32x4*)(X + off + 4);
                    const f32x4 h0 = x0 + acc[ai][bj][m][0], h1 = x1 + acc[ai][bj][m][1];
                    *(f32x4*)(OUT + off) = h0; *(f32x4*)(OUT + off + 4) = h1;
                    s += (h0[0] * h0[0] + h0[1] * h0[1]) + (h0[2] * h0[2] + h0[3] * h0[3]) + (h1[0] * h1[0] + h1[1] * h1[1]) + (h1[2] * h1[2] + h1[3] * h1[3]); }
                s += __shfl_xor(s, 16); s += __shfl_xor(s, 32);
                if (fq == 0) SSQP[row * 16 + u.pn * 4 + wc] = s; }
    }
};
struct EpiAct {
    static constexpr bool PERM = true, AFTER_DRAIN = false;
    const float* BGU; bf16_t* ACT;
    __device__ __forceinline__ void operator()(const f32x4 (&acc)[2][2][4][2], const Unit& u, int wr, int wc, int fr, int fq) const {
        const int row0 = u.pm * BM + wr * 64 + fr, j0 = u.pn * HALF + wc * 32 + 8 * fq;
        const float* bg = BGU + (size_t)u.e * 2048 + j0;
        const f32x4 bg0 = *(const f32x4*)bg, bg1 = *(const f32x4*)(bg + 4), bu0 = *(const f32x4*)(bg + 1024), bu1 = *(const f32x4*)(bg + 1028);
#pragma unroll
        for (int ai = 0; ai < 2; ++ai)
#pragma unroll
            for (int m = 0; m < 4; ++m) { f32x4 o[2];
#pragma unroll
                for (int n = 0; n < 2; ++n) { const f32x4 g = acc[ai][0][m][n] + (n ? bg1 : bg0), up = acc[ai][1][m][n] + (n ? bu1 : bu0);
#pragma unroll
                    for (int j = 0; j < 4; ++j) { const float gc = fminf(g[j], 7.0f), uc = fminf(fmaxf(up[j], -7.0f), 7.0f); o[n][j] = (uc + 1.0f) * gc * sigmoidf_(1.702f * gc); } }
                *(u32x4*)(ACT + (size_t)(row0 + ai * HALF + m * 16) * 1024 + j0) = pack8(o[0], o[1]); }
    }
};
struct EpiDown {
    static constexpr bool PERM = true, AFTER_DRAIN = false;
    const float* BD; bf16_t* Y;
    __device__ __forceinline__ void operator()(const f32x4 (&acc)[2][2][4][2], const Unit& u, int wr, int wc, int fr, int fq) const {
        const int row0 = u.pm * BM + wr * 64 + fr, col0 = u.pn * BM + wc * 32 + 8 * fq;
        f32x4 bv[2][2];
#pragma unroll
        for (int bj = 0; bj < 2; ++bj)
#pragma unroll
            for (int n = 0; n < 2; ++n) bv[bj][n] = *(const f32x4*)(BD + (size_t)u.e * 1024 + col0 + bj * HALF + 4 * n);
#pragma unroll
        for (int ai = 0; ai < 2; ++ai)
#pragma unroll
            for (int m = 0; m < 4; ++m) { bf16_t* rowp = Y + (size_t)(row0 + ai * HALF + m * 16) * 1024 + col0;
#pragma unroll
                for (int bj = 0; bj < 2; ++bj) *(u32x4*)(rowp + bj * HALF) = pack8(acc[ai][bj][m][0] + bv[bj][0], acc[ai][bj][m][1] + bv[bj][1]); }
    }
};
struct MoeOrder {
    const volatile PG8_LAS int* ts; int T, nN, nwg, G, c;
    __device__ void init(const volatile PG8_LAS int* ts_, int nN_, int G_, int c_) { ts = ts_; T = ts_[32]; nN = nN_; nwg = T * nN_; G = G_; c = c_; }
    __device__ bool next(int i, Unit& u) const {
        const long L = (long)i * G + c; if (L >= nwg) return false;
        int wgid = (int)L; { const int q = nwg / NXCD, r = nwg % NXCD, xcd = wgid % NXCD, off = wgid / NXCD; wgid = (xcd < r ? xcd * (q + 1) : r * (q + 1) + (xcd - r) * q) + off; }
        const int nig = WGM * nN, gid = wgid / nig, fm = gid * WGM, gsz = (T - fm) < WGM ? (T - fm) : WGM;
        u.pm = fm + ((wgid % nig) % gsz); u.pn = (wgid % nig) / gsz;
        int e = 0; while (e < 31 && ts[e + 1] <= u.pm) ++e;
        u.e = e; u.pb = e * nN + u.pn; return true;
    }
    __device__ __forceinline__ void a_ready(const Unit&) const {}
    __device__ __forceinline__ void done(const Unit&) const {}
};

template <class Epi, class Sched, bool ALIGN_EPI = false, bool SP2 = false>
__device__ __forceinline__ void gemm_phase(PG8_LAS unsigned char* lds, const Gemm g, const Sched& S, const Epi& E) {
    const int tid = threadIdx.x, wid = __builtin_amdgcn_readfirstlane(tid >> 6), lane = tid & 63, wr = wid >> 2, wc = wid & 3, fr = lane & 15, fq = lane >> 4;
    const int K = g.K, nt = K / BK;
    unsigned voffA[2], voffB[2];
#pragma unroll
    for (int i = 0; i < 2; ++i) { int R, C; stage_rc(tid * 16 + i * 8192, R, C); const int Rb = Epi::PERM ? ((R & ~31) + perm32(R & 31)) : R;
        voffA[i] = (unsigned)(R * K + C) * 2u; voffB[i] = (unsigned)(Rb * K + C) * 2u; }
    const size_t kstep = (size_t)(BK * 2);
    const size_t hstep = (size_t)HALF * K * 2;
    const size_t tstep = 2 * hstep;
    const unsigned ldsw = (unsigned)wid * 1024u;
    const int aoff = lds_byte(wr * 64 + fr, fq * 8), boff = lds_byte(wc * 32 + fr, fq * 8);
#define PG8_SA(b, h) (((b) * 2 + (h)) * HTB)
#define PG8_SB(b, h) ((4 + (b) * 2 + (h)) * HTB)
#define PG8_STAGE(bufoff, gbase, voff) do { _Pragma("unroll") for (int _i = 0; _i < 2; ++_i) \
        __builtin_amdgcn_global_load_lds((const unsigned*)((const char*)(gbase) + (voff)[_i]), (PG8_LAS unsigned*)(lds + (bufoff) + ldsw + _i * 8192), 16, 0, 0); } while (0)
#define PG8_LDA(dst, b, h) do { _Pragma("unroll") for (int m = 0; m < 4; ++m) _Pragma("unroll") for (int k = 0; k < 2; ++k) dst[m][k] = *(const PG8_LAS bf16x8*)(lds + PG8_SA(b, h) + aoff + m * 2048 + k * 1024); } while (0)
#define PG8_LDB(dst, b, h) do { _Pragma("unroll") for (int n = 0; n < 2; ++n) _Pragma("unroll") for (int k = 0; k < 2; ++k) dst[n][k] = *(const PG8_LAS bf16x8*)(lds + PG8_SB(b, h) + boff + n * 2048 + k * 1024); } while (0)
#define PG8_MMA(ai, bj, At, Bt) do { __builtin_amdgcn_s_setprio(1); _Pragma("unroll") for (int m = 0; m < 4; ++m) _Pragma("unroll") for (int n = 0; n < 2; ++n) _Pragma("unroll") for (int k = 0; k < 2; ++k) \
        acc[ai][bj][m][n] = __builtin_amdgcn_mfma_f32_16x16x32_bf16(Bt[n][k], At[m][k], acc[ai][bj][m][n], 0, 0, 0); __builtin_amdgcn_s_setprio(0); } while (0)
#define PG8_WAIT_V(n) asm volatile("s_waitcnt vmcnt(" #n ")" ::: "memory")
#define PG8_WAIT_L(n) asm volatile("s_waitcnt lgkmcnt(" #n ")" ::: "memory")
#define PG8_BAR __builtin_amdgcn_s_barrier()
#define PG8_SCHED __builtin_amdgcn_sched_barrier(0)
    Unit cur, nxt; int ui = 0;
    if (!S.next(0, cur)) return;
    f32x4 acc[2][2][4][2];
#pragma unroll
    for (int a = 0; a < 2; ++a)
#pragma unroll
        for (int b = 0; b < 2; ++b)
#pragma unroll
            for (int m = 0; m < 4; ++m)
#pragma unroll
                for (int n = 0; n < 2; ++n) acc[a][b][m][n] = (f32x4){0.f, 0.f, 0.f, 0.f};
    bf16x8 At[4][2], B0[2][2], B1[2][2];
    const char* cA = (const char*)g.A + (size_t)cur.pm * tstep; const char* cB = (const char*)g.Bt + (size_t)cur.pb * tstep;
    S.a_ready(cur);
    if constexpr (SP2) {
        PG8_STAGE(PG8_SB(0, 0), cB, voffB); PG8_STAGE(PG8_SB(0, 1), cB + hstep, voffB); PG8_STAGE(PG8_SA(0, 0), cA, voffA); PG8_STAGE(PG8_SA(0, 1), cA + hstep, voffA);
        if (wr == 1) PG8_BAR;
        PG8_WAIT_V(2); PG8_BAR;
        PG8_STAGE(PG8_SB(1, 0), cB + kstep, voffB); PG8_STAGE(PG8_SA(1, 0), cA + kstep, voffA); PG8_STAGE(PG8_SB(1, 1), cB + hstep + kstep, voffB);
        PG8_WAIT_V(6); PG8_BAR;
    } else {
        PG8_STAGE(PG8_SB(0, 0), cB, voffB); PG8_STAGE(PG8_SA(0, 0), cA, voffA); PG8_STAGE(PG8_SB(0, 1), cB + hstep, voffB); PG8_STAGE(PG8_SA(0, 1), cA + hstep, voffA);
        if (wr == 1) PG8_BAR;
        PG8_WAIT_V(4); PG8_BAR;
        PG8_STAGE(PG8_SB(1, 0), cB + kstep, voffB); PG8_STAGE(PG8_SA(1, 0), cA + kstep, voffA); PG8_STAGE(PG8_SB(1, 1), cB + hstep + kstep, voffB);
        PG8_WAIT_V(6); PG8_BAR;
    }
    for (;;) {
        const bool has_next = S.next(ui + 1, nxt);
        const char* nA = has_next ? (const char*)g.A + (size_t)nxt.pm * tstep : cA; const char* nB = has_next ? (const char*)g.Bt + (size_t)nxt.pb * tstep : cB;
        for (int t = 0; t < nt; t += 2) {
            const bool last = (t == nt - 2);
            const char* a1 = cA + (size_t)(t + 1) * kstep;
            const char* a2 = last ? nA : cA + (size_t)(t + 2) * kstep; const char* b2 = last ? nB : cB + (size_t)(t + 2) * kstep;
            const char* a3 = a2 + kstep; const char* b3 = b2 + kstep;
            if (last && has_next) S.a_ready(nxt);
            if constexpr (SP2) {
            PG8_LDB(B0, 0, 0); PG8_LDB(B1, 0, 1); PG8_SCHED; PG8_LDA(At, 0, 0); PG8_STAGE(PG8_SA(1, 1), a1 + hstep, voffA);
            PG8_WAIT_V(8); PG8_WAIT_L(0); PG8_BAR; PG8_MMA(0, 0, At, B0); PG8_MMA(0, 1, At, B1); PG8_BAR; PG8_SCHED;
            PG8_LDA(At, 0, 1); PG8_STAGE(PG8_SB(0, 0), b2, voffB); PG8_STAGE(PG8_SB(0, 1), b2 + hstep, voffB); PG8_STAGE(PG8_SA(0, 0), a2, voffA);
            PG8_WAIT_V(8); PG8_WAIT_L(0); PG8_BAR; PG8_MMA(1, 0, At, B0); PG8_MMA(1, 1, At, B1); PG8_BAR; PG8_SCHED;
            PG8_LDB(B0, 1, 0); PG8_LDB(B1, 1, 1); PG8_SCHED; PG8_LDA(At, 1, 0); PG8_STAGE(PG8_SA(0, 1), a2 + hstep, voffA);
            PG8_WAIT_V(8); PG8_WAIT_L(0); PG8_BAR; PG8_MMA(0, 0, At, B0); PG8_MMA(0, 1, At, B1); PG8_BAR; PG8_SCHED;
            PG8_LDA(At, 1, 1); PG8_STAGE(PG8_SB(1, 0), b3, voffB); PG8_STAGE(PG8_SB(1, 1), b3 + hstep, voffB); PG8_STAGE(PG8_SA(1, 0), a3, voffA);
            PG8_WAIT_V(8); PG8_WAIT_L(0); PG8_BAR; PG8_MMA(1, 0, At, B0); PG8_MMA(1, 1, At, B1); PG8_BAR; PG8_SCHED;
            } else {
            PG8_LDB(B0, 0, 0); PG8_SCHED; PG8_LDA(At, 0, 0); PG8_STAGE(PG8_SA(1, 1), a1 + hstep, voffA);
            PG8_WAIT_L(8); PG8_BAR; PG8_WAIT_L(0); PG8_MMA(0, 0, At, B0); PG8_BAR; PG8_SCHED;
            PG8_LDB(B1, 0, 1); PG8_STAGE(PG8_SB(0, 0), b2, voffB);
            PG8_BAR; PG8_WAIT_L(0); PG8_MMA(0, 1, At, B1); PG8_BAR;
            PG8_LDA(At, 0, 1); PG8_STAGE(PG8_SA(0, 0), a2, voffA);
            PG8_BAR; PG8_WAIT_L(0); PG8_MMA(1, 0, At, B0); PG8_BAR; PG8_SCHED;
            PG8_STAGE(PG8_SB(0, 1), b2 + hstep, voffB);
            PG8_WAIT_V(6); PG8_BAR; PG8_MMA(1, 1, At, B1); PG8_BAR;
            PG8_LDB(B0, 1, 0); PG8_SCHED; PG8_LDA(At, 1, 0); PG8_STAGE(PG8_SA(0, 1), a2 + hstep, voffA);
            PG8_WAIT_L(8); PG8_BAR; PG8_WAIT_L(0); PG8_MMA(0, 0, At, B0); PG8_BAR; PG8_SCHED;
            PG8_LDB(B1, 1, 1); PG8_STAGE(PG8_SB(1, 0), b3, voffB);
            PG8_BAR; PG8_WAIT_L(0); PG8_MMA(0, 1, At, B1); PG8_BAR;
            PG8_LDA(At, 1, 1); PG8_STAGE(PG8_SA(1, 0), a3, voffA);
            PG8_BAR; PG8_WAIT_L(0); PG8_MMA(1, 0, At, B0); PG8_BAR; PG8_SCHED;
            PG8_STAGE(PG8_SB(1, 1), b3 + hstep, voffB);
            PG8_WAIT_V(6); PG8_BAR; PG8_MMA(1, 1, At, B1); PG8_BAR;
            }
        }
        if constexpr (ALIGN_EPI) { if (wr == 0) PG8_BAR; }
        if constexpr (!Epi::AFTER_DRAIN) { E(acc, cur, wr, wc, fr, fq); S.done(cur); }
        if (!has_next) break;
#pragma unroll
        for (int a = 0; a < 2; ++a)
#pragma unroll
            for (int b = 0; b < 2; ++b)
#pragma unroll
                for (int m = 0; m < 4; ++m)
#pragma unroll
                    for (int n = 0; n < 2; ++n) acc[a][b][m][n] = (f32x4){0.f, 0.f, 0.f, 0.f};
        cur = nxt; cA = nA; cB = nB; ++ui;
        if constexpr (ALIGN_EPI) { if (wr == 1) PG8_BAR; }
    }
    PG8_WAIT_V(0);
    if constexpr (!ALIGN_EPI) { if (wr == 0) PG8_BAR; }
    PG8_BAR;
    if constexpr (Epi::AFTER_DRAIN) { E.fused(acc, cur, wr, wc, fr, fq, lds, wid, lane); S.done(cur); }
#undef PG8_SA
#undef PG8_SB
#undef PG8_STAGE
#undef PG8_LDA
#undef PG8_LDB
#undef PG8_MMA
#undef PG8_WAIT_V
#undef PG8_WAIT_L
#undef PG8_BAR
#undef PG8_SCHED
}
}

constexpr int NWAVES = 8;
#ifndef MK_N_LAUNCHES
#define MK_N_LAUNCHES 11
#endif
constexpr int N_PHASES = 11;
constexpr int N_LAUNCHES = MK_N_LAUNCHES;

constexpr int NB = 4, SEQ = 4096, DM = 1024, NTOK = NB * SEQ;
constexpr int NPROJ = 4808, NPROJ_PAD = 4864, PROJ_LD = 4608;
constexpr int NEXP = 32, MAXTILES = 288;
constexpr float RMS_EPS = 1e-6f;

constexpr size_t MiB = 1u << 20;
constexpr size_t WS_CTL = 0, CTL_ZERO_BYTES = 1 * MiB;
constexpr size_t WS_WI = 2 * MiB, WS_WPA = 12 * MiB, WS_WPB = 13 * MiB, WS_WO = 14 * MiB, WS_WGU = 16 * MiB, WS_WD = 144 * MiB;
constexpr size_t WS_XN = 208 * MiB, WS_PROJ = 240 * MiB, WS_SMALLF = 384 * MiB, WS_KA = 400 * MiB, WS_VA = 402 * MiB, WS_KI = 404 * MiB, WS_WIQ = 406 * MiB;
constexpr size_t WS_OA = 408 * MiB, WS_OB = 424 * MiB, WS_MERGED = 440 * MiB, WS_SSQP = 472 * MiB;
constexpr size_t WS_TOKE = 473 * MiB, WS_TOKG = WS_TOKE + 256 * 1024, WS_TOKP = WS_TOKG + 256 * 1024, WS_LIST = 474 * MiB;
constexpr size_t WS_XG = 480 * MiB, WS_ACT = 624 * MiB, WS_Y = 768 * MiB, WS_END = 912 * MiB;
constexpr int CW_TMO = 0, CW_CODE = 1;
constexpr int CW_BAR = 4096;
constexpr int CW_CNT = 8192;
constexpr int CW_QUEUE = 8448;
constexpr int RING_OFF = 0, RING_BYTES = 131072;
constexpr int IDX_OFF = 131072;
constexpr int LDSCTL_OFF = 143360, MISC_OFF = LDSCTL_OFF + 320;
constexpr int LDS_BYTES = 147456;
constexpr int MI_BAR = 8, MI_TS = 16  , MI_CNT = 64  , MI_Q = 100;

#define GAS __attribute__((address_space(1)))
#define LAS __attribute__((address_space(3)))
typedef unsigned short bf16;
typedef unsigned v4u __attribute__((ext_vector_type(4)));
typedef float f32x4 __attribute__((ext_vector_type(4)));
typedef short bf16x8 __attribute__((ext_vector_type(8)));
typedef GAS unsigned gu32;
typedef GAS unsigned long long gu64;
#define RLX_AGENT __ATOMIC_RELAXED, __HIP_MEMORY_SCOPE_AGENT
#define LDS_WAIT() asm volatile("s_waitcnt lgkmcnt(0)" ::: "memory")
#define VM_WAIT() asm volatile("s_waitcnt vmcnt(0)" ::: "memory")
__device__ __forceinline__ unsigned long long rt() { return __builtin_amdgcn_s_memrealtime(); }
__device__ __forceinline__ unsigned f2bf(float f) { unsigned u = __builtin_bit_cast(unsigned, f); return (u + 0x7fffu + ((u >> 16) & 1u)) >> 16; }
__device__ __forceinline__ unsigned pk2(float lo, float hi) { return f2bf(lo) | (f2bf(hi) << 16); }

#define XB_TMO      128
#define XB_XCNT(j)  (256  + 64 * (j))
#define XB_XSUB(j)  (1280 + 64 * (j))
#define XB_XGEN(j)  (2304 + 64 * (j))
#define XB_TOP      3328
#define XB_TOPGEN   3392
#define XCD_BAR_WORDS 3456
#define XB_SPIN_CAP (1u << 18)

__device__ __forceinline__ unsigned xb_ld(unsigned* p)              { return __hip_atomic_load(p, __ATOMIC_RELAXED, __HIP_MEMORY_SCOPE_AGENT); }
__device__ __forceinline__ unsigned xb_add(unsigned* p, unsigned v) { return __hip_atomic_fetch_add(p, v, __ATOMIC_RELAXED, __HIP_MEMORY_SCOPE_AGENT); }
__device__ __forceinline__ unsigned xb_xcc_id() { return (unsigned)__builtin_amdgcn_s_getreg((3 << 11) | 20) & 0xFu; }
#define XB_SPIN(cond, bar) do { unsigned _sp = 0; while (cond) { __builtin_amdgcn_s_sleep(1); \
    if ((++_sp & 255u) == 0u) { if (xb_ld(&(bar)[XB_TMO])) break; if (_sp > XB_SPIN_CAP) { atomicAdd(&(bar)[XB_TMO], 1u); break; } } } } while (0)

struct XcdBarrier {
    unsigned* bar; unsigned x;
    volatile LAS unsigned* st;
};

__device__ __forceinline__ XcdBarrier xcd_barrier_post(unsigned* bar, volatile LAS unsigned* st) {
    XcdBarrier b; b.bar = bar; b.x = xb_xcc_id(); b.st = st;
    if (threadIdx.x == 0) (void)xb_add(&bar[XB_XCNT(b.x)], 1u);
    return b;
}
__device__ __forceinline__ void xcd_barrier_complete(unsigned* bar, unsigned x, unsigned& nloc, unsigned& nx) {
    const unsigned G = gridDim.x * gridDim.y * gridDim.z;
    unsigned sum, cnt, mine, sp = 0u;
    for (;;) {
        sum = 0u; cnt = 0u; mine = 0u;
#pragma unroll
        for (unsigned j = 0; j < 16; ++j) { const unsigned c = xb_ld(&bar[XB_XCNT(j)]); sum += c; cnt += (c > 0u) ? 1u : 0u; mine = (j == x) ? c : mine; }
        if (sum == G) break;
        __builtin_amdgcn_s_sleep(1);
        if ((++sp & 255u) == 0u) { if (xb_ld(&bar[XB_TMO])) break; if (sp > XB_SPIN_CAP) { atomicAdd(&bar[XB_TMO], 1u); break; } }
    }
    nloc = mine > 0u ? mine : 1u; nx = cnt > 0u ? cnt : 1u;
}

__device__ __forceinline__ void xcd_barrier(const XcdBarrier& b) {
    asm volatile("s_waitcnt vmcnt(0)" ::: "memory");
    __syncthreads();
    if (threadIdx.x == 0) {
        unsigned* bar = b.bar;
        __builtin_amdgcn_s_waitcnt(0);
        unsigned nloc = b.st[0], nx = b.st[1];
        if (nloc == 0u) { xcd_barrier_complete(bar, b.x, nloc, nx); b.st[0] = nloc; b.st[1] = nx; }
        const unsigned old = xb_add(&bar[XB_XSUB(b.x)], 1u);
        const unsigned gen = old / nloc;
        if (old + 1u == (gen + 1u) * nloc) {
            __builtin_amdgcn_fence(__ATOMIC_RELEASE, "agent");
            asm volatile("s_waitcnt vmcnt(0)" ::: "memory");
            const unsigned og = xb_add(&bar[XB_TOP], 1u);
            const unsigned tg = og / nx;
            if (og + 1u == (tg + 1u) * nx) xb_add(&bar[XB_TOPGEN], 1u);
            else XB_SPIN(xb_ld(&bar[XB_TOPGEN]) == tg, bar);
            __builtin_amdgcn_fence(__ATOMIC_ACQUIRE, "agent");
            xb_add(&bar[XB_XGEN(b.x)], 1u);
            asm volatile("s_waitcnt vmcnt(0)" ::: "memory");
        } else {
            XB_SPIN(xb_ld(&bar[XB_XGEN(b.x)]) == gen, bar);
            __builtin_amdgcn_fence(__ATOMIC_ACQUIRE, "agent");
            asm volatile("s_waitcnt vmcnt(0)" ::: "memory");
        }
    }
    __syncthreads();
}


__device__ __forceinline__ float bf2f(unsigned short b) { return __uint_as_float((unsigned)b << 16); }
__device__ __forceinline__ float bflo(unsigned w) { return __uint_as_float(w << 16); }
__device__ __forceinline__ float bfhi(unsigned w) { return __uint_as_float(w & 0xffff0000u); }

struct Frame {
    LAS unsigned char* lds;
    volatile LAS unsigned* MISC;
    gu32* ctl;
    int tid, lane, wave;
    int G;
    const float *x, *g_mix, *w_in, *qg, *kg, *wpa, *wpb, *wout, *g_ffn, *wr, *br, *wgu, *bgu, *wd, *bd;
    float* out;
    bf16 *WI, *WPA, *WPB, *WO, *WGU, *WD;
    bf16 *XN, *PROJ, *KA, *VA, *KI, *OA, *OB, *MERGED, *XG, *ACT, *Y;
    float *SMALLF, *WIQ, *SSQP, *TOKG;
    int *TOKE, *TOKP, *LIST;
};

__device__ __forceinline__ float wave_sum(float v) {
#pragma unroll
    for (int o = 1; o < 64; o <<= 1) v += __shfl_xor(v, o);
    return v;
}
__device__ __forceinline__ float wave_max(float v) {
#pragma unroll
    for (int o = 1; o < 64; o <<= 1) v = fmaxf(v, __shfl_xor(v, o));
    return v;
}

__device__ __forceinline__ int wi_rowmap(int n) {
    if (n < 512) return n;
    if (n < 576) return 4608 + (n - 512);
    if (n < 640) return 4672 + (n - 576);
    if (n < 1152) return 512 + (n - 640);
    if (n < 1216) return 4736 + (n - 1152);
    if (n < 1224) return 4800 + (n - 1216);
    if (n < 1736) return 1024 + (n - 1224);
    if (n < 2248) return 1536 + (n - 1736);
    if (n < 2760) return 2048 + (n - 2248);
    if (n < 3784) return 2560 + (n - 2760);
    return 3584 + (n - 3784);
}
template <int MAP> __device__ __forceinline__ void transpose_item(const float* W, int K, int N, bf16* WT, int row_base, LAS float* scr, int item, int lane) {
    const int nblk = (N + 31) / 32, kb = item / nblk, nb = item % nblk, k0 = 64 * kb, n0 = 32 * nb;
    const int nsrc = n0 + (lane & 31); const bool ok = nsrc < N; const int ncl = ok ? nsrc : 0;
#pragma unroll 8
    for (int i = 0; i < 32; ++i) { const int kk = 2 * i + (lane >> 5); const float v = W[(size_t)(k0 + kk) * N + ncl]; scr[kk * 33 + (lane & 31)] = v; }
    LDS_WAIT(); asm volatile("" ::: "memory");
    const int c = lane & 7;
#pragma unroll
    for (int j = 0; j < 4; ++j) { const int nl = (lane >> 3) + 8 * j, n = n0 + nl; const LAS float* s = scr + (8 * c) * 33 + nl;
        if (n < N) { int dr;
            if (MAP == 0) dr = n; else if (MAP == 1) dr = wi_rowmap(n); else { const int jj = n & 1023; dr = 256 * (jj >> 7) + 128 * (n >> 10) + (jj & 127); }
            v4u o; o.x = pk2(s[0 * 33], s[1 * 33]); o.y = pk2(s[2 * 33], s[3 * 33]); o.z = pk2(s[4 * 33], s[5 * 33]); o.w = pk2(s[6 * 33], s[7 * 33]);
            *(GAS v4u*)(WT + (size_t)(row_base + dr) * K + k0 + 8 * c) = o; } }
    LDS_WAIT(); asm volatile("" ::: "memory");
}
__device__ __forceinline__ void p0_prologue(Frame& F) {
    LAS float* scr = (LAS float*)(F.lds + RING_OFF + F.wave * 16384);
    const int gw = blockIdx.x * NWAVES + F.wave, NGW = F.G * NWAVES;
    constexpr int I_WI = 16 * 151, I_PA = 8 * 32, I_WO = 16 * 32, I_GU = 16 * 64, I_D = 16 * 32;
    constexpr int NITEMS = I_WI + 2 * I_PA + I_WO + NEXP * (I_GU + I_D);
    for (int it = gw; it < NITEMS; it += NGW) {
        int r = it;
        if (r < NEXP * I_GU) { const int e = r / I_GU; transpose_item<2>(F.wgu + (size_t)e * 1024 * 2048, 1024, 2048, F.WGU, e * 2048, scr, r % I_GU, F.lane); continue; } r -= NEXP * I_GU;
        if (r < NEXP * I_D) { const int e = r / I_D; transpose_item<0>(F.wd + (size_t)e * 1024 * 1024, 1024, 1024, F.WD, e * 1024, scr, r % I_D, F.lane); continue; } r -= NEXP * I_D;
        if (r < I_WI) { transpose_item<1>(F.w_in, 1024, NPROJ, F.WI, 0, scr, r, F.lane); continue; } r -= I_WI;
        if (r < I_PA) { transpose_item<0>(F.wpa, 512, 1024, F.WPA, 0, scr, r, F.lane); continue; } r -= I_PA;
        if (r < I_PA) { transpose_item<0>(F.wpb, 512, 1024, F.WPB, 0, scr, r, F.lane); continue; } r -= I_PA;
        transpose_item<0>(F.wout, 1024, 1024, F.WO, 0, scr, r, F.lane);
    }
    { const int gt = blockIdx.x * (NWAVES * 64) + F.tid; if (gt < 7168) { v4u z = {0u, 0u, 0u, 0u}; *((GAS v4u*)(F.WI + (size_t)NPROJ * 1024) + gt) = z; } }
    for (int m = gw; m < NTOK; m += NGW) {
        const GAS f32x4* xr = (const GAS f32x4*)(F.x + (size_t)m * DM) + F.lane; const GAS f32x4* gr = (const GAS f32x4*)F.g_mix + F.lane;
        f32x4 v[4]; float s = 0.f;
#pragma unroll
        for (int j = 0; j < 4; ++j) { v[j] = xr[64 * j]; s += (v[j].x * v[j].x + v[j].y * v[j].y) + (v[j].z * v[j].z + v[j].w * v[j].w); }
        const float rr = 1.0f / sqrtf(wave_sum(s) * (1.f / DM) + RMS_EPS);
        GAS unsigned long long* o8 = (GAS unsigned long long*)(F.XN + (size_t)m * DM) + F.lane;
#pragma unroll
        for (int j = 0; j < 4; ++j) { const f32x4 g = gr[64 * j]; o8[64 * j] = (unsigned long long)pk2(v[j].x * rr * g.x, v[j].y * rr * g.y) | ((unsigned long long)pk2(v[j].z * rr * g.z, v[j].w * rr * g.w) << 32); }
    }
}

__device__ __forceinline__ void p2_prep(Frame& F) {
    const int gt = blockIdx.x * (NWAVES * 64) + F.tid, NGT = F.G * NWAVES * 64;
    for (int w = gt; w < NTOK * 20; w += NGT) {
        const int tk = w / 20, j = w % 20, pos = tk & (SEQ - 1);
        if (j == 19) {
#pragma unroll
            for (int h = 0; h < 8; ++h) F.WIQ[(size_t)tk * 8 + h] = F.SMALLF[(size_t)tk * 256 + 192 + h] * 0.044194173824159216f;
            continue;
        }
        float v[64];
        bf16* dst; bool norm = false, rope = true; const float* g = nullptr; float scale = 1.0f;
        if (j < 16) {
            bf16* p = F.PROJ + (size_t)tk * PROJ_LD + (j < 8 ? j * 64 : 512 + (j - 8) * 64);
#pragma unroll
            for (int c = 0; c < 8; ++c) { const v4u u = *((const GAS v4u*)p + c); v[8 * c] = bflo(u.x); v[8 * c + 1] = bfhi(u.x); v[8 * c + 2] = bflo(u.y); v[8 * c + 3] = bfhi(u.y); v[8 * c + 4] = bflo(u.z); v[8 * c + 5] = bfhi(u.z); v[8 * c + 6] = bflo(u.w); v[8 * c + 7] = bfhi(u.w); }
            dst = p; if (j < 8) { norm = true; g = F.qg; scale = 0.125f; }
        } else {
            const float* p = F.SMALLF + (size_t)tk * 256 + (j == 16 ? 0 : (j == 17 ? 128 : 64));
#pragma unroll
            for (int c = 0; c < 16; ++c) { const f32x4 u = *((const GAS f32x4*)p + c); v[4 * c] = u.x; v[4 * c + 1] = u.y; v[4 * c + 2] = u.z; v[4 * c + 3] = u.w; }
            if (j == 16) { dst = F.KA + (size_t)tk * 64; norm = true; g = F.kg; } else if (j == 17) { dst = F.KI + (size_t)tk * 64; } else { dst = F.VA + (size_t)tk * 64; rope = false; }
        }
        if (norm) { float ss = 0.f;
#pragma unroll
            for (int d = 0; d < 64; ++d) ss += v[d] * v[d];
            const float rr = 1.0f / sqrtf(ss * (1.f / 64.f) + RMS_EPS);
#pragma unroll
            for (int d = 0; d < 64; ++d) v[d] = v[d] * rr * g[d]; }
        if (rope) {
#pragma unroll
            for (int i = 0; i < 8; ++i) { const float inv = exp2f(-(float)i * 0.125f * 18.931568569324174f); const float ang = (float)pos * inv; float sn, cs; sincosf(ang, &sn, &cs);
                const float a = v[i], b2 = v[i + 8]; v[i] = a * cs - b2 * sn; v[i + 8] = b2 * cs + a * sn; } }
#pragma unroll
        for (int c = 0; c < 8; ++c) { v4u o; o.x = pk2(v[8 * c] * scale, v[8 * c + 1] * scale); o.y = pk2(v[8 * c + 2] * scale, v[8 * c + 3] * scale); o.z = pk2(v[8 * c + 4] * scale, v[8 * c + 5] * scale); o.w = pk2(v[8 * c + 6] * scale, v[8 * c + 7] * scale);
            *((GAS v4u*)dst + c) = o; }
    }
}

typedef float f32x16 __attribute__((ext_vector_type(16)));
__device__ __forceinline__ void sb_item(Frame& F, int item) {
    const int bh = item >> 3, tb = item & 7, b = bh >> 3, h = bh & 7, t = tb * 512 + F.tid;
    const bf16* base = F.PROJ + (size_t)(b * SEQ) * PROJ_LD + h * 64;
    float o[64]; v4u qw[8];
    { const GAS v4u* qp = (const GAS v4u*)(base + (size_t)t * PROJ_LD + 1024);
#pragma unroll
      for (int c = 0; c < 8; ++c) qw[c] = qp[c]; }
#pragma unroll
    for (int d = 0; d < 64; ++d) o[d] = 0.f;
    float R = 0.f; int s = t - 1;
    for (;;) {
        const bool active = (s >= 0) && (R <= 104.0f);
        if (!__any(active)) break;
        if (active) {
            const GAS v4u* kp = (const GAS v4u*)(base + (size_t)s * PROJ_LD + 1536);
            const GAS v4u* vp = (const GAS v4u*)(base + (size_t)s * PROJ_LD + 2048);
            float z = 0.f;
#pragma unroll
            for (int c = 0; c < 8; ++c) { const v4u u = kp[c];
                const v4u qq = qw[c]; z += bflo(qq.x) * bflo(u.x) + bfhi(qq.x) * bfhi(u.x) + bflo(qq.y) * bflo(u.y) + bfhi(qq.y) * bfhi(u.y) + bflo(qq.z) * bflo(u.z) + bfhi(qq.z) * bfhi(u.z) + bflo(qq.w) * bflo(u.w) + bfhi(qq.w) * bfhi(u.w); }
            const float sp = fmaxf(z, 0.f) + log1pf(__expf(-fabsf(z)));
            R += sp;
            const float a = __expf(z - R);
#pragma unroll
            for (int c = 0; c < 8; ++c) { const v4u u = vp[c];
                o[8 * c] += a * bflo(u.x); o[8 * c + 1] += a * bfhi(u.x); o[8 * c + 2] += a * bflo(u.y); o[8 * c + 3] += a * bfhi(u.y); o[8 * c + 4] += a * bflo(u.z); o[8 * c + 5] += a * bfhi(u.z); o[8 * c + 6] += a * bflo(u.w); o[8 * c + 7] += a * bfhi(u.w); }
        }
        --s;
    }
    GAS v4u* op = (GAS v4u*)(F.OB + (size_t)(b * SEQ + t) * 512 + h * 64);
#pragma unroll
    for (int c = 0; c < 8; ++c) { v4u w; w.x = pk2(o[8 * c], o[8 * c + 1]); w.y = pk2(o[8 * c + 2], o[8 * c + 3]); w.z = pk2(o[8 * c + 4], o[8 * c + 5]); w.w = pk2(o[8 * c + 6], o[8 * c + 7]); op[c] = w; }
}

__device__ __forceinline__ void dsa_item(Frame& F, int b, int t0) {
    const int lane = F.lane, wave = F.wave;
    const int L = ((t0 >> 6) + 1) << 6;
    LAS float* sc = (LAS float*)(F.lds + RING_OFF);
    if (L > 256) {
        const int r = lane & 31, hb = lane >> 5;
        const int head = (r & 3) + 4 * ((r >> 3) & 1), qsub = ((r >> 2) & 1) + 2 * ((r >> 4) & 1);
        bf16x8 qa[2][4]; float wq[2][2][8];
#pragma unroll
        for (int j = 0; j < 2; ++j) {
            const bf16* qp = F.PROJ + (size_t)(b * SEQ + t0 + 4 * j + qsub) * PROJ_LD + 512 + head * 64 + 8 * hb;
#pragma unroll
            for (int ks = 0; ks < 4; ++ks) qa[j][ks] = *(const GAS bf16x8*)(qp + 16 * ks);
#pragma unroll
            for (int x2 = 0; x2 < 2; ++x2)
#pragma unroll
                for (int hh = 0; hh < 8; ++hh) wq[j][x2][hh] = F.WIQ[(size_t)(b * SEQ + t0 + 4 * j + hb + 2 * x2) * 8 + hh];
        }
        for (int kt = wave; kt < (L >> 5); kt += 8) {
            const bf16* kp = F.KI + (size_t)(b * SEQ + 32 * kt + r) * 64 + 8 * hb;
            bf16x8 kb[4];
#pragma unroll
            for (int ks = 0; ks < 4; ++ks) kb[ks] = *(const GAS bf16x8*)(kp + 16 * ks);
#pragma unroll
            for (int j = 0; j < 2; ++j) {
                f32x16 c;
#pragma unroll
                for (int i = 0; i < 16; ++i) c[i] = 0.f;
#pragma unroll
                for (int ks = 0; ks < 4; ++ks) c = __builtin_amdgcn_mfma_f32_32x32x16_bf16(qa[j][ks], kb[ks], c, 0, 0, 0);
                float s0 = 0.f, s1 = 0.f;
#pragma unroll
                for (int i = 0; i < 8; ++i) { s0 += wq[j][0][i] * fmaxf(c[i], 0.f); s1 += wq[j][1][i] * fmaxf(c[8 + i], 0.f); }
                sc[(4 * j + hb) * 4096 + 32 * kt + r] = s0; sc[(4 * j + hb + 2) * 4096 + 32 * kt + r] = s1;
            }
        }
    }
    __syncthreads();
    LAS float* row = sc + wave * 4096; LAS unsigned* rowu = (LAS unsigned*)row;
    LAS int* idxl = (LAS int*)(F.lds + IDX_OFF) + wave * 256;
    int nsel;
    if (L <= 256) { nsel = L; for (int i = lane; i < 256; i += 64) idxl[i] = (i < L) ? i : 0; }
    else {
        unsigned kmin = 0xffffffffu, kmax = 0u;
        for (int i = lane; i < L; i += 64) { unsigned u = rowu[i]; u = (u & 0x80000000u) ? ~u : (u | 0x80000000u); rowu[i] = u; kmin = u < kmin ? u : kmin; kmax = u > kmax ? u : kmax; }
#pragma unroll
        for (int o = 1; o < 64; o <<= 1) { const unsigned a = (unsigned)__shfl_xor((int)kmin, o), c2 = (unsigned)__shfl_xor((int)kmax, o); kmin = a < kmin ? a : kmin; kmax = c2 > kmax ? c2 : kmax; }
        LDS_WAIT(); asm volatile("" ::: "memory");
        unsigned lo = kmin, hi = kmax + 1u; int chi = 0;
        while (hi - lo > 1u) {
            const unsigned mid = lo + ((hi - lo) >> 1);
            int c = 0;
            for (int i = lane; i < L; i += 64) c += __popcll(__ballot(rowu[i] >= mid));
            if (c >= 256) { lo = mid; if (c == 256) { hi = mid; chi = 256; break; } } else { hi = mid; chi = c; }
        }
        const int need = 256 - chi; int base = 0, tdone = 0;
        for (int c0 = 0; c0 < L; c0 += 64) {
            const unsigned u = rowu[c0 + lane];
            const bool gt = u >= hi, eq = (u == lo) && !gt;
            const unsigned long long meq = __ballot(eq);
            const int eqrank = tdone + (int)__builtin_amdgcn_mbcnt_hi((unsigned)(meq >> 32), __builtin_amdgcn_mbcnt_lo((unsigned)meq, 0u));
            const bool sel = gt || (eq && eqrank < need);
            const unsigned long long msel = __ballot(sel);
            const int pos = base + (int)__builtin_amdgcn_mbcnt_hi((unsigned)(msel >> 32), __builtin_amdgcn_mbcnt_lo((unsigned)msel, 0u));
            if (sel && pos < 256) idxl[pos] = c0 + lane;
            base += __popcll(msel); tdone += __popcll(meq);
        }
        nsel = 256;
    }
    LDS_WAIT(); asm volatile("" ::: "memory");
    const int t = t0 + wave;
    {
        const v4u u = *(const GAS v4u*)(F.PROJ + (size_t)(b * SEQ + t) * PROJ_LD + lane * 8);
        LAS float* qd = row + 2048 + lane * 8;
        qd[0] = bflo(u.x); qd[1] = bfhi(u.x); qd[2] = bflo(u.y); qd[3] = bfhi(u.y); qd[4] = bflo(u.z); qd[5] = bfhi(u.z); qd[6] = bflo(u.w); qd[7] = bfhi(u.w);
    }
    LDS_WAIT(); asm volatile("" ::: "memory");
#pragma unroll 1
    for (int i = 0; i < 4; ++i) {
        const int p = lane + 64 * i; const bool valid = p < nsel; const int key = valid ? idxl[p] : 0;
        const GAS v4u* kp = (const GAS v4u*)(F.KA + (size_t)(b * SEQ + key) * 64);
        v4u kw[8];
#pragma unroll
        for (int c = 0; c < 8; ++c) kw[c] = kp[c];
#pragma unroll 1
        for (int hh = 0; hh < 8; ++hh) { float d = 0.f;
#pragma unroll
            for (int c = 0; c < 8; ++c) { const f32x4 q0 = *(const LAS f32x4*)(row + 2048 + hh * 64 + 8 * c), q1 = *(const LAS f32x4*)(row + 2048 + hh * 64 + 8 * c + 4); const v4u u = kw[c];
                d += bflo(u.x) * q0.x + bfhi(u.x) * q0.y + bflo(u.y) * q0.z + bfhi(u.y) * q0.w + bflo(u.z) * q1.x + bfhi(u.z) * q1.y + bflo(u.w) * q1.z + bfhi(u.w) * q1.w; }
            row[p * 8 + hh] = valid ? d : -INFINITY; }
    }
    LDS_WAIT(); asm volatile("" ::: "memory");
#pragma unroll 1
    for (int hh = 0; hh < 8; ++hh) {
        float l4[4];
#pragma unroll
        for (int i = 0; i < 4; ++i) l4[i] = row[(lane + 64 * i) * 8 + hh];
        const float m = wave_max(fmaxf(fmaxf(l4[0], l4[1]), fmaxf(l4[2], l4[3])));
        float e[4], s = 0.f;
#pragma unroll
        for (int i = 0; i < 4; ++i) { e[i] = __expf(l4[i] - m); s += e[i]; }
        const float inv = 1.0f / wave_sum(s);
#pragma unroll
        for (int i = 0; i < 4; ++i) row[(lane + 64 * i) * 8 + hh] = e[i] * inv;
    }
    LDS_WAIT(); asm volatile("" ::: "memory");
    float o[8];
#pragma unroll
    for (int hh = 0; hh < 8; ++hh) o[hh] = 0.f;
    const bf16* vbase = F.VA + (size_t)(b * SEQ) * 64 + lane;
#pragma unroll 4
    for (int p = 0; p < nsel; ++p) {
        const int key = idxl[p];
        const float v = bf2f(vbase[(size_t)key * 64]);
        const f32x4 p0 = *(const LAS f32x4*)(row + p * 8), p1 = *(const LAS f32x4*)(row + p * 8 + 4);
        o[0] += p0.x * v; o[1] += p0.y * v; o[2] += p0.z * v; o[3] += p0.w * v; o[4] += p1.x * v; o[5] += p1.y * v; o[6] += p1.z * v; o[7] += p1.w * v;
    }
    bf16* op = F.OA + (size_t)(b * SEQ + t) * 512 + lane;
#pragma unroll
    for (int hh = 0; hh < 8; ++hh) op[hh * 64] = (bf16)f2bf(o[hh]);
    __syncthreads();
}
__device__ __forceinline__ void p3_attention(Frame& F) {
#ifndef NO_SB
    for (int item = blockIdx.x; item < 256; item += F.G) sb_item(F, item);
#endif
#ifndef NO_DSA
    gu32* qh = F.ctl + CW_QUEUE;
    for (;;) {
        if (F.tid == 0) F.MISC[MI_Q] = __hip_atomic_fetch_add(qh, 1u, RLX_AGENT);
        __syncthreads();
        const int it = (int)F.MISC[MI_Q];
        if (it >= 2048) break;
        const int chunk = 63 - (it >> 5), within = it & 31, b = within >> 3, g8 = within & 7;
        dsa_item(F, b, chunk * 64 + g8 * 8);
    }
#endif
}

__device__ __forceinline__ void p6_router(Frame& F) {
    const int lane = F.lane, wave = F.wave, tid = F.tid;
    LAS float* scr = (LAS float*)(F.lds) + wave * (64 * 33);
    LAS float* red = (LAS float*)(F.lds + 8 * 64 * 33 * 4);
    LAS float* lgt = (LAS float*)(F.lds);
    LAS float* rrs = (LAS float*)(F.lds + 2 * 8 * 64 * 33 * 4);
    for (int tile = blockIdx.x; tile < NTOK / 64; tile += F.G) {
        const int tok0 = tile * 64;
        float acc[32];
#pragma unroll
        for (int e = 0; e < 32; ++e) acc[e] = 0.f;
        const int kw0 = wave * 128;
        for (int sub = 0; sub < 4; ++sub) {
            const int kb = kw0 + sub * 32;
#pragma unroll
            for (int i = 0; i < 8; ++i) { const int rr = 8 * i + (lane >> 3);
                const f32x4 v = *(const GAS f32x4*)(F.out + (size_t)(tok0 + rr) * DM + kb + 4 * (lane & 7));
                LAS float* d = scr + rr * 33 + 4 * (lane & 7); d[0] = v.x; d[1] = v.y; d[2] = v.z; d[3] = v.w; }
            LDS_WAIT(); asm volatile("" ::: "memory");
            for (int kk = 0; kk < 32; ++kk) {
                const float hg = scr[lane * 33 + kk] * F.g_ffn[kb + kk];
                const float* wrow = F.wr + (size_t)(kb + kk) * 32;
#pragma unroll
                for (int e = 0; e < 32; ++e) acc[e] += hg * wrow[e];
            }
            LDS_WAIT(); asm volatile("" ::: "memory");
        }
#pragma unroll
        for (int e = 0; e < 32; ++e) red[(wave * 64 + lane) * 33 + e] = acc[e];
        __syncthreads();
        { const int tok = tid & 63, eg = tid >> 6;
#pragma unroll
          for (int e4 = 0; e4 < 4; ++e4) { float s = 0.f;
#pragma unroll
              for (int w2 = 0; w2 < 8; ++w2) s += red[(w2 * 64 + tok) * 33 + 4 * eg + e4];
              lgt[tok * 33 + 4 * eg + e4] = s; } }
        __syncthreads();
        if (wave == 0) {
            const int tok = tok0 + lane;
            float ssq = 0.f;
#pragma unroll
            for (int i = 0; i < 16; ++i) ssq += F.SSQP[(size_t)tok * 16 + i];
            const float rr = 1.0f / sqrtf(ssq * (1.f / DM) + RMS_EPS);
            rrs[lane] = rr;
            float tv[4]; int te[4]; float pv = INFINITY; int pe = -1;
#pragma unroll
            for (int k = 0; k < 4; ++k) { float bv = -INFINITY; int be = 0x7fffffff;
#pragma unroll
                for (int e = 0; e < 32; ++e) { const float v = lgt[lane * 33 + e] * rr + F.br[e];
                    const bool after = (v < pv) || (v == pv && e > pe);
                    const bool better = (v > bv) || (v == bv && e < be);
                    if (after && better) { bv = v; be = e; } }
                tv[k] = bv; te[k] = be; pv = bv; pe = be; }
            float gs = 0.f, gk[4];
#pragma unroll
            for (int k = 0; k < 4; ++k) { gk[k] = __expf(tv[k] - tv[0]); gs += gk[k]; }
            const float ginv = 1.0f / gs;
            int mytotal = 0;
            for (int j = 0; j < 32; ++j) { int c = 0;
#pragma unroll
                for (int k = 0; k < 4; ++k) c += __popcll(__ballot(te[k] == j));
                if (lane == j) mytotal = c; }
            int mybase = 0;
            if (lane < 32 && mytotal > 0) mybase = (int)__hip_atomic_fetch_add(F.ctl + CW_CNT + lane, (unsigned)mytotal, RLX_AGENT);
            int pos[4] = {0, 0, 0, 0};
            for (int j = 0; j < 32; ++j) { const int bj = __shfl(mybase, j); int run = bj;
#pragma unroll
                for (int k = 0; k < 4; ++k) { const unsigned long long mk = __ballot(te[k] == j);
                    if (te[k] == j) pos[k] = run + (int)__builtin_amdgcn_mbcnt_hi((unsigned)(mk >> 32), __builtin_amdgcn_mbcnt_lo((unsigned)mk, 0u));
                    run += __popcll(mk); } }
#pragma unroll
            for (int k = 0; k < 4; ++k) { const int m = tok * 4 + k; F.TOKE[m] = te[k]; F.TOKG[m] = gk[k] * ginv; F.TOKP[m] = pos[k]; F.LIST[(size_t)te[k] * NTOK + pos[k]] = m; }
        }
        __syncthreads();
        for (int i = 0; i < 8; ++i) { const int tl = wave * 8 + i; const float rr = rrs[tl];
            const GAS f32x4* hr = (const GAS f32x4*)(F.out + (size_t)(tok0 + tl) * DM) + lane; const GAS f32x4* gr = (const GAS f32x4*)F.g_ffn + lane;
            GAS unsigned long long* o8 = (GAS unsigned long long*)(F.XN + (size_t)(tok0 + tl) * DM) + lane;
#pragma unroll
            for (int j = 0; j < 4; ++j) { const f32x4 v = hr[64 * j], g = gr[64 * j]; o8[64 * j] = (unsigned long long)pk2(v.x * rr * g.x, v.y * rr * g.y) | ((unsigned long long)pk2(v.z * rr * g.z, v.w * rr * g.w) << 32); } }
        __syncthreads();
    }
}
__device__ __forceinline__ void compute_ts(Frame& F) {
    if (F.tid < 32) F.MISC[MI_CNT + F.tid] = __hip_atomic_load(F.ctl + CW_CNT + F.tid, RLX_AGENT);
    __syncthreads();
    if (F.tid == 0) { unsigned run = 0; for (int e = 0; e < 32; ++e) { F.MISC[MI_TS + e] = run; run += (F.MISC[MI_CNT + e] + 255u) >> 8; } F.MISC[MI_TS + 32] = run; }
    __syncthreads();
}
__device__ __forceinline__ void p7_gather(Frame& F) {
    const int gw = blockIdx.x * NWAVES + F.wave, NGW = F.G * NWAVES; const int T = (int)F.MISC[MI_TS + 32];
    for (int r = gw; r < T * 256; r += NGW) {
        const int rt = r >> 8; int e = 0; while (e < 31 && (int)F.MISC[MI_TS + e + 1] <= rt) ++e;
        const int local = r - 256 * (int)F.MISC[MI_TS + e]; const bool valid = local < (int)F.MISC[MI_CNT + e];
        v4u a = {0u, 0u, 0u, 0u}, c = {0u, 0u, 0u, 0u};
        if (valid) { const int tok = F.LIST[(size_t)e * NTOK + local] >> 2; const GAS v4u* src = (const GAS v4u*)(F.XN + (size_t)tok * DM); a = src[F.lane]; c = src[64 + F.lane]; }
        GAS v4u* dst = (GAS v4u*)(F.XG + (size_t)r * DM); dst[F.lane] = a; dst[64 + F.lane] = c;
    }
}
__device__ __forceinline__ void p10_combine(Frame& F) {
    const int gw = blockIdx.x * NWAVES + F.wave, NGW = F.G * NWAVES;
    for (int tok = gw; tok < NTOK; tok += NGW) {
        float g[4]; const bf16* yr[4];
#pragma unroll
        for (int k = 0; k < 4; ++k) { const int m = tok * 4 + k; const int e = F.TOKE[m]; g[k] = F.TOKG[m]; yr[k] = F.Y + (size_t)(256 * (int)F.MISC[MI_TS + e] + F.TOKP[m]) * DM; }
        GAS f32x4* hr = (GAS f32x4*)(F.out + (size_t)tok * DM) + F.lane;
#pragma unroll
        for (int j = 0; j < 4; ++j) { f32x4 v = hr[64 * j];
#pragma unroll
            for (int k = 0; k < 4; ++k) { const unsigned long long y = *((const GAS unsigned long long*)yr[k] + 64 * j + F.lane); const unsigned ylo = (unsigned)y, yhi = (unsigned)(y >> 32);
                v.x += g[k] * bflo(ylo); v.y += g[k] * bfhi(ylo); v.z += g[k] * bflo(yhi); v.w += g[k] * bfhi(yhi); }
            hr[64 * j] = v; }
    }
}

struct Args { const float* in[15]; float* out; unsigned char* ws; int ph_lo, ph_hi; };
__global__ void __launch_bounds__(NWAVES * 64, 2) mk_fwd(Args args) {
    extern __shared__ __attribute__((aligned(16))) unsigned char lds[];
    Frame F;
    F.lds = (LAS unsigned char*)lds;
    F.MISC = (volatile LAS unsigned*)(F.lds + MISC_OFF);
    F.tid = threadIdx.x; F.lane = F.tid & 63; F.wave = __builtin_amdgcn_readfirstlane(F.tid >> 6);
    F.G = gridDim.x;
    unsigned char* ws = args.ws;
    F.ctl = (gu32*)(ws + WS_CTL);
    F.x = args.in[0]; F.g_mix = args.in[1]; F.w_in = args.in[2]; F.qg = args.in[3]; F.kg = args.in[4]; F.wpa = args.in[5]; F.wpb = args.in[6]; F.wout = args.in[7];
    F.g_ffn = args.in[8]; F.wr = args.in[9]; F.br = args.in[10]; F.wgu = args.in[11]; F.bgu = args.in[12]; F.wd = args.in[13]; F.bd = args.in[14]; F.out = args.out;
    F.WI = (bf16*)(ws + WS_WI); F.WPA = (bf16*)(ws + WS_WPA); F.WPB = (bf16*)(ws + WS_WPB); F.WO = (bf16*)(ws + WS_WO); F.WGU = (bf16*)(ws + WS_WGU); F.WD = (bf16*)(ws + WS_WD);
    F.XN = (bf16*)(ws + WS_XN); F.PROJ = (bf16*)(ws + WS_PROJ); F.KA = (bf16*)(ws + WS_KA); F.VA = (bf16*)(ws + WS_VA); F.KI = (bf16*)(ws + WS_KI);
    F.OA = (bf16*)(ws + WS_OA); F.OB = (bf16*)(ws + WS_OB); F.MERGED = (bf16*)(ws + WS_MERGED); F.XG = (bf16*)(ws + WS_XG); F.ACT = (bf16*)(ws + WS_ACT); F.Y = (bf16*)(ws + WS_Y);
    F.SMALLF = (float*)(ws + WS_SMALLF); F.WIQ = (float*)(ws + WS_WIQ); F.SSQP = (float*)(ws + WS_SSQP); F.TOKG = (float*)(ws + WS_TOKG);
    F.TOKE = (int*)(ws + WS_TOKE); F.TOKP = (int*)(ws + WS_TOKP); F.LIST = (int*)(ws + WS_LIST);
    for (int u = F.tid; u < (LDS_BYTES - LDSCTL_OFF) / 4; u += NWAVES * 64) ((LAS unsigned*)(F.lds + LDSCTL_OFF))[u] = 0u;
    __syncthreads();
    XcdBarrier bar; bar.bar = (unsigned*)(F.ctl + CW_BAR); bar.x = 0; bar.st = nullptr;
    if (N_LAUNCHES == 1) bar = xcd_barrier_post((unsigned*)(F.ctl + CW_BAR), F.MISC + MI_BAR);
    const int lo = args.ph_lo, hi = args.ph_hi;
#ifdef PHASE_ONLY
#define IN(k) ((k) == PHASE_ONLY && lo <= (k) && (k) < hi)
#else
#define IN(k) (lo <= (k) && (k) < hi)
#endif
#define SEAM(k) do { if (IN(k) && IN((k) + 1)) xcd_barrier(bar); } while (0)
    if (IN(0)) { p0_prologue(F); __syncthreads(); } SEAM(0);
    if (IN(1)) { pg8::Gemm g{F.XN, F.WI, NTOK, NPROJ_PAD, DM}; pg8::StaticOrder S; S.init(NTOK, NPROJ_PAD, F.G, (int)blockIdx.x);
        pg8::EpiProj E{F.PROJ, F.SMALLF}; pg8::gemm_phase<pg8::EpiProj, pg8::StaticOrder, true, true>(F.lds + RING_OFF, g, S, E); } SEAM(1);
    if (IN(2)) { p2_prep(F); } SEAM(2);
    if (IN(3)) { p3_attention(F); } SEAM(3);
    if (IN(4)) { pg8::StaticOrder S; S.init(NTOK, DM, F.G, (int)blockIdx.x);
        { pg8::Gemm g{F.OA, F.WPA, NTOK, DM, 512}; pg8::EpiGate<true> E{F.PROJ, 2560, F.MERGED}; pg8::gemm_phase<pg8::EpiGate<true>, pg8::StaticOrder, true, true>(F.lds + RING_OFF, g, S, E); }
        { pg8::Gemm g{F.OB, F.WPB, NTOK, DM, 512}; pg8::EpiGate<false> E{F.PROJ, 3584, F.MERGED}; pg8::gemm_phase<pg8::EpiGate<false>, pg8::StaticOrder, true, true>(F.lds + RING_OFF, g, S, E); } } SEAM(4);
    if (IN(5)) { pg8::Gemm g{F.MERGED, F.WO, NTOK, DM, DM}; pg8::StaticOrder S; S.init(NTOK, DM, F.G, (int)blockIdx.x);
        pg8::EpiOut E{F.x, F.out, F.SSQP}; pg8::gemm_phase<pg8::EpiOut, pg8::StaticOrder, true, true>(F.lds + RING_OFF, g, S, E); } SEAM(5);
    if (IN(6)) { p6_router(F); } SEAM(6);
    if (hi > 7) compute_ts(F);
    if (IN(7)) { p7_gather(F); } SEAM(7);
    if (IN(8)) { pg8::Gemm g{F.XG, F.WGU, 0, 2048, DM}; pg8::MoeOrder S; S.init((const volatile LAS int*)(F.MISC + MI_TS), 8, F.G, (int)blockIdx.x);
        pg8::EpiAct E{F.bgu, F.ACT}; pg8::gemm_phase<pg8::EpiAct, pg8::MoeOrder, true, true>(F.lds + RING_OFF, g, S, E); } SEAM(8);
    if (IN(9)) { pg8::Gemm g{F.ACT, F.WD, 0, DM, DM}; pg8::MoeOrder S; S.init((const volatile LAS int*)(F.MISC + MI_TS), 4, F.G, (int)blockIdx.x);
        pg8::EpiDown E{F.bd, F.Y}; pg8::gemm_phase<pg8::EpiDown, pg8::MoeOrder, true, true>(F.lds + RING_OFF, g, S, E); } SEAM(9);
    if (IN(10)) { p10_combine(F);
        if (N_LAUNCHES == 1) {
            const unsigned bad = __hip_atomic_load((gu32*)((unsigned*)(F.ctl + CW_BAR) + XB_TMO), RLX_AGENT);
            if (bad) { const float q = __builtin_nanf(""); for (size_t i = (size_t)blockIdx.x * 512 + F.tid; i < (size_t)NTOK * DM; i += (size_t)F.G * 512) F.out[i] = q; } } }
#undef IN
#undef SEAM
}

extern "C" void kernel_launch(void* const* d_in, const int* in_sizes, int n_in, void* d_out, int out_size, void* d_ws, size_t ws_size, hipStream_t stream) {
    static int grid = 0;
    if (grid == 0) {
        if (n_in != 15 || in_sizes[0] != NTOK * DM || out_size != NTOK * DM || ws_size < WS_END) { fprintf(stderr, "kernel_launch: unexpected shapes / workspace (n_in %d, in0 %d, out %d, ws %zu); nothing launched\n", n_in, n_in > 0 ? in_sizes[0] : -1, out_size, ws_size); grid = -1; return; }
        int dev = 0, cus = 0, per_cu = 0;
        if (hipGetDevice(&dev) != hipSuccess || hipDeviceGetAttribute(&cus, hipDeviceAttributeMultiprocessorCount, dev) != hipSuccess) { fprintf(stderr, "kernel_launch: device query failed\n"); grid = -1; return; }
        if (hipFuncSetAttribute((const void*)mk_fwd, hipFuncAttributeMaxDynamicSharedMemorySize, LDS_BYTES) != hipSuccess) { fprintf(stderr, "kernel_launch: hipFuncSetAttribute failed\n"); grid = -1; return; }
        if (hipOccupancyMaxActiveBlocksPerMultiprocessor(&per_cu, (const void*)mk_fwd, NWAVES * 64, LDS_BYTES) != hipSuccess || per_cu < 1) { fprintf(stderr, "kernel_launch: occupancy query says %d workgroups per CU; nothing launched\n", per_cu); (void)hipGetLastError(); grid = -1; return; }
        grid = cus;
    }
    if (grid < 0) return;
    if (hipMemsetAsync((char*)d_ws + WS_CTL, 0, CTL_ZERO_BYTES, stream) != hipSuccess) { fprintf(stderr, "kernel_launch: hipMemsetAsync failed\n"); return; }
    Args a{};
    for (int i = 0; i < 15; ++i) a.in[i] = (const float*)d_in[i];
    a.out = (float*)d_out; a.ws = (unsigned char*)d_ws;
    for (int li = 0; li < N_LAUNCHES; ++li) {
        a.ph_lo = (N_LAUNCHES == 1) ? 0 : li; a.ph_hi = (N_LAUNCHES == 1) ? N_PHASES : li + 1;
        hipLaunchKernelGGL(mk_fwd, dim3(grid), dim3(NWAVES * 64), LDS_BYTES, stream, a);
        const hipError_t le = hipPeekAtLastError();
        if (le != hipSuccess) { fprintf(stderr, "kernel_launch: launch %d failed: %s\n", li, hipGetErrorName(le)); break; }
    }
}
```

```cpp
#include <hip/hip_runtime.h>
#include <cstdio>
#include <cstdint>
namespace pg8 {
#define PG8_LAS __attribute__((address_space(3)))
typedef unsigned short bf16_t;
typedef short bf16x8 __attribute__((ext_vector_type(8)));
typedef float f32x4 __attribute__((ext_vector_type(4)));
typedef unsigned u32x4 __attribute__((ext_vector_type(4)));
constexpr int BM = 256, BK = 64, HALF = 128, HTB = HALF * BK * 2  , STAGE_BYTES = 8 * HTB, NXCD = 8, WGM = 8;

__host__ __device__ __forceinline__ int lds_byte(int r, int c) { const int st = (r >> 4) * 2 + (c >> 5), rr = r & 15, cc = c & 31, ob = rr * 64 + cc * 2; return st * 1024 + (ob ^ (((ob >> 9) & 1) << 5)); }
__host__ __device__ __forceinline__ void stage_rc(int b, int& R, int& C) { const int st = b / 1024, sb = b % 1024, swz = sb ^ (((sb >> 9) & 1) << 5); R = (st >> 1) * 16 + swz / 64; C = (st & 1) * 32 + (swz % 64) / 2; }
__host__ __device__ __forceinline__ int perm32(int rho) { const int n = rho >> 4, i = rho & 15; return 8 * (i >> 2) + 4 * n + (i & 3); }

struct Unit { int pm, pn, pb, e; };
struct Gemm { const bf16_t* A; const bf16_t* Bt; int M, N, K; };

struct StaticOrder {
    int nM, nN, nwg, G, c, lim;
    __host__ __device__ void init(int M, int N, int G_, int c_) { nM = M / BM; nN = N / BM; nwg = nM * nN; G = G_; c = c_; lim = nwg; }
    __host__ __device__ bool next(int i, Unit& u) const {
        const long L = (long)i * G + c; if (L >= lim) return false;
        int wgid = (int)L; { const int q = nwg / NXCD, r = nwg % NXCD, xcd = wgid % NXCD, off = wgid / NXCD; wgid = (xcd < r ? xcd * (q + 1) : r * (q + 1) + (xcd - r) * q) + off; }
        const int nig = WGM * nN, gid = wgid / nig, fm = gid * WGM, gsz = (nM - fm) < WGM ? (nM - fm) : WGM;
        u.pm = fm + ((wgid % nig) % gsz); u.pn = (wgid % nig) / gsz; u.pb = u.pn; u.e = 0; return true;
    }
    __device__ __forceinline__ void a_ready(const Unit&) const {}
    __device__ __forceinline__ void done(const Unit&) const {}
    __device__ __forceinline__ int tok(const Unit&, int) const { return 0; }
};


__device__ __forceinline__ unsigned cvt_pk_bf16(float lo, float hi) { unsigned r; asm volatile("v_cvt_pk_bf16_f32 %0, %1, %2" : "=v"(r) : "v"(lo), "v"(hi)); return r; }
__device__ __forceinline__ float bf_lo(unsigned w) { return __uint_as_float(w << 16); }
__device__ __forceinline__ float bf_hi(unsigned w) { return __uint_as_float(w & 0xffff0000u); }
__device__ __forceinline__ float sigmoidf_(float x) { return 1.0f / (1.0f + __expf(-x)); }
__device__ __forceinline__ u32x4 pack8(const f32x4& v0, const f32x4& v1) { u32x4 w; w.x = cvt_pk_bf16(v0[0], v0[1]); w.y = cvt_pk_bf16(v0[2], v0[3]); w.z = cvt_pk_bf16(v1[0], v1[1]); w.w = cvt_pk_bf16(v1[2], v1[3]); return w; }
__device__ __forceinline__ void unpack8(const u32x4& w, f32x4& v0, f32x4& v1) { v0 = (f32x4){bf_lo(w.x), bf_hi(w.x), bf_lo(w.y), bf_hi(w.y)}; v1 = (f32x4){bf_lo(w.z), bf_hi(w.z), bf_lo(w.w), bf_hi(w.w)}; }

struct EpiProj {
    static constexpr bool PERM = true, AFTER_DRAIN = false;
    bf16_t* PROJ; float* SMALLF;
    __device__ __forceinline__ void operator()(const f32x4 (&acc)[2][2][4][2], const Unit& u, int wr, int wc, int fr, int fq) const {
        const int row0 = u.pm * BM + wr * 64 + fr, cl = wc * 32 + 8 * fq;
        if (u.pn < 18) {
            const int mode = (u.pn >= 10) ? 2 : ((u.pn == 4 || u.pn == 5) ? 1 : 0);
#pragma unroll
            for (int ai = 0; ai < 2; ++ai)
#pragma unroll
                for (int m = 0; m < 4; ++m) { bf16_t* rowp = PROJ + (size_t)(row0 + ai * HALF + m * 16) * 4608 + u.pn * BM + cl;
#pragma unroll
                    for (int bj = 0; bj < 2; ++bj) { f32x4 v0 = acc[ai][bj][m][0], v1 = acc[ai][bj][m][1];
                        if (mode == 1) { v0 = v0 * 0.125f; v1 = v1 * 0.125f; }
                        else if (mode == 2) {
#pragma unroll
                            for (int j = 0; j < 4; ++j) { v0[j] = sigmoidf_(v0[j]); v1[j] = sigmoidf_(v1[j]); } }
                        *(u32x4*)(rowp + bj * HALF) = pack8(v0, v1); } }
        } else {
#pragma unroll
            for (int ai = 0; ai < 2; ++ai)
#pragma unroll
                for (int m = 0; m < 4; ++m) { float* rowp = SMALLF + (size_t)(row0 + ai * HALF + m * 16) * 256 + cl;
#pragma unroll
                    for (int bj = 0; bj < 2; ++bj) { *(f32x4*)(rowp + bj * HALF) = acc[ai][bj][m][0]; *(f32x4*)(rowp + bj * HALF + 4) = acc[ai][bj][m][1]; } }
        }
    }
};
template <bool FIRST> struct EpiGate {
    static constexpr bool PERM = true, AFTER_DRAIN = false;
    const bf16_t* PROJ; int goff; bf16_t* MERGED;
    __device__ __forceinline__ void operator()(const f32x4 (&acc)[2][2][4][2], const Unit& u, int wr, int wc, int fr, int fq) const {
        const int row0 = u.pm * BM + wr * 64 + fr, col0 = u.pn * BM + wc * 32 + 8 * fq;
#pragma unroll
        for (int ai = 0; ai < 2; ++ai)
#pragma unroll
            for (int m = 0; m < 4; ++m) { const size_t row = (size_t)(row0 + ai * HALF + m * 16);
#pragma unroll
                for (int bj = 0; bj < 2; ++bj) { const int col = col0 + bj * HALF;
                    const u32x4 gw = *(const u32x4*)(PROJ + row * 4608 + goff + col); f32x4 g0, g1; unpack8(gw, g0, g1);
                    f32x4 v0 = acc[ai][bj][m][0] * g0, v1 = acc[ai][bj][m][1] * g1;
                    bf16_t* mp = MERGED + row * 1024 + col;
                    if (!FIRST) { const u32x4 pw = *(const u32x4*)mp; f32x4 p0, p1; unpack8(pw, p0, p1); v0 = v0 + p0; v1 = v1 + p1; }
                    *(u32x4*)mp = pack8(v0, v1); } }
    }
};
struct EpiOut {
    static constexpr bool PERM = true, AFTER_DRAIN = false;
    const float* X; float* OUT; float* SSQP;
    __device__ __forceinline__ void operator()(const f32x4 (&acc)[2][2][4][2], const Unit& u, int wr, int wc, int fr, int fq) const {
        const int row0 = u.pm * BM + wr * 64 + fr, col0 = u.pn * BM + wc * 32 + 8 * fq;
#pragma unroll
        for (int ai = 0; ai < 2; ++ai)
#pragma unroll
            for (int m = 0; m < 4; ++m) { const size_t row = (size_t)(row0 + ai * HALF + m * 16); float s = 0.f;
#pragma unroll
                for (int bj = 0; bj < 2; ++bj) { const size_t off = row * 1024 + col0 + bj * HALF;
                    const f32x4 x0 = *(const f32x4*)(X + off), x1 = *(const f32x4*)(X + off + 4);
                    const f32x4 h0 = x0 + acc[ai][bj][m][0], h1 = x1 + acc[ai][bj][m][1];
                    *(f32x4*)(OUT + off) = h0; *(f32x4*)(OUT + off + 4) = h1;
                    s += (h0[0] * h0[0] + h0[1] * h0[1]) + (h0[2] * h0[2] + h0[3] * h0[3]) + (h1[0] * h1[0] + h1[1] * h1[1]) + (h1[2] * h1[2] + h1[3] * h1[3]); }
                s += __shfl_xor(s, 16); s += __shfl_xor(s, 32);
                if (fq == 0) SSQP[row * 16 + u.pn * 4 + wc] = s; }
    }
};
struct EpiAct {
    static constexpr bool PERM = true, AFTER_DRAIN = false;
    const float* BGU; unsigned char* ACT;
    __device__ __forceinline__ void operator()(const f32x4 (&acc)[2][2][4][2], const Unit& u, int wr, int wc, int fr, int fq) const {
        const int row0 = u.pm * BM + wr * 64 + fr, j0 = u.pn * HALF + wc * 32 + 8 * fq;
        const float* bg = BGU + (size_t)u.e * 2048 + j0;
        const f32x4 bg0 = *(const f32x4*)bg, bg1 = *(const f32x4*)(bg + 4), bu0 = *(const f32x4*)(bg + 1024), bu1 = *(const f32x4*)(bg + 1028);
#pragma unroll
        for (int ai = 0; ai < 2; ++ai)
#pragma unroll
            for (int m = 0; m < 4; ++m) { f32x4 o[2];
#pragma unroll
                for (int n = 0; n < 2; ++n) { const f32x4 g = acc[ai][0][m][n] + (n ? bg1 : bg0), up = acc[ai][1][m][n] + (n ? bu1 : bu0);
#pragma unroll
                    for (int j = 0; j < 4; ++j) { const float gc = fminf(g[j], 7.0f), uc = fminf(fmaxf(up[j], -7.0f), 7.0f); o[n][j] = (uc + 1.0f) * gc * sigmoidf_(1.702f * gc); } }
                int p0 = __builtin_amdgcn_cvt_pk_fp8_f32(o[0][0], o[0][1], 0, false); p0 = __builtin_amdgcn_cvt_pk_fp8_f32(o[0][2], o[0][3], p0, true);
                int p1 = __builtin_amdgcn_cvt_pk_fp8_f32(o[1][0], o[1][1], 0, false); p1 = __builtin_amdgcn_cvt_pk_fp8_f32(o[1][2], o[1][3], p1, true);
                typedef int i32x2 __attribute__((ext_vector_type(2)));
                *(i32x2*)(ACT + (size_t)(row0 + ai * HALF + m * 16) * 1024 + j0) = (i32x2){p0, p1}; }
    }
};
struct EpiDown {
    static constexpr bool PERM = true, AFTER_DRAIN = false;
    const float* BD; unsigned char* Y;
    __device__ __forceinline__ void operator()(const f32x4 (&acc)[2][2][4][2], const Unit& u, int wr, int wc, int fr, int fq) const {
        const int row0 = u.pm * BM + wr * 64 + fr, col0 = u.pn * BM + wc * 32 + 8 * fq;
        f32x4 bv[2][2];
#pragma unroll
        for (int bj = 0; bj < 2; ++bj)
#pragma unroll
            for (int n = 0; n < 2; ++n) bv[bj][n] = *(const f32x4*)(BD + (size_t)u.e * 1024 + col0 + bj * HALF + 4 * n);
#pragma unroll
        for (int ai = 0; ai < 2; ++ai)
#pragma unroll
            for (int m = 0; m < 4; ++m) { unsigned char* rowp = Y + (size_t)(row0 + ai * HALF + m * 16) * 1024 + col0;
#pragma unroll
                for (int bj = 0; bj < 2; ++bj) { const f32x4 v0 = acc[ai][bj][m][0] + bv[bj][0], v1 = acc[ai][bj][m][1] + bv[bj][1];
                    int p0 = __builtin_amdgcn_cvt_pk_fp8_f32(v0[0], v0[1], 0, false); p0 = __builtin_amdgcn_cvt_pk_fp8_f32(v0[2], v0[3], p0, true);
                    int p1 = __builtin_amdgcn_cvt_pk_fp8_f32(v1[0], v1[1], 0, false); p1 = __builtin_amdgcn_cvt_pk_fp8_f32(v1[2], v1[3], p1, true);
                    typedef int i32x2 __attribute__((ext_vector_type(2)));
                    *(i32x2*)(rowp + bj * HALF) = (i32x2){p0, p1}; } }
    }
};
struct MoeOrder {
    const volatile PG8_LAS int* ts; const volatile PG8_LAS int* cnt; const int* LIST; int T, nN, nwg, G, c;
    __device__ void init(const volatile PG8_LAS int* ts_, const volatile PG8_LAS int* cnt_, const int* LIST_, int nN_, int G_, int c_) { ts = ts_; cnt = cnt_; LIST = LIST_; T = ts_[32]; nN = nN_; nwg = T * nN_; G = G_; c = c_; }
    __device__ __forceinline__ int tok(const Unit& u, int r) const { const int pos = 256 * (u.pm - ts[u.e]) + r; return pos < cnt[u.e] ? (LIST[(size_t)u.e * 16384 + pos] >> 2) : 0; }
    __device__ bool next(int i, Unit& u) const {
        const long L = (long)i * G + c; if (L >= nwg) return false;
        int wgid = (int)L; { const int q = nwg / NXCD, r = nwg % NXCD, xcd = wgid % NXCD, off = wgid / NXCD; wgid = (xcd < r ? xcd * (q + 1) : r * (q + 1) + (xcd - r) * q) + off; }
        const int nig = WGM * nN, gid = wgid / nig, fm = gid * WGM, gsz = (T - fm) < WGM ? (T - fm) : WGM;
        u.pm = fm + ((wgid % nig) % gsz); u.pn = (wgid % nig) / gsz;
        int e = 0; while (e < 31 && ts[e + 1] <= u.pm) ++e;
        u.e = e; u.pb = e * nN + u.pn; return true;
    }
    __device__ __forceinline__ void a_ready(const Unit&) const {}
    __device__ __forceinline__ void done(const Unit&) const {}
};

typedef int v4i_t __attribute__((ext_vector_type(4))); typedef int v8i_t __attribute__((ext_vector_type(8)));
__device__ __forceinline__ v8i_t cat8(bf16x8 a, bf16x8 b) { const v4i_t x = __builtin_bit_cast(v4i_t, a), y = __builtin_bit_cast(v4i_t, b); return __builtin_shufflevector(x, y, 0, 1, 2, 3, 4, 5, 6, 7); }
__device__ __forceinline__ void mfma_f8(f32x4& acc, const v8i_t& wfrag, const v8i_t& afrag) {
    asm volatile("s_nop 1\n\tv_mfma_scale_f32_16x16x128_f8f6f4 %0, %1, %2, %0, %3, %4 op_sel_hi:[0,0,0]" : "+v"(acc) : "v"(wfrag), "v"(afrag), "v"(0x7a7a7a7a), "v"(0x7f7f7f7f));
}
template <class Epi, class Sched, bool ALIGN_EPI = false, bool SP2 = false, bool FP8 = false, bool GATHER = false>
__device__ __forceinline__ void gemm_phase(PG8_LAS unsigned char* lds, const Gemm g, const Sched& S, const Epi& E, const int wave_id) {
    unsigned ones_ = ~0u; asm volatile("" : "+v"(ones_));
    const int wid = wave_id, tid = (int)__builtin_amdgcn_mbcnt_hi(ones_, __builtin_amdgcn_mbcnt_lo(ones_, 0u)) + 64 * wave_id, lane = tid & 63, wr = wid >> 2, wc = wid & 3, fr = lane & 15, fq = lane >> 4;
    const int K = g.K, nt = K / BK;
    unsigned voffA[2], voffB[2]; int stR[2], stC[2];
#pragma unroll
    for (int i = 0; i < 2; ++i) { int R, C; stage_rc(tid * 16 + i * 8192, R, C); const int Rb = Epi::PERM ? ((R & ~31) + perm32(R & 31)) : R;
        voffA[i] = (unsigned)(R * K + C) * 2u; voffB[i] = (unsigned)(Rb * K + C) * 2u; stR[i] = R; stC[i] = C; }
    const size_t kstep = (size_t)(BK * 2);
    const size_t hstep = (size_t)HALF * K * 2;
    const size_t tstep = 2 * hstep;
    const unsigned ldsw = (unsigned)wid * 1024u;
    const int aoff = lds_byte(wr * 64 + fr, fq * 8), boff = lds_byte(wc * 32 + fr, fq * 8);
#define PG8_SA(b, h) (((b) * 2 + (h)) * HTB)
#define PG8_SB(b, h) ((4 + (b) * 2 + (h)) * HTB)
#define PG8_STAGE(bufoff, gbase, voff) do { _Pragma("unroll") for (int _i = 0; _i < 2; ++_i) \
        __builtin_amdgcn_global_load_lds((const unsigned*)((const char*)(gbase) + (voff)[_i]), (PG8_LAS unsigned*)(lds + (bufoff) + ldsw + _i * 8192), 16, 0, 0); } while (0)
#define PG8_LDA(dst, b, h) do { _Pragma("unroll") for (int m = 0; m < 4; ++m) { _Pragma("unroll") for (int k = 0; k < 2; ++k) dst[m][k] = *(const PG8_LAS bf16x8*)(lds + PG8_SA(b, h) + aoff + m * 2048 + k * 1024); if constexpr (FP8) dst##8[m] = cat8(dst[m][0], dst[m][1]); } } while (0)
#define PG8_LDB(dst, b, h) do { _Pragma("unroll") for (int n = 0; n < 2; ++n) { _Pragma("unroll") for (int k = 0; k < 2; ++k) dst[n][k] = *(const PG8_LAS bf16x8*)(lds + PG8_SB(b, h) + boff + n * 2048 + k * 1024); if constexpr (FP8) dst##8[n] = cat8(dst[n][0], dst[n][1]); } } while (0)
#define PG8_MMA(ai, bj, At, Bt) do { __builtin_amdgcn_s_setprio(1); _Pragma("unroll") for (int m = 0; m < 4; ++m) _Pragma("unroll") for (int n = 0; n < 2; ++n) { \
        if constexpr (FP8) { mfma_f8(acc[ai][bj][m][n], Bt##8[n], At##8[m]); } \
        else { _Pragma("unroll") for (int k = 0; k < 2; ++k) acc[ai][bj][m][n] = __builtin_amdgcn_mfma_f32_16x16x32_bf16(Bt[n][k], At[m][k], acc[ai][bj][m][n], 0, 0, 0); } } \
        __builtin_amdgcn_s_setprio(0); } while (0)
#define PG8_WAIT_V(n) asm volatile("s_waitcnt vmcnt(" #n ")" ::: "memory")
#define PG8_WAIT_L(n) asm volatile("s_waitcnt lgkmcnt(" #n ")" ::: "memory")
#define PG8_BAR __builtin_amdgcn_s_barrier()
#define PG8_SCHED __builtin_amdgcn_sched_barrier(0)
    Unit cur, nxt; int ui = 0;
    if (!S.next(0, cur)) return;
    f32x4 acc[2][2][4][2];
#pragma unroll
    for (int a = 0; a < 2; ++a)
#pragma unroll
        for (int b = 0; b < 2; ++b)
#pragma unroll
            for (int m = 0; m < 4; ++m)
#pragma unroll
                for (int n = 0; n < 2; ++n) acc[a][b][m][n] = (f32x4){0.f, 0.f, 0.f, 0.f};
    bf16x8 At[4][2], B0[2][2], B1[2][2]; v8i_t At8[4], B08[2], B18[2];
    const char* cA = GATHER ? (const char*)g.A : (const char*)g.A + (size_t)cur.pm * tstep; const char* cB = (const char*)g.Bt + (size_t)cur.pb * tstep;
    unsigned vC[2][2], vN[2][2];
#define PG8_GROWS(V, u_) do { _Pragma("unroll") for (int h_ = 0; h_ < 2; ++h_) _Pragma("unroll") for (int i_ = 0; i_ < 2; ++i_) V[h_][i_] = (unsigned)S.tok(u_, 128 * h_ + stR[i_]) * (unsigned)(K * 2) + (unsigned)stC[i_] * 2u; } while (0)
    if constexpr (GATHER) { PG8_GROWS(vC, cur); }
    else {
#pragma unroll
        for (int h_ = 0; h_ < 2; ++h_)
#pragma unroll
            for (int i_ = 0; i_ < 2; ++i_) vC[h_][i_] = voffA[i_] + (unsigned)(h_ * hstep); }
#pragma unroll
    for (int h_ = 0; h_ < 2; ++h_)
#pragma unroll
        for (int i_ = 0; i_ < 2; ++i_) vN[h_][i_] = vC[h_][i_];
    S.a_ready(cur);
    if constexpr (SP2) {
        PG8_STAGE(PG8_SB(0, 0), cB, voffB); PG8_STAGE(PG8_SB(0, 1), cB + hstep, voffB); PG8_STAGE(PG8_SA(0, 0), cA, vC[0]); PG8_STAGE(PG8_SA(0, 1), cA, vC[1]);
        if (wr == 1) PG8_BAR;
        PG8_WAIT_V(2); PG8_BAR;
        PG8_STAGE(PG8_SB(1, 0), cB + kstep, voffB); PG8_STAGE(PG8_SA(1, 0), cA + kstep, vC[0]); PG8_STAGE(PG8_SB(1, 1), cB + hstep + kstep, voffB);
        PG8_WAIT_V(6); PG8_BAR;
    } else {
        PG8_STAGE(PG8_SB(0, 0), cB, voffB); PG8_STAGE(PG8_SA(0, 0), cA, vC[0]); PG8_STAGE(PG8_SB(0, 1), cB + hstep, voffB); PG8_STAGE(PG8_SA(0, 1), cA, vC[1]);
        if (wr == 1) PG8_BAR;
        PG8_WAIT_V(4); PG8_BAR;
        PG8_STAGE(PG8_SB(1, 0), cB + kstep, voffB); PG8_STAGE(PG8_SA(1, 0), cA + kstep, vC[0]); PG8_STAGE(PG8_SB(1, 1), cB + hstep + kstep, voffB);
        PG8_WAIT_V(6); PG8_BAR;
    }
    for (;;) {
        const bool has_next = S.next(ui + 1, nxt);
        if constexpr (GATHER) { if (has_next) { PG8_GROWS(vN, nxt); } }
        const char* nA = has_next ? (GATHER ? (const char*)g.A : (const char*)g.A + (size_t)nxt.pm * tstep) : cA; const char* nB = has_next ? (const char*)g.Bt + (size_t)nxt.pb * tstep : cB;
        for (int t = 0; t < nt; t += 2) {
            const bool last = (t == nt - 2);
            const char* a1 = cA + (size_t)(t + 1) * kstep;
            const char* a2 = last ? nA : cA + (size_t)(t + 2) * kstep; const char* b2 = last ? nB : cB + (size_t)(t + 2) * kstep;
            const char* a3 = a2 + kstep; const char* b3 = b2 + kstep;
            unsigned vS[2][2];
#pragma unroll
            for (int h_ = 0; h_ < 2; ++h_)
#pragma unroll
                for (int i_ = 0; i_ < 2; ++i_) vS[h_][i_] = (GATHER && last) ? vN[h_][i_] : vC[h_][i_];
            if (last && has_next) S.a_ready(nxt);
            if constexpr (SP2) {
            PG8_LDB(B0, 0, 0); PG8_LDB(B1, 0, 1); PG8_SCHED; PG8_LDA(At, 0, 0); PG8_STAGE(PG8_SA(1, 1), a1, vC[1]);
            PG8_WAIT_V(8); PG8_WAIT_L(0); PG8_BAR; PG8_MMA(0, 0, At, B0); PG8_MMA(0, 1, At, B1); PG8_BAR; PG8_SCHED;
            PG8_LDA(At, 0, 1); PG8_STAGE(PG8_SB(0, 0), b2, voffB); PG8_STAGE(PG8_SB(0, 1), b2 + hstep, voffB); PG8_STAGE(PG8_SA(0, 0), a2, vS[0]);
            PG8_WAIT_V(8); PG8_WAIT_L(0); PG8_BAR; PG8_MMA(1, 0, At, B0); PG8_MMA(1, 1, At, B1); PG8_BAR; PG8_SCHED;
            PG8_LDB(B0, 1, 0); PG8_LDB(B1, 1, 1); PG8_SCHED; PG8_LDA(At, 1, 0); PG8_STAGE(PG8_SA(0, 1), a2, vS[1]);
            PG8_WAIT_V(8); PG8_WAIT_L(0); PG8_BAR; PG8_MMA(0, 0, At, B0); PG8_MMA(0, 1, At, B1); PG8_BAR; PG8_SCHED;
            PG8_LDA(At, 1, 1); PG8_STAGE(PG8_SB(1, 0), b3, voffB); PG8_STAGE(PG8_SB(1, 1), b3 + hstep, voffB); PG8_STAGE(PG8_SA(1, 0), a3, vS[0]);
            PG8_WAIT_V(8); PG8_WAIT_L(0); PG8_BAR; PG8_MMA(1, 0, At, B0); PG8_MMA(1, 1, At, B1); PG8_BAR; PG8_SCHED;
            } else {
            PG8_LDB(B0, 0, 0); PG8_SCHED; PG8_LDA(At, 0, 0); PG8_STAGE(PG8_SA(1, 1), a1, vC[1]);
            PG8_WAIT_L(8); PG8_BAR; PG8_WAIT_L(0); PG8_MMA(0, 0, At, B0); PG8_BAR; PG8_SCHED;
            PG8_LDB(B1, 0, 1); PG8_STAGE(PG8_SB(0, 0), b2, voffB);
            PG8_BAR; PG8_WAIT_L(0); PG8_MMA(0, 1, At, B1); PG8_BAR;
            PG8_LDA(At, 0, 1); PG8_STAGE(PG8_SA(0, 0), a2, vS[0]);
            PG8_BAR; PG8_WAIT_L(0); PG8_MMA(1, 0, At, B0); PG8_BAR; PG8_SCHED;
            PG8_STAGE(PG8_SB(0, 1), b2 + hstep, voffB);
            PG8_WAIT_V(6); PG8_BAR; PG8_MMA(1, 1, At, B1); PG8_BAR;
            PG8_LDB(B0, 1, 0); PG8_SCHED; PG8_LDA(At, 1, 0); PG8_STAGE(PG8_SA(0, 1), a2, vS[1]);
            PG8_WAIT_L(8); PG8_BAR; PG8_WAIT_L(0); PG8_MMA(0, 0, At, B0); PG8_BAR; PG8_SCHED;
            PG8_LDB(B1, 1, 1); PG8_STAGE(PG8_SB(1, 0), b3, voffB);
            PG8_BAR; PG8_WAIT_L(0); PG8_MMA(0, 1, At, B1); PG8_BAR;
            PG8_LDA(At, 1, 1); PG8_STAGE(PG8_SA(1, 0), a3, vS[0]);
            PG8_BAR; PG8_WAIT_L(0); PG8_MMA(1, 0, At, B0); PG8_BAR; PG8_SCHED;
            PG8_STAGE(PG8_SB(1, 1), b3 + hstep, voffB);
            PG8_WAIT_V(6); PG8_BAR; PG8_MMA(1, 1, At, B1); PG8_BAR;
            }
        }
        if constexpr (FP8) asm volatile("s_nop 15\n\ts_nop 15" ::: "memory");
        if constexpr (ALIGN_EPI) { if (wr == 0) PG8_BAR; }
        if constexpr (!Epi::AFTER_DRAIN) { E(acc, cur, wr, wc, fr, fq); S.done(cur); }
        if (!has_next) break;
#pragma unroll
        for (int a = 0; a < 2; ++a)
#pragma unroll
            for (int b = 0; b < 2; ++b)
#pragma unroll
                for (int m = 0; m < 4; ++m)
#pragma unroll
                    for (int n = 0; n < 2; ++n) acc[a][b][m][n] = (f32x4){0.f, 0.f, 0.f, 0.f};
        cur = nxt; cA = nA; cB = nB; ++ui;
        if constexpr (GATHER) {
#pragma unroll
            for (int h_ = 0; h_ < 2; ++h_)
#pragma unroll
                for (int i_ = 0; i_ < 2; ++i_) vC[h_][i_] = vN[h_][i_]; }
        if constexpr (ALIGN_EPI) { if (wr == 1) PG8_BAR; }
    }
    PG8_WAIT_V(0);
    if constexpr (!ALIGN_EPI) { if (wr == 0) PG8_BAR; }
    PG8_BAR;
    if constexpr (Epi::AFTER_DRAIN) { E.fused(acc, cur, wr, wc, fr, fq, lds, wid, lane); S.done(cur); }
#undef PG8_GROWS
#undef PG8_SA
#undef PG8_SB
#undef PG8_STAGE
#undef PG8_LDA
#undef PG8_LDB
#undef PG8_MMA
#undef PG8_WAIT_V
#undef PG8_WAIT_L
#undef PG8_BAR
#undef PG8_SCHED
}
}

constexpr int NWAVES = 8;
#ifndef MK_N_LAUNCHES
#define MK_N_LAUNCHES 1
#endif
constexpr int N_PHASES = 11;
constexpr int N_LAUNCHES = MK_N_LAUNCHES;

constexpr int NB = 4, SEQ = 4096, DM = 1024, NTOK = NB * SEQ;
constexpr int NPROJ = 4808, NPROJ_PAD = 4864, PROJ_LD = 4608;
constexpr int NEXP = 32, MAXTILES = 288;
constexpr float RMS_EPS = 1e-6f;

constexpr size_t MiB = 1u << 20;
constexpr size_t WS_CTL = 0, CTL_ZERO_BYTES = 1 * MiB;
constexpr size_t WS_WI = 2 * MiB, WS_WPA = 12 * MiB, WS_WPB = 13 * MiB, WS_WO = 14 * MiB, WS_WGU = 16 * MiB, WS_WD = 144 * MiB;
constexpr size_t WS_XN = 208 * MiB, WS_PROJ = 240 * MiB, WS_SMALLF = 384 * MiB, WS_KA = 400 * MiB, WS_VA = 402 * MiB, WS_KI = 404 * MiB, WS_WIQ = 406 * MiB;
constexpr size_t WS_OA = 408 * MiB, WS_OB = 424 * MiB, WS_MERGED = 440 * MiB, WS_SSQP = 472 * MiB;
constexpr size_t WS_TOKE = 473 * MiB, WS_TOKG = WS_TOKE + 256 * 1024, WS_TOKP = WS_TOKG + 256 * 1024, WS_LIST = 474 * MiB;
constexpr size_t WS_WRG = 478 * MiB;
constexpr size_t WS_ROPE = 479 * MiB;
constexpr size_t WS_XG = 480 * MiB, WS_ACT = 624 * MiB, WS_Y = 768 * MiB, WS_END = 912 * MiB;
constexpr int CW_TMO = 0, CW_CODE = 1;
constexpr int CW_BAR = 4096;
constexpr int CW_CNT = 8192;
constexpr int CW_QUEUE = 8448;
constexpr int RING_OFF = 0, RING_BYTES = 131072;
constexpr int IDX_OFF = 131072;
constexpr int HIST_OFF = 139264;
constexpr int LDSCTL_OFF = 155648, MISC_OFF = LDSCTL_OFF + 320;
constexpr int LDS_BYTES = 159744;
constexpr int MI_BAR = 8, MI_TS = 16  , MI_CNT = 64  , MI_Q = 100, MI_STAMP = 104  ;

#define GAS __attribute__((address_space(1)))
#define LAS __attribute__((address_space(3)))
typedef unsigned short bf16;
typedef unsigned v4u __attribute__((ext_vector_type(4)));
typedef float f32x4 __attribute__((ext_vector_type(4)));
typedef short bf16x8 __attribute__((ext_vector_type(8)));
typedef GAS unsigned gu32;
typedef GAS unsigned long long gu64;
#define RLX_AGENT __ATOMIC_RELAXED, __HIP_MEMORY_SCOPE_AGENT
#define LDS_WAIT() asm volatile("s_waitcnt lgkmcnt(0)" ::: "memory")
#define VM_WAIT() asm volatile("s_waitcnt vmcnt(0)" ::: "memory")
__device__ __forceinline__ unsigned long long rt() { return __builtin_amdgcn_s_memrealtime(); }
__device__ __forceinline__ unsigned f2bf(float f) { unsigned u = __builtin_bit_cast(unsigned, f); return (u + 0x7fffu + ((u >> 16) & 1u)) >> 16; }
__device__ __forceinline__ unsigned pk2(float lo, float hi) { return f2bf(lo) | (f2bf(hi) << 16); }

#define XB_TMO      128
#define XB_XCNT(j)  (256  + 64 * (j))
#define XB_XSUB(j)  (1280 + 64 * (j))
#define XB_XGEN(j)  (2304 + 64 * (j))
#define XB_TOP      3328
#define XB_TOPGEN   3392
#define XCD_BAR_WORDS 3456
#define XB_SPIN_CAP (1u << 18)

__device__ __forceinline__ unsigned xb_ld(unsigned* p)              { return __hip_atomic_load(p, __ATOMIC_RELAXED, __HIP_MEMORY_SCOPE_AGENT); }
__device__ __forceinline__ unsigned xb_add(unsigned* p, unsigned v) { return __hip_atomic_fetch_add(p, v, __ATOMIC_RELAXED, __HIP_MEMORY_SCOPE_AGENT); }
__device__ __forceinline__ unsigned xb_xcc_id() { return (unsigned)__builtin_amdgcn_s_getreg((3 << 11) | 20) & 0xFu; }
#define XB_SPIN(cond, bar) do { unsigned _sp = 0; while (cond) { __builtin_amdgcn_s_sleep(1); \
    if ((++_sp & 255u) == 0u) { if (xb_ld(&(bar)[XB_TMO])) break; if (_sp > XB_SPIN_CAP) { atomicAdd(&(bar)[XB_TMO], 1u); break; } } } } while (0)

struct XcdBarrier {
    unsigned* bar; unsigned x;
    volatile LAS unsigned* st;
};

__device__ __forceinline__ XcdBarrier xcd_barrier_post(unsigned* bar, volatile LAS unsigned* st) {
    XcdBarrier b; b.bar = bar; b.x = xb_xcc_id(); b.st = st;
    if (threadIdx.x == 0) (void)xb_add(&bar[XB_XCNT(b.x)], 1u);
    return b;
}
__device__ __forceinline__ void xcd_barrier_complete(unsigned* bar, unsigned x, unsigned& nloc, unsigned& nx) {
    const unsigned G = gridDim.x * gridDim.y * gridDim.z;
    unsigned sum, cnt, mine, sp = 0u;
    for (;;) {
        sum = 0u; cnt = 0u; mine = 0u;
#pragma unroll
        for (unsigned j = 0; j < 16; ++j) { const unsigned c = xb_ld(&bar[XB_XCNT(j)]); sum += c; cnt += (c > 0u) ? 1u : 0u; mine = (j == x) ? c : mine; }
        if (sum == G) break;
        __builtin_amdgcn_s_sleep(1);
        if ((++sp & 255u) == 0u) { if (xb_ld(&bar[XB_TMO])) break; if (sp > XB_SPIN_CAP) { atomicAdd(&bar[XB_TMO], 1u); break; } }
    }
    nloc = mine > 0u ? mine : 1u; nx = cnt > 0u ? cnt : 1u;
}

__device__ __forceinline__ void xcd_barrier(const XcdBarrier& b, const bool lead  ) {
    asm volatile("s_waitcnt vmcnt(0)" ::: "memory");
    __syncthreads();
    if (lead) {
        unsigned* bar = b.bar;
        __builtin_amdgcn_s_waitcnt(0);
        unsigned nloc = b.st[0], nx = b.st[1];
        if (nloc == 0u) { xcd_barrier_complete(bar, b.x, nloc, nx); b.st[0] = nloc; b.st[1] = nx; }
        const unsigned old = xb_add(&bar[XB_XSUB(b.x)], 1u);
        const unsigned gen = old / nloc;
        if (old + 1u == (gen + 1u) * nloc) {
            __builtin_amdgcn_fence(__ATOMIC_RELEASE, "agent");
            asm volatile("s_waitcnt vmcnt(0)" ::: "memory");
            const unsigned og = xb_add(&bar[XB_TOP], 1u);
            const unsigned tg = og / nx;
            if (og + 1u == (tg + 1u) * nx) xb_add(&bar[XB_TOPGEN], 1u);
            else XB_SPIN(xb_ld(&bar[XB_TOPGEN]) == tg, bar);
            __builtin_amdgcn_fence(__ATOMIC_ACQUIRE, "agent");
            xb_add(&bar[XB_XGEN(b.x)], 1u);
            asm volatile("s_waitcnt vmcnt(0)" ::: "memory");
        } else {
            XB_SPIN(xb_ld(&bar[XB_XGEN(b.x)]) == gen, bar);
            __builtin_amdgcn_fence(__ATOMIC_ACQUIRE, "agent");
            asm volatile("s_waitcnt vmcnt(0)" ::: "memory");
        }
    }
    __syncthreads();
}


__device__ __forceinline__ float bf2f(unsigned short b) { return __uint_as_float((unsigned)b << 16); }
__device__ __forceinline__ float bflo(unsigned w) { return __uint_as_float(w << 16); }
__device__ __forceinline__ float bfhi(unsigned w) { return __uint_as_float(w & 0xffff0000u); }

struct Args { const float* in[15]; float* out; unsigned char* ws; int ph_lo, ph_hi, rep, pad; };
struct Frame {
    const Args* a;
    LAS unsigned char* lds;
    volatile LAS unsigned* MISC;
    gu32* ctl;
    int tid, lane, wave;
    int G;
};
#define WSP(T, off) ((T*)((F.a->ws) + (off)))
#define F_WI WSP(bf16, WS_WI)
#define F_WPA WSP(bf16, WS_WPA)
#define F_WPB WSP(bf16, WS_WPB)
#define F_WO WSP(bf16, WS_WO)
#define F_WGU WSP(bf16, WS_WGU)
#define F_WD WSP(bf16, WS_WD)
#define F_XN WSP(bf16, WS_XN)
#define F_PROJ WSP(bf16, WS_PROJ)
#define F_KA WSP(bf16, WS_KA)
#define F_VA WSP(bf16, WS_VA)
#define F_KI WSP(bf16, WS_KI)
#define F_OA WSP(bf16, WS_OA)
#define F_OB WSP(bf16, WS_OB)
#define F_MERGED WSP(bf16, WS_MERGED)
#define F_XG WSP(bf16, WS_XG)
#define F_ACT WSP(bf16, WS_ACT)
#define F_Y WSP(bf16, WS_Y)
#define F_SMALLF WSP(float, WS_SMALLF)
#define F_WIQ WSP(float, WS_WIQ)
#define F_SSQP WSP(float, WS_SSQP)
#define F_TOKG WSP(float, WS_TOKG)
#define F_TOKE WSP(int, WS_TOKE)
#define F_TOKP WSP(int, WS_TOKP)
#define F_LIST WSP(int, WS_LIST)
#define F_WRG WSP(float, WS_WRG)
#define F_ROPE WSP(float, WS_ROPE)

__device__ __forceinline__ int fresh_lane() { unsigned ones_ = ~0u; asm volatile("" : "+v"(ones_)); return (int)__builtin_amdgcn_mbcnt_hi(ones_, __builtin_amdgcn_mbcnt_lo(ones_, 0u)); }
__device__ __forceinline__ float wave_sum(float v) {
#pragma unroll
    for (int o = 1; o < 64; o <<= 1) v += __shfl_xor(v, o);
    return v;
}
__device__ __forceinline__ float wave_max(float v) {
#pragma unroll
    for (int o = 1; o < 64; o <<= 1) v = fmaxf(v, __shfl_xor(v, o));
    return v;
}

__device__ __forceinline__ int wi_rowmap(int n) {
    if (n < 512) return n;
    if (n < 576) return 4608 + (n - 512);
    if (n < 640) return 4672 + (n - 576);
    if (n < 1152) return 512 + (n - 640);
    if (n < 1216) return 4736 + (n - 1152);
    if (n < 1224) return 4800 + (n - 1216);
    if (n < 1736) return 1024 + (n - 1224);
    if (n < 2248) return 1536 + (n - 1736);
    if (n < 2760) return 2048 + (n - 2248);
    if (n < 3784) return 2560 + (n - 2760);
    return 3584 + (n - 3784);
}
template <int MAP> __device__ __forceinline__ void transpose_item(const float* W, int K, int N, bf16* WT, int row_base, LAS float* scr, int item, int lane) {
    const int nblk = (N + 31) / 32, kb = item / nblk, nb = item % nblk, k0 = 64 * kb, n0 = 32 * nb;
    const int nsrc = n0 + (lane & 31); const bool ok = nsrc < N; const int ncl = ok ? nsrc : 0;
#pragma unroll 8
    for (int i = 0; i < 32; ++i) { const int kk = 2 * i + (lane >> 5); const float v = W[(size_t)(k0 + kk) * N + ncl]; scr[kk * 33 + (lane & 31)] = v; }
    LDS_WAIT(); asm volatile("" ::: "memory");
    const int c = lane & 7;
#pragma unroll
    for (int j = 0; j < 4; ++j) { const int nl = (lane >> 3) + 8 * j, n = n0 + nl; const LAS float* s = scr + (8 * c) * 33 + nl;
        if (n < N) { int dr;
            if (MAP == 0) dr = n; else if (MAP == 1) dr = wi_rowmap(n); else { const int jj = n & 1023; dr = 256 * (jj >> 7) + 128 * (n >> 10) + (jj & 127); }
            v4u o; o.x = pk2(s[0 * 33], s[1 * 33]); o.y = pk2(s[2 * 33], s[3 * 33]); o.z = pk2(s[4 * 33], s[5 * 33]); o.w = pk2(s[6 * 33], s[7 * 33]);
            *(GAS v4u*)(WT + (size_t)(row_base + dr) * K + k0 + 8 * c) = o; } }
    LDS_WAIT(); asm volatile("" ::: "memory");
}
template <int MAP> __device__ __forceinline__ void transpose_item_f8(const float* W, int K, int N, unsigned char* WT, int row_base, LAS float* scr, int item, int lane, float scale) {
    const int nblk = (N + 31) / 32, kb = item / nblk, nb = item % nblk, k0 = 64 * kb, n0 = 32 * nb;
    const int nsrc = n0 + (lane & 31); const bool ok = nsrc < N; const int ncl = ok ? nsrc : 0;
#pragma unroll 8
    for (int i = 0; i < 32; ++i) { const int kk = 2 * i + (lane >> 5); const float v = W[(size_t)(k0 + kk) * N + ncl]; scr[kk * 33 + (lane & 31)] = v; }
    LDS_WAIT(); asm volatile("" ::: "memory");
    const int c = lane & 7;
#pragma unroll
    for (int j = 0; j < 4; ++j) { const int nl = (lane >> 3) + 8 * j, n = n0 + nl; const LAS float* s = scr + (8 * c) * 33 + nl;
        if (n < N) { int dr;
            if (MAP == 0) dr = n; else { const int jj = n & 1023; dr = 256 * (jj >> 7) + 128 * (n >> 10) + (jj & 127); }
            int lo = __builtin_amdgcn_cvt_pk_fp8_f32(s[0 * 33] * scale, s[1 * 33] * scale, 0, false); lo = __builtin_amdgcn_cvt_pk_fp8_f32(s[2 * 33] * scale, s[3 * 33] * scale, lo, true);
            int hi = __builtin_amdgcn_cvt_pk_fp8_f32(s[4 * 33] * scale, s[5 * 33] * scale, 0, false); hi = __builtin_amdgcn_cvt_pk_fp8_f32(s[6 * 33] * scale, s[7 * 33] * scale, hi, true);
            typedef int i32x2 __attribute__((ext_vector_type(2)));
            *(GAS i32x2*)(WT + (size_t)(row_base + dr) * K + k0 + 8 * c) = (i32x2){lo, hi}; } }
    LDS_WAIT(); asm volatile("" ::: "memory");
}
template <int MAP> __device__ __forceinline__ void convert_item_f8(const float* W, int K, int N, unsigned char* WT, int row_base, LAS unsigned char* tile, int item, int lane, float scale) {
    const int nblk = N / 64, kb = item / nblk, nb = item % nblk, k0 = 128 * kb, n0 = 64 * nb, ng = lane & 15, ko = lane >> 4;
    const float* src = W + (size_t)(k0 + 8 * ko) * N + n0 + 4 * ng;
    typedef int i32x2 __attribute__((ext_vector_type(2)));
#pragma unroll
    for (int q = 0; q < 4; ++q) {
        f32x4 v[8];
#pragma unroll
        for (int k = 0; k < 8; ++k) v[k] = *(const GAS f32x4*)(src + (size_t)(32 * q + k) * N);
#pragma unroll
        for (int j = 0; j < 4; ++j) {
            int lo = __builtin_amdgcn_cvt_pk_fp8_f32(v[0][j] * scale, v[1][j] * scale, 0, false); lo = __builtin_amdgcn_cvt_pk_fp8_f32(v[2][j] * scale, v[3][j] * scale, lo, true);
            int hi = __builtin_amdgcn_cvt_pk_fp8_f32(v[4][j] * scale, v[5][j] * scale, 0, false); hi = __builtin_amdgcn_cvt_pk_fp8_f32(v[6][j] * scale, v[7][j] * scale, hi, true);
            *(LAS i32x2*)(tile + (4 * ng + j) * 144 + 32 * q + 8 * ko) = (i32x2){lo, hi}; }
    }
    LDS_WAIT(); asm volatile("" ::: "memory");
#pragma unroll
    for (int i = 0; i < 8; ++i) { const int rl = (lane >> 3) + 8 * i, n = n0 + rl; int dr; if (MAP == 0) dr = n; else { const int jj = n & 1023; dr = 256 * (jj >> 7) + 128 * (n >> 10) + (jj & 127); }
        const v4u w = *(const LAS v4u*)(tile + rl * 144 + 16 * (lane & 7));
        *(GAS v4u*)(WT + (size_t)(row_base + dr) * K + k0 + 16 * (lane & 7)) = w; }
    LDS_WAIT(); asm volatile("" ::: "memory");
}
template <int MAP> __device__ __forceinline__ void convert_stream_f8(const float* Wall, int N, int items_per_e, unsigned char* WT, LAS unsigned char* tile, int first, int stride, int end, int lane, float scale) {
    if (first >= end) return;
    const int ng = lane & 15, ko = lane >> 4, nblk = N / 64;
    typedef int i32x2 __attribute__((ext_vector_type(2)));
    f32x4 v[4][8];
    { const int e = first / items_per_e, item = first % items_per_e, kb = item / nblk, nb = item % nblk;
      const float* src = Wall + (size_t)e * 1024 * N + (size_t)(128 * kb + 8 * ko) * N + 64 * nb + 4 * ng;
#pragma unroll
      for (int q = 0; q < 4; ++q)
#pragma unroll
          for (int k = 0; k < 8; ++k) v[q][k] = __builtin_nontemporal_load((const GAS f32x4*)(src + (size_t)(32 * q + k) * N)); }
#pragma unroll 1
    for (int r = first; r < end; r += stride) {
        const int rn = r + stride; const bool hn = rn < end; const int rr = hn ? rn : r;
        const int en = rr / items_per_e, itn = rr % items_per_e;
        const float* nsrc = Wall + (size_t)en * 1024 * N + (size_t)(128 * (itn / nblk) + 8 * ko) * N + 64 * (itn % nblk) + 4 * ng;
#pragma unroll
        for (int q = 0; q < 4; ++q) {
#pragma unroll
            for (int j = 0; j < 4; ++j) {
                int lo = __builtin_amdgcn_cvt_pk_fp8_f32(v[q][0][j] * scale, v[q][1][j] * scale, 0, false); lo = __builtin_amdgcn_cvt_pk_fp8_f32(v[q][2][j] * scale, v[q][3][j] * scale, lo, true);
                int hi = __builtin_amdgcn_cvt_pk_fp8_f32(v[q][4][j] * scale, v[q][5][j] * scale, 0, false); hi = __builtin_amdgcn_cvt_pk_fp8_f32(v[q][6][j] * scale, v[q][7][j] * scale, hi, true);
                *(LAS i32x2*)(tile + (4 * ng + j) * 144 + 32 * q + 8 * ko) = (i32x2){lo, hi}; }
            if (hn) {
#pragma unroll
                for (int k = 0; k < 8; ++k) v[q][k] = __builtin_nontemporal_load((const GAS f32x4*)(nsrc + (size_t)(32 * q + k) * N)); }
        }
        LDS_WAIT(); asm volatile("" ::: "memory");
        const int e = r / items_per_e, item = r % items_per_e, k0 = 128 * (item / nblk), n0 = 64 * (item % nblk);
#pragma unroll
        for (int i = 0; i < 8; ++i) { const int rl = (lane >> 3) + 8 * i, n = n0 + rl; int dr; if (MAP == 0) dr = n; else { const int jj = n & 1023; dr = 256 * (jj >> 7) + 128 * (n >> 10) + (jj & 127); }
            const v4u w = *(const LAS v4u*)(tile + rl * 144 + 16 * (lane & 7));
            *(GAS v4u*)(WT + (size_t)(e * N + dr) * 1024 + k0 + 16 * (lane & 7)) = w; }
        LDS_WAIT(); asm volatile("" ::: "memory");
    }
}
constexpr int I_GU = 8 * 32, I_D = 8 * 16, NMOE_ITEMS = NEXP * (I_GU + I_D);
#ifndef MOE_P1_ITEMS
#define MOE_P1_ITEMS 9216
#endif
__device__ __forceinline__ void moe_item(Frame& F, int r, LAS float* scr) {
    if (r < NEXP * I_GU) { const int e = r / I_GU; convert_item_f8<2>((F.a->in[11]) + (size_t)e * 1024 * 2048, 1024, 2048, (unsigned char*)F_WGU, e * 2048, (LAS unsigned char*)scr, r % I_GU, F.lane, 32.0f); return; }
    r -= NEXP * I_GU;
    { const int e = r / I_D; convert_item_f8<0>((F.a->in[13]) + (size_t)e * 1024 * 1024, 1024, 1024, (unsigned char*)F_WD, e * 1024, (LAS unsigned char*)scr, r % I_D, F.lane, 32.0f); }
}
__device__ __forceinline__ void p1_convert(Frame& F, int cc, int NC, int moe_hi) {
    LAS unsigned char* scr = (LAS unsigned char*)(F.lds + RING_OFF + F.wave * 16384);
    const int w = cc * NWAVES + F.wave, nw = NC * NWAVES;
    const int hi_gu = moe_hi < NEXP * I_GU ? moe_hi : NEXP * I_GU, hi_d = moe_hi - NEXP * I_GU;
    convert_stream_f8<2>((F.a->in[11]), 2048, I_GU, (unsigned char*)F_WGU, scr, w, nw, hi_gu, F.lane, 32.0f);
    convert_stream_f8<0>((F.a->in[13]), 1024, I_D, (unsigned char*)F_WD, scr, w, nw, hi_d, F.lane, 32.0f);
}
__device__ __forceinline__ void p0_prologue(Frame& F, int moe_lo) {
    LAS float* scr = (LAS float*)(F.lds + RING_OFF + F.wave * 16384);
    const int gw = blockIdx.x * NWAVES + F.wave, NGW = F.G * NWAVES;
    constexpr int I_WI = 16 * 151, I_PA = 8 * 32, I_WO = 16 * 32;
    constexpr int NITEMS = I_WI + 2 * I_PA + I_WO + NMOE_ITEMS;
    for (int it = moe_lo + gw; it < NITEMS; it += NGW) {
        int r = it;
        if (r < NMOE_ITEMS) { moe_item(F, r, scr); continue; } r -= NMOE_ITEMS;
        if (r < I_WI) { transpose_item<1>((F.a->in[2]), 1024, NPROJ, F_WI, 0, scr, r, F.lane); continue; } r -= I_WI;
        if (r < I_PA) { transpose_item<0>((F.a->in[5]), 512, 1024, F_WPA, 0, scr, r, F.lane); continue; } r -= I_PA;
        if (r < I_PA) { transpose_item<0>((F.a->in[6]), 512, 1024, F_WPB, 0, scr, r, F.lane); continue; } r -= I_PA;
        transpose_item<0>((F.a->in[7]), 1024, 1024, F_WO, 0, scr, r, F.lane);
    }
    { const int gt = blockIdx.x * (NWAVES * 64) + F.tid; if (gt < 7168) { v4u z = {0u, 0u, 0u, 0u}; *((GAS v4u*)(F_WI + (size_t)NPROJ * 1024) + gt) = z; } }
    { const int gt = blockIdx.x * (NWAVES * 64) + F.tid; if (gt < 1024 * 32) F_WRG[gt] = (F.a->in[8])[gt >> 5] * (F.a->in[9])[gt]; }
    { const int gt = blockIdx.x * (NWAVES * 64) + F.tid; if (gt < SEQ * 8) { const int i = gt & 7; const float inv = exp2f(-(float)i * 0.125f * 18.931568569324174f); float sn, cs; sincosf((float)(gt >> 3) * inv, &sn, &cs); F_ROPE[2 * gt] = cs; F_ROPE[2 * gt + 1] = sn; } }
    for (int m = gw; m < NTOK; m += NGW) {
        const GAS f32x4* xr = (const GAS f32x4*)((F.a->in[0]) + (size_t)m * DM) + F.lane; const GAS f32x4* gr = (const GAS f32x4*)(F.a->in[1]) + F.lane;
        f32x4 v[4]; float s = 0.f;
#pragma unroll
        for (int j = 0; j < 4; ++j) { v[j] = xr[64 * j]; s += (v[j].x * v[j].x + v[j].y * v[j].y) + (v[j].z * v[j].z + v[j].w * v[j].w); }
        const float rr = 1.0f / sqrtf(wave_sum(s) * (1.f / DM) + RMS_EPS);
        GAS unsigned long long* o8 = (GAS unsigned long long*)(F_XN + (size_t)m * DM) + F.lane;
#pragma unroll
        for (int j = 0; j < 4; ++j) { const f32x4 g = gr[64 * j]; o8[64 * j] = (unsigned long long)pk2(v[j].x * rr * g.x, v[j].y * rr * g.y) | ((unsigned long long)pk2(v[j].z * rr * g.z, v[j].w * rr * g.w) << 32); }
    }
}

__device__ __forceinline__ void rope16(float (&v)[16], const float* tab  ) {
#pragma unroll
    for (int i = 0; i < 8; ++i) { const float cs = tab[2 * i], sn = tab[2 * i + 1]; const float a = v[i], b2 = v[i + 8]; v[i] = a * cs - b2 * sn; v[i + 8] = b2 * cs + a * sn; }
}
__device__ __forceinline__ void p2_prep(Frame& F, int rep) {
    const size_t shift = rep ? (size_t)(WS_Y - WS_PROJ) / 2 : 0;
    const int gt = blockIdx.x * (NWAVES * 64) + F.tid, NGT = F.G * NWAVES * 64;
    for (int w = gt; w < NTOK * 8; w += NGT) {
        const int tk = w >> 3, h = w & 7; bf16* p = F_PROJ + (size_t)tk * PROJ_LD + h * 64; const float* g = (F.a->in[3]);
        v4u u[8]; float ss = 0.f;
#pragma unroll
        for (int c = 0; c < 8; ++c) { u[c] = *((const GAS v4u*)p + c); const float a0 = bflo(u[c].x), a1 = bfhi(u[c].x), a2 = bflo(u[c].y), a3 = bfhi(u[c].y), a4 = bflo(u[c].z), a5 = bfhi(u[c].z), a6 = bflo(u[c].w), a7 = bfhi(u[c].w);
            ss += (a0 * a0 + a1 * a1) + (a2 * a2 + a3 * a3) + (a4 * a4 + a5 * a5) + (a6 * a6 + a7 * a7); }
        const float rr = 1.0f / sqrtf(ss * (1.f / 64.f) + RMS_EPS);
        float r16[16];
#pragma unroll
        for (int c = 0; c < 2; ++c) { r16[8 * c] = bflo(u[c].x) * rr * g[8 * c]; r16[8 * c + 1] = bfhi(u[c].x) * rr * g[8 * c + 1]; r16[8 * c + 2] = bflo(u[c].y) * rr * g[8 * c + 2]; r16[8 * c + 3] = bfhi(u[c].y) * rr * g[8 * c + 3];
            r16[8 * c + 4] = bflo(u[c].z) * rr * g[8 * c + 4]; r16[8 * c + 5] = bfhi(u[c].z) * rr * g[8 * c + 5]; r16[8 * c + 6] = bflo(u[c].w) * rr * g[8 * c + 6]; r16[8 * c + 7] = bfhi(u[c].w) * rr * g[8 * c + 7]; }
        rope16(r16, F_ROPE + (size_t)(tk & (SEQ - 1)) * 16);
        const float sc = 0.125f;
#pragma unroll
        for (int c = 0; c < 8; ++c) { v4u o;
            if (c < 2) { o.x = pk2(r16[8 * c] * sc, r16[8 * c + 1] * sc); o.y = pk2(r16[8 * c + 2] * sc, r16[8 * c + 3] * sc); o.z = pk2(r16[8 * c + 4] * sc, r16[8 * c + 5] * sc); o.w = pk2(r16[8 * c + 6] * sc, r16[8 * c + 7] * sc); }
            else { const float q = rr * sc; o.x = pk2(bflo(u[c].x) * q * g[8 * c], bfhi(u[c].x) * q * g[8 * c + 1]); o.y = pk2(bflo(u[c].y) * q * g[8 * c + 2], bfhi(u[c].y) * q * g[8 * c + 3]);
                o.z = pk2(bflo(u[c].z) * q * g[8 * c + 4], bfhi(u[c].z) * q * g[8 * c + 5]); o.w = pk2(bflo(u[c].w) * q * g[8 * c + 6], bfhi(u[c].w) * q * g[8 * c + 7]); }
            *((GAS v4u*)(p + shift) + c) = o; }
    }
    for (int w = gt; w < NTOK * 4; w += NGT) {
        const int tk = w >> 2, j = w & 3;
        if (j == 3) {
#pragma unroll
            for (int h = 0; h < 8; ++h) (F_WIQ + (rep ? (size_t)(WS_ACT - WS_WIQ) / 4 + 4 * MiB : 0))[(size_t)tk * 8 + h] = F_SMALLF[(size_t)tk * 256 + 192 + h] * 0.044194173824159216f;
            continue;
        }
        const float* p = F_SMALLF + (size_t)tk * 256 + (j == 0 ? 0 : (j == 1 ? 128 : 64));
        bf16* dst = (j == 0 ? F_KA : (j == 1 ? F_KI : F_VA)) + (size_t)tk * 64 + (rep ? (size_t)(WS_ACT - WS_KA) / 2 : 0);
        float v[64];
#pragma unroll
        for (int c = 0; c < 16; ++c) { const f32x4 u = *((const GAS f32x4*)p + c); v[4 * c] = u.x; v[4 * c + 1] = u.y; v[4 * c + 2] = u.z; v[4 * c + 3] = u.w; }
        if (j == 0) { const float* g = (F.a->in[4]); float ss = 0.f;
#pragma unroll
            for (int d = 0; d < 64; ++d) ss += v[d] * v[d];
            const float rr = 1.0f / sqrtf(ss * (1.f / 64.f) + RMS_EPS);
#pragma unroll
            for (int d = 0; d < 64; ++d) v[d] = v[d] * rr * g[d]; }
        if (j < 2) { float r16[16];
#pragma unroll
            for (int d = 0; d < 16; ++d) r16[d] = v[d];
            rope16(r16, F_ROPE + (size_t)(tk & (SEQ - 1)) * 16);
#pragma unroll
            for (int d = 0; d < 16; ++d) v[d] = r16[d]; }
#pragma unroll
        for (int c = 0; c < 8; ++c) { v4u o; o.x = pk2(v[8 * c], v[8 * c + 1]); o.y = pk2(v[8 * c + 2], v[8 * c + 3]); o.z = pk2(v[8 * c + 4], v[8 * c + 5]); o.w = pk2(v[8 * c + 6], v[8 * c + 7]); *((GAS v4u*)dst + c) = o; }
    }
}

typedef float f32x16 __attribute__((ext_vector_type(16)));
__device__ __forceinline__ void sb_item(Frame& F, int item) {
    const int bh = item >> 3, tb = item & 7, b = bh >> 3, h = bh & 7, t = tb * 512 + F.tid;
    const bf16* base = F_PROJ + (size_t)(b * SEQ) * PROJ_LD + h * 64;
    float o[64]; v4u qw[8];
    { const GAS v4u* qp = (const GAS v4u*)(base + (size_t)t * PROJ_LD + 1024);
#pragma unroll
      for (int c = 0; c < 8; ++c) qw[c] = qp[c]; }
#pragma unroll
    for (int d = 0; d < 64; ++d) o[d] = 0.f;
    float R = 0.f; int s = t - 1;
    for (;;) {
        const bool active = (s >= 0) && (R <= 104.0f);
        if (!__any(active)) break;
        if (active) {
            const GAS v4u* kp = (const GAS v4u*)(base + (size_t)s * PROJ_LD + 1536);
            const GAS v4u* vp = (const GAS v4u*)(base + (size_t)s * PROJ_LD + 2048);
            float z = 0.f;
#pragma unroll
            for (int c = 0; c < 8; ++c) { const v4u u = kp[c];
                const v4u qq = qw[c]; z += bflo(qq.x) * bflo(u.x) + bfhi(qq.x) * bfhi(u.x) + bflo(qq.y) * bflo(u.y) + bfhi(qq.y) * bfhi(u.y) + bflo(qq.z) * bflo(u.z) + bfhi(qq.z) * bfhi(u.z) + bflo(qq.w) * bflo(u.w) + bfhi(qq.w) * bfhi(u.w); }
            const float sp = fmaxf(z, 0.f) + log1pf(__expf(-fabsf(z)));
            R += sp;
            const float a = __expf(z - R);
#pragma unroll
            for (int c = 0; c < 8; ++c) { const v4u u = vp[c];
                o[8 * c] += a * bflo(u.x); o[8 * c + 1] += a * bfhi(u.x); o[8 * c + 2] += a * bflo(u.y); o[8 * c + 3] += a * bfhi(u.y); o[8 * c + 4] += a * bflo(u.z); o[8 * c + 5] += a * bfhi(u.z); o[8 * c + 6] += a * bflo(u.w); o[8 * c + 7] += a * bfhi(u.w); }
        }
        --s;
    }
    GAS v4u* op = (GAS v4u*)(F_OB + (size_t)(b * SEQ + t) * 512 + h * 64);
#pragma unroll
    for (int c = 0; c < 8; ++c) { v4u w; w.x = pk2(o[8 * c], o[8 * c + 1]); w.y = pk2(o[8 * c + 2], o[8 * c + 3]); w.z = pk2(o[8 * c + 4], o[8 * c + 5]); w.w = pk2(o[8 * c + 6], o[8 * c + 7]); op[c] = w; }
}

typedef float f32x2_t __attribute__((ext_vector_type(2))); typedef __bf16 bf16x2_t __attribute__((ext_vector_type(2)));
__device__ __forceinline__ float relu_i(float x) { const int i = __builtin_bit_cast(int, x); return __builtin_bit_cast(float, i > 0 ? i : 0); }
typedef short v4i16_t __attribute__((ext_vector_type(4)));
__device__ __forceinline__ unsigned cvtpk_s(float lo, float hi) { f32x2_t v = {lo, hi}; bf16x2_t b = __builtin_convertvector(v, bf16x2_t); return __builtin_bit_cast(unsigned, b); }
__device__ __forceinline__ v4i16_t vtr(LAS unsigned char* p) { return __builtin_amdgcn_ds_read_tr16_b64_v4i16((LAS v4i16_t*)p); }
__device__ __forceinline__ void sb_item_mfma(Frame& F, int item) {
    const int lane = F.lane, wave = F.wave, r32 = lane & 31, hb = lane >> 5;
    const int bh = item >> 4, qb = item & 15, b = bh >> 3, h = bh & 7, qt = qb * 8 + wave, t0 = qt * 32;
    const bf16* base = F_PROJ + (size_t)(b * SEQ) * PROJ_LD + h * 64;
    LAS unsigned char* vl = F.lds + RING_OFF + wave * 16384;
    bf16x8 qf[4];
#pragma unroll
    for (int ks = 0; ks < 4; ++ks) qf[ks] = *(const GAS bf16x8*)(base + (size_t)(t0 + r32) * PROJ_LD + 1024 + 16 * ks + 8 * hb);
    f32x16 o0, o1;
#pragma unroll
    for (int i = 0; i < 16; ++i) { o0[i] = 0.f; o1[i] = 0.f; }
    float R = 0.f;
    const int tg = (lane >> 4) & 1, tq = (lane & 15) >> 2, tp = lane & 3;
    LAS unsigned char* trb = vl + (4 * hb + tq) * 192 + (16 * tg + 4 * tp) * 2;
    for (int kt = qt; kt >= 0; --kt) {
        const bf16* kp = base + (size_t)(32 * kt + r32) * PROJ_LD + 1536 + 8 * hb;
        bf16x8 kf[4];
#pragma unroll
        for (int ks = 0; ks < 4; ++ks) kf[ks] = *(const GAS bf16x8*)(kp + 16 * ks);
        v4u vv[4];
#pragma unroll
        for (int i = 0; i < 4; ++i) vv[i] = *(const GAS v4u*)(base + (size_t)(32 * kt + (lane >> 3) + 8 * i) * PROJ_LD + 2048 + 8 * (lane & 7));
        f32x16 c;
#pragma unroll
        for (int i = 0; i < 16; ++i) c[i] = 0.f;
#pragma unroll
        for (int ks = 0; ks < 4; ++ks) c = __builtin_amdgcn_mfma_f32_32x32x16_bf16(kf[ks], qf[ks], c, 0, 0, 0);
#pragma unroll
        for (int i = 0; i < 4; ++i) *(LAS v4u*)(vl + ((lane >> 3) + 8 * i) * 192 + 16 * (lane & 7)) = vv[i];
        const bool diag = (kt == qt);
        float sp[16];
#pragma unroll
        for (int i = 0; i < 16; ++i) { const int kk = (i & 3) + 8 * (i >> 2) + 4 * hb; const bool msk = diag && (kk >= r32); const float z = c[i];
            const float v = fmaxf(z, 0.f) + 0.6931471805599453f * __builtin_amdgcn_logf(1.0f + __builtin_amdgcn_exp2f(-fabsf(z) * 1.4426950408889634f));
            sp[i] = msk ? 0.f : v; }
        float gs[4], pg[4];
#pragma unroll
        for (int k4 = 0; k4 < 4; ++k4) { gs[k4] = (sp[4 * k4] + sp[4 * k4 + 1]) + (sp[4 * k4 + 2] + sp[4 * k4 + 3]); pg[k4] = __shfl_xor(gs[k4], 32); }
        float off[4];
        { const float so2 = gs[3], so1 = so2 + gs[2], so0 = so1 + gs[1]; const float po2 = pg[3], po1 = po2 + pg[2], po0 = po1 + pg[1];
          off[3] = 0.f; off[2] = so2 + po2; off[1] = so1 + po1; off[0] = so0 + po0;
          if (hb == 0) { off[3] += pg[3]; off[2] += pg[2]; off[1] += pg[1]; off[0] += pg[0]; }
          const float total = (so0 + gs[0]) + (po0 + pg[0]);
#pragma unroll
          for (int k4 = 0; k4 < 4; ++k4) { float run = R + off[k4];
#pragma unroll
              for (int w = 3; w >= 0; --w) { const int i = 4 * k4 + w; const int kk = w + 8 * k4 + 4 * hb; const bool msk = diag && (kk >= r32);
                  run += sp[i]; const float a = __builtin_amdgcn_exp2f((c[i] - run) * 1.4426950408889634f); c[i] = msk ? 0.f : a; } }
          R += total; }
        bf16x8 pa[2];
#pragma unroll
        for (int s2 = 0; s2 < 2; ++s2) { v4u w4; w4.x = cvtpk_s(c[8 * s2], c[8 * s2 + 1]); w4.y = cvtpk_s(c[8 * s2 + 2], c[8 * s2 + 3]); w4.z = cvtpk_s(c[8 * s2 + 4], c[8 * s2 + 5]); w4.w = cvtpk_s(c[8 * s2 + 6], c[8 * s2 + 7]); pa[s2] = __builtin_bit_cast(bf16x8, w4); }
        LDS_WAIT(); asm volatile("" ::: "memory");
#pragma unroll
        for (int s2 = 0; s2 < 2; ++s2) {
#pragma unroll
            for (int db = 0; db < 2; ++db) {
                const v4i16_t lo = vtr(trb + (16 * s2) * 192 + db * 64), hi2 = vtr(trb + (16 * s2 + 8) * 192 + db * 64);
                const bf16x8 vf = (bf16x8){lo[0], lo[1], lo[2], lo[3], hi2[0], hi2[1], hi2[2], hi2[3]};
                if (db == 0) o0 = __builtin_amdgcn_mfma_f32_32x32x16_bf16(pa[s2], vf, o0, 0, 0, 0); else o1 = __builtin_amdgcn_mfma_f32_32x32x16_bf16(pa[s2], vf, o1, 0, 0, 0);
            } }
        LDS_WAIT(); asm volatile("" ::: "memory");
        if (__all(R > 104.0f)) break;
    }
    bf16* op = F_OB + (size_t)(b * SEQ + t0) * 512 + h * 64 + r32;
#pragma unroll
    for (int i = 0; i < 16; ++i) { const int qr = (i & 3) + 8 * (i >> 2) + 4 * hb; op[(size_t)qr * 512] = (bf16)f2bf(o0[i]); op[(size_t)qr * 512 + 32] = (bf16)f2bf(o1[i]); }
}

template <int NV> __device__ __forceinline__ bool select256_hist(const LAS unsigned* rowu, LAS int* idxl, LAS unsigned* hist  , int L, int lane) {
    unsigned kv[NV]; unsigned kmin = 0xffffffffu, kmax = 0u;
    const LAS unsigned* rp = rowu + lane; asm volatile("" : "+v"(rp));
#pragma unroll
    for (int j = 0; j < NV; ++j) { unsigned u = 0u;
        if (64 * j < L) { u = rp[64 * j]; u = (u & 0x80000000u) ? ~u : (u | 0x80000000u); kmin = u < kmin ? u : kmin; kmax = u > kmax ? u : kmax; }
        kv[j] = u; }
#pragma unroll
    for (int o = 1; o < 64; o <<= 1) { const unsigned a = (unsigned)__shfl_xor((int)kmin, o), c2 = (unsigned)__shfl_xor((int)kmax, o); kmin = a < kmin ? a : kmin; kmax = c2 > kmax ? c2 : kmax; }
    const float fmin = __uint_as_float((kmin & 0x80000000u) ? (kmin ^ 0x80000000u) : ~kmin), fmax = __uint_as_float((kmax & 0x80000000u) ? (kmax ^ 0x80000000u) : ~kmax);
    const float rng = fmax - fmin, scale = rng > 0.f ? 1023.5f / rng : 0.f;
#define SEL_BIN(kk) ({ const unsigned k_ = (kk); const float f_ = __uint_as_float((k_ & 0x80000000u) ? (k_ ^ 0x80000000u) : ~k_); int b_ = (int)((f_ - fmin) * scale); b_ = b_ > 1023 ? 1023 : b_; b_; })
#pragma unroll
    for (int i = 0; i < 2; ++i) *(LAS v4u*)(hist + 4 * (lane + 64 * i)) = (v4u){0u, 0u, 0u, 0u};
    LDS_WAIT(); asm volatile("" ::: "memory");
#pragma unroll
    for (int j = 0; j < NV; ++j) if (64 * j < L) { const int b = SEL_BIN(kv[j]); __hip_atomic_fetch_add(hist + (b >> 1), 1u << (16 * (b & 1)), __ATOMIC_RELAXED, __HIP_MEMORY_SCOPE_WORKGROUP); }
    LDS_WAIT(); asm volatile("" ::: "memory");
    int hb[16];
    { const v4u w0 = *(const LAS v4u*)(hist + 8 * lane), w1 = *(const LAS v4u*)(hist + 8 * lane + 4);
      hb[0] = w0.x & 0xffff; hb[1] = w0.x >> 16; hb[2] = w0.y & 0xffff; hb[3] = w0.y >> 16; hb[4] = w0.z & 0xffff; hb[5] = w0.z >> 16; hb[6] = w0.w & 0xffff; hb[7] = w0.w >> 16;
      hb[8] = w1.x & 0xffff; hb[9] = w1.x >> 16; hb[10] = w1.y & 0xffff; hb[11] = w1.y >> 16; hb[12] = w1.z & 0xffff; hb[13] = w1.z >> 16; hb[14] = w1.w & 0xffff; hb[15] = w1.w >> 16; }
    int S = 0;
#pragma unroll
    for (int i = 0; i < 16; ++i) S += hb[i];
    int incl = S;
#pragma unroll
    for (int o = 1; o < 64; o <<= 1) { const int v = __shfl_down(incl, o); if (lane + o < 64) incl += v; }
    const int T = incl - S;
    int bstar = -1, cA = 0, nb = 0;
    { int run = T; bool found = false;
#pragma unroll
      for (int i = 15; i >= 0; --i) { const bool here = !found && (T < 256) && (T + S >= 256) && (run + hb[i] >= 256); if (here) { bstar = 16 * lane + i; cA = run; nb = hb[i]; found = true; } run += hb[i]; } }
    { const unsigned long long mown = __ballot(bstar >= 0); const int src = (int)__ffsll((long long)mown) - 1; bstar = __shfl(bstar, src); cA = __shfl(cA, src); nb = __shfl(nb, src); }
    if (nb > 512) return false;
    const int need = 256 - cA;
    LDS_WAIT(); asm volatile("" ::: "memory");
    LAS int* cand = (LAS int*)hist;
    int base = 0, cbase = 0;
#pragma unroll
    for (int j = 0; j < NV; ++j) {
        const int b = (64 * j < L) ? SEL_BIN(kv[j]) : -1;
        const bool gt = b > bstar, eq = b == bstar;
        const unsigned long long mg = __ballot(gt), me = __ballot(eq);
        const int pg = base + (int)__builtin_amdgcn_mbcnt_hi((unsigned)(mg >> 32), __builtin_amdgcn_mbcnt_lo((unsigned)mg, 0u));
        const int pe = cbase + (int)__builtin_amdgcn_mbcnt_hi((unsigned)(me >> 32), __builtin_amdgcn_mbcnt_lo((unsigned)me, 0u));
        if (gt && pg < 256) idxl[pg] = 64 * j + lane;
        if (eq && pe < 512) cand[pe] = 64 * j + lane;
        base += __popcll(mg); cbase += __popcll(me);
    }
#undef SEL_BIN
    LDS_WAIT(); asm volatile("" ::: "memory");
    for (int i = lane; i < nb; i += 64) {
        const int ci = cand[i]; unsigned ki = rowu[ci]; ki = (ki & 0x80000000u) ? ~ki : (ki | 0x80000000u);
        int rank = 0;
        for (int j = 0; j < nb; ++j) { const int cj = cand[j]; unsigned kj = rowu[cj]; kj = (kj & 0x80000000u) ? ~kj : (kj | 0x80000000u); rank += (kj > ki || (kj == ki && cj < ci)) ? 1 : 0; }
        if (rank < need) idxl[cA + rank] = ci;
    }
    return true;
}
template <int NV> __device__ __forceinline__ void select256(const LAS unsigned* rowu, LAS int* idxl, int L, int lane) {
    unsigned kv[NV]; unsigned kmin = 0xffffffffu, kmax = 0u;
    const LAS unsigned* rp = rowu + lane; asm volatile("" : "+v"(rp));
#pragma unroll
    for (int j = 0; j < NV; ++j) { unsigned u = 0u;
        if (64 * j < L) { u = rp[64 * j]; u = (u & 0x80000000u) ? ~u : (u | 0x80000000u); kmin = u < kmin ? u : kmin; kmax = u > kmax ? u : kmax; }
        kv[j] = u; }
#pragma unroll
    for (int o = 1; o < 64; o <<= 1) { const unsigned a = (unsigned)__shfl_xor((int)kmin, o), c2 = (unsigned)__shfl_xor((int)kmax, o); kmin = a < kmin ? a : kmin; kmax = c2 > kmax ? c2 : kmax; }
    unsigned lo = kmin, hi = kmax + 1u; int chi = 0;
    while (hi - lo > 1u) {
        const unsigned mid = lo + ((hi - lo) >> 1);
        int c = 0;
#pragma unroll
        for (int j = 0; j < NV; j += 8) {
            unsigned long long mk[8];
#pragma unroll
            for (int q = 0; q < 8; ++q) mk[q] = __ballot(kv[j + q] >= mid);
            asm volatile("" : "+s"(mk[0]), "+s"(mk[1]), "+s"(mk[2]), "+s"(mk[3]), "+s"(mk[4]), "+s"(mk[5]), "+s"(mk[6]), "+s"(mk[7]));
#pragma unroll
            for (int q = 0; q < 8; ++q) c += __popcll(mk[q]);
        }
        if (c >= 256) { lo = mid; if (c == 256) { hi = mid; chi = 256; break; } } else { hi = mid; chi = c; }
    }
    const int need = 256 - chi; int base = 0, tdone = 0;
#pragma unroll
    for (int j = 0; j < NV; ++j) {
        const unsigned u = kv[j];
        const bool gt = u >= hi, eq = (u == lo) && !gt;
        const unsigned long long meq = __ballot(eq);
        const int eqrank = tdone + (int)__builtin_amdgcn_mbcnt_hi((unsigned)(meq >> 32), __builtin_amdgcn_mbcnt_lo((unsigned)meq, 0u));
        const bool sel = gt || (eq && eqrank < need);
        const unsigned long long msel = __ballot(sel);
        const int pos = base + (int)__builtin_amdgcn_mbcnt_hi((unsigned)(msel >> 32), __builtin_amdgcn_mbcnt_lo((unsigned)msel, 0u));
        if (sel && pos < 256) idxl[pos] = 64 * j + lane;
        base += __popcll(msel); tdone += __popcll(meq);
    }
}
#ifndef P3_MODE
#define P3_MODE 0
#endif
__device__ __forceinline__ void dsa_item(Frame& F, int b, int t0, int stop) {
    const int lane = F.lane, wave = F.wave;
    const int L = ((t0 >> 6) + 1) << 6;
    LAS float* sc = (LAS float*)(F.lds + RING_OFF);
    if (L > 256) {
        const int r = lane & 31, hb = lane >> 5;
        const int head = (r & 3) + 4 * ((r >> 3) & 1), qsub = ((r >> 2) & 1) + 2 * ((r >> 4) & 1);
        bf16x8 qa[2][4]; float wq[2][2][8];
#pragma unroll
        for (int j = 0; j < 2; ++j) {
            const bf16* qp = F_PROJ + (size_t)(b * SEQ + t0 + 4 * j + qsub) * PROJ_LD + 512 + head * 64 + 8 * hb;
#pragma unroll
            for (int ks = 0; ks < 4; ++ks) qa[j][ks] = *(const GAS bf16x8*)(qp + 16 * ks);
#pragma unroll
            for (int x2 = 0; x2 < 2; ++x2)
#pragma unroll
                for (int hh = 0; hh < 8; ++hh) wq[j][x2][hh] = F_WIQ[(size_t)(b * SEQ + t0 + 4 * j + hb + 2 * x2) * 8 + hh];
        }
        const int ntile = L >> 5;
        const bf16* kbase = F_KI + (size_t)(b * SEQ + r) * 64 + 8 * hb;
#define IDX_LOAD(dst, kt_) do { const bf16* kp_ = kbase + (size_t)(32 * (kt_)) * 64; _Pragma("unroll") for (int ks = 0; ks < 4; ++ks) dst[ks] = *(const GAS bf16x8*)(kp_ + 16 * ks); } while (0)
#define IDX_TILE(src, kt_) do { _Pragma("unroll") for (int j = 0; j < 2; ++j) { f32x16 c; _Pragma("unroll") for (int i = 0; i < 16; ++i) c[i] = 0.f; \
            _Pragma("unroll") for (int ks = 0; ks < 4; ++ks) c = __builtin_amdgcn_mfma_f32_32x32x16_bf16(qa[j][ks], src[ks], c, 0, 0, 0); \
            float s0 = 0.f, s1 = 0.f; _Pragma("unroll") for (int i = 0; i < 8; ++i) { s0 += wq[j][0][i] * fmaxf(c[i], 0.f); s1 += wq[j][1][i] * fmaxf(c[8 + i], 0.f); } \
            sc[(4 * j + hb) * 4096 + 32 * (kt_) + r] = s0; sc[(4 * j + hb + 2) * 4096 + 32 * (kt_) + r] = s1; } } while (0)
        for (int kt = wave; kt < ntile; kt += 32) {
            bf16x8 k4[4][4];
#pragma unroll
            for (int u = 0; u < 4; ++u) { const int ku = kt + 8 * u; IDX_LOAD(k4[u], ku < ntile ? ku : ntile - 1); }
#pragma unroll
            for (int u = 0; u < 4; ++u) { const int ku = kt + 8 * u; if (ku < ntile) IDX_TILE(k4[u], ku); }
        }
#undef IDX_LOAD
#undef IDX_TILE
    }
    __syncthreads();
    if (stop == 1) { __syncthreads(); return; }
    LAS float* row = sc + wave * 4096; LAS unsigned* rowu = (LAS unsigned*)row;
    LAS int* idxl = (LAS int*)(F.lds + IDX_OFF) + wave * 256;
    int nsel;
    if (L <= 256) { nsel = L; for (int i = lane; i < 256; i += 64) idxl[i] = (i < L) ? i : 0; }
    else {
        LAS unsigned* hist = (LAS unsigned*)(F.lds + HIST_OFF) + wave * 512;
        bool ok;
        if (L <= 1024) ok = select256_hist<16>(rowu, idxl, hist, L, lane); else if (L <= 2048) ok = select256_hist<32>(rowu, idxl, hist, L, lane); else if (L <= 3072) ok = select256_hist<48>(rowu, idxl, hist, L, lane); else ok = select256_hist<64>(rowu, idxl, hist, L, lane);
        if (!ok) select256<64>(rowu, idxl, L, lane);
        nsel = 256;
    }
    LDS_WAIT(); asm volatile("" ::: "memory");
    if (stop == 2) { __syncthreads(); return; }
    const int t = t0 + wave;
    {
        const int c16 = lane & 15, q4 = lane >> 4, tq = c16 >> 2, tp = c16 & 3;
        bf16x8 qf[2];
        { const bf16* qp = F_PROJ + (size_t)(b * SEQ + t) * PROJ_LD + (c16 & 7) * 64 + 8 * q4;
          qf[0] = *(const GAS bf16x8*)qp; qf[1] = *(const GAS bf16x8*)(qp + 32);
          if (c16 >= 8) { qf[0] = (bf16x8){0, 0, 0, 0, 0, 0, 0, 0}; qf[1] = qf[0]; } }
        f32x4 lg[16];
        const bf16* kbase = F_KA + (size_t)(b * SEQ) * 64 + 8 * q4;
#pragma unroll
        for (int g = 0; g < 16; ++g) {
            const int p = 16 * g + c16; const int key = (p < nsel) ? idxl[p] : 0;
            const bf16* kp = kbase + (size_t)key * 64;
            const bf16x8 k0 = *(const GAS bf16x8*)kp, k1 = *(const GAS bf16x8*)(kp + 32);
            f32x4 c = {0.f, 0.f, 0.f, 0.f};
            c = __builtin_amdgcn_mfma_f32_16x16x32_bf16(k0, qf[0], c, 0, 0, 0);
            c = __builtin_amdgcn_mfma_f32_16x16x32_bf16(k1, qf[1], c, 0, 0, 0);
#pragma unroll
            for (int r = 0; r < 4; ++r) if (16 * g + 4 * q4 + r >= nsel) c[r] = -INFINITY;
            lg[g] = c;
        }
        v4u vA[8], vB[8];
#pragma unroll
        for (int i = 0; i < 8; ++i) { const int p_ = (lane >> 3) + 8 * i; const int key_ = (p_ < nsel) ? idxl[p_] : 0; vA[i] = *(const GAS v4u*)(F_VA + (size_t)(b * SEQ + key_) * 64 + 8 * (lane & 7)); }
        float m = -INFINITY;
#pragma unroll
        for (int g = 0; g < 16; ++g) m = fmaxf(m, fmaxf(fmaxf(lg[g][0], lg[g][1]), fmaxf(lg[g][2], lg[g][3])));
        m = fmaxf(m, __shfl_xor(m, 16)); m = fmaxf(m, __shfl_xor(m, 32));
        float ssum = 0.f;
#pragma unroll
        for (int g = 0; g < 16; ++g)
#pragma unroll
            for (int r = 0; r < 4; ++r) { const float e = __builtin_amdgcn_exp2f((lg[g][r] - m) * 1.4426950408889634f); lg[g][r] = e; ssum += e; }
        ssum += __shfl_xor(ssum, 16); ssum += __shfl_xor(ssum, 32);
        const float inv = 1.0f / ssum;
        LAS unsigned char* vl = (LAS unsigned char*)row;
        f32x4 o[4];
#pragma unroll
        for (int db = 0; db < 4; ++db) o[db] = (f32x4){0.f, 0.f, 0.f, 0.f};
#define V_LOAD(dst, ch_) do { _Pragma("unroll") for (int i = 0; i < 8; ++i) { const int p_ = 64 * (ch_) + (lane >> 3) + 8 * i; const int key_ = (p_ < nsel) ? idxl[p_] : 0; \
            dst[i] = *(const GAS v4u*)(F_VA + (size_t)(b * SEQ + key_) * 64 + 8 * (lane & 7)); } } while (0)
#define V_STEP(cur, nxt, ch_, HAS_NEXT) do { \
            _Pragma("unroll") for (int i = 0; i < 8; ++i) *(LAS v4u*)(vl + ((lane >> 3) + 8 * i) * 160 + 16 * (lane & 7)) = cur[i]; \
            LDS_WAIT(); asm volatile("" ::: "memory"); \
            if (HAS_NEXT) V_LOAD(nxt, (ch_) + 1); \
            _Pragma("unroll") for (int ss = 0; ss < 2; ++ss) { const int s2 = 2 * (ch_) + ss; \
                v4u w4; w4.x = cvtpk_s(lg[2 * s2][0] * inv, lg[2 * s2][1] * inv); w4.y = cvtpk_s(lg[2 * s2][2] * inv, lg[2 * s2][3] * inv); \
                w4.z = cvtpk_s(lg[2 * s2 + 1][0] * inv, lg[2 * s2 + 1][1] * inv); w4.w = cvtpk_s(lg[2 * s2 + 1][2] * inv, lg[2 * s2 + 1][3] * inv); \
                const bf16x8 pa = __builtin_bit_cast(bf16x8, w4); \
                _Pragma("unroll") for (int db = 0; db < 4; ++db) { \
                    const v4i16_t lo = vtr(vl + (32 * ss + 4 * q4 + tq) * 160 + (16 * db + 4 * tp) * 2), hi2 = vtr(vl + (32 * ss + 16 + 4 * q4 + tq) * 160 + (16 * db + 4 * tp) * 2); \
                    const bf16x8 vf = (bf16x8){lo[0], lo[1], lo[2], lo[3], hi2[0], hi2[1], hi2[2], hi2[3]}; \
                    o[db] = __builtin_amdgcn_mfma_f32_16x16x32_bf16(pa, vf, o[db], 0, 0, 0); } } \
            LDS_WAIT(); asm volatile("" ::: "memory"); } while (0)
        V_STEP(vA, vB, 0, true); V_STEP(vB, vA, 1, true); V_STEP(vA, vB, 2, true); V_STEP(vB, vA, 3, false);
#undef V_LOAD
#undef V_STEP
        if (q4 < 2) { bf16* op = F_OA + (size_t)(b * SEQ + t) * 512 + (4 * q4) * 64 + c16;
#pragma unroll
            for (int db = 0; db < 4; ++db)
#pragma unroll
                for (int r = 0; r < 4; ++r) op[r * 64 + 16 * db] = (bf16)f2bf(o[db][r]); }
    }
    __syncthreads();
}
__device__ __forceinline__ int shx_i(int v, int o, int lane) { return __builtin_amdgcn_ds_bpermute((lane ^ o) << 2, v); }
__device__ __forceinline__ float shx_f(float v, int o, int lane) { return __int_as_float(__builtin_amdgcn_ds_bpermute((lane ^ o) << 2, __float_as_int(v))); }
__device__ __forceinline__ int shl_i(int v, int src) { return __builtin_amdgcn_ds_bpermute(src << 2, v); }
__device__ __forceinline__ unsigned h2key(unsigned u) { return (u & 0x8000u) ? (~u & 0xffffu) : (u | 0x8000u); }
__device__ __forceinline__ float key2val(unsigned k) { const unsigned u = (k & 0x8000u) ? (k ^ 0x8000u) : (~k & 0xffffu); return (float)__builtin_bit_cast(_Float16, (unsigned short)u); }
template <int NV> __device__ __forceinline__ void select256_b16(const LAS unsigned short* rowh, LAS unsigned short* idxl, int L, int lane) {
    unsigned kv[NV]; unsigned kmin = 0xffffffffu, kmax = 0u;
    const LAS unsigned short* rp = rowh + lane; asm volatile("" : "+v"(rp));
#pragma unroll
    for (int j = 0; j < NV; ++j) { unsigned u = 0u; if (j < NV - 16 || 64 * j < L) { u = h2key(rp[64 * j]); kmin = u < kmin ? u : kmin; kmax = u > kmax ? u : kmax; } kv[j] = u; }
#pragma unroll
    for (int o = 1; o < 64; o <<= 1) { const unsigned a = (unsigned)shx_i((int)kmin, o, lane), c2 = (unsigned)shx_i((int)kmax, o, lane); kmin = a < kmin ? a : kmin; kmax = c2 > kmax ? c2 : kmax; }
    unsigned lo = kmin, hi = kmax + 1u; int chi = 0;
    while (hi - lo > 1u) {
        const unsigned mid = lo + ((hi - lo) >> 1);
        int c = 0;
#pragma unroll
        for (int j = 0; j < NV; ++j) c += __popcll(__ballot(kv[j] >= mid));
        if (c >= 256) { lo = mid; if (c == 256) { hi = mid; chi = 256; break; } } else { hi = mid; chi = c; }
    }
    const int need = 256 - chi; int base = 0, tdone = 0;
#pragma unroll
    for (int j = 0; j < NV; ++j) {
        const unsigned u = kv[j];
        const bool gt = u >= hi, eq = (u == lo) && !gt;
        const unsigned long long meq = __ballot(eq);
        const int eqrank = tdone + (int)__builtin_amdgcn_mbcnt_hi((unsigned)(meq >> 32), __builtin_amdgcn_mbcnt_lo((unsigned)meq, 0u));
        const bool sel = gt || (eq && eqrank < need);
        const unsigned long long msel = __ballot(sel);
        const int pos = base + (int)__builtin_amdgcn_mbcnt_hi((unsigned)(msel >> 32), __builtin_amdgcn_mbcnt_lo((unsigned)msel, 0u));
        if (sel && pos < 256) idxl[pos] = (unsigned short)(64 * j + lane);
        base += __popcll(msel); tdone += __popcll(meq);
    }
}
template <int NV> __device__ __forceinline__ bool select256_h16(const LAS unsigned short* rowh, LAS unsigned short* idxl, LAS unsigned* hist  , int L, int lane) {
    float kv[NV]; float fmin = INFINITY, fmax = -INFINITY;
    const LAS _Float16* rp = (const LAS _Float16*)rowh + lane; asm volatile("" : "+v"(rp));
#pragma unroll
    for (int j = 0; j < NV; ++j) { float f = -INFINITY; if (j < NV - 16 || 64 * j < L) { f = (float)rp[64 * j]; fmin = fminf(fmin, f); fmax = fmaxf(fmax, f); } kv[j] = f; }
#pragma unroll
    for (int o = 1; o < 64; o <<= 1) { fmin = fminf(fmin, shx_f(fmin, o, lane)); fmax = fmaxf(fmax, shx_f(fmax, o, lane)); }
    const float rng = fmax - fmin, scale = rng > 0.f ? 511.5f / rng : 0.f;
#pragma unroll
    for (int i = 0; i < 2; ++i) *(LAS v4u*)(hist + 4 * (lane + 64 * i)) = (v4u){0u, 0u, 0u, 0u};
    LDS_WAIT(); asm volatile("" ::: "memory");
    int kb[NV];
#pragma unroll
    for (int j = 0; j < NV; ++j) { int bq = -1;
        if (j < NV - 16 || 64 * j < L) { bq = (int)((kv[j] - fmin) * scale); bq = bq > 511 ? 511 : bq; __hip_atomic_fetch_add(hist + bq, 1u, __ATOMIC_RELAXED, __HIP_MEMORY_SCOPE_WORKGROUP); }
        kb[j] = bq; }
    LDS_WAIT(); asm volatile("" ::: "memory");
    int hb[8];
    { const v4u w0 = *(const LAS v4u*)(hist + 8 * lane), w1 = *(const LAS v4u*)(hist + 8 * lane + 4);
      hb[0] = (int)w0.x; hb[1] = (int)w0.y; hb[2] = (int)w0.z; hb[3] = (int)w0.w; hb[4] = (int)w1.x; hb[5] = (int)w1.y; hb[6] = (int)w1.z; hb[7] = (int)w1.w; }
    int S = 0;
#pragma unroll
    for (int i = 0; i < 8; ++i) S += hb[i];
    int incl = S;
#pragma unroll
    for (int o = 1; o < 64; o <<= 1) { const int v = shl_i(incl, (lane + o) & 63); if (lane + o < 64) incl += v; }
    const int T = incl - S;
    int bstar = -1, cA = 0, nb = 0;
    { int run = T; bool found = false;
#pragma unroll
      for (int i = 7; i >= 0; --i) { const bool here = !found && (T < 256) && (T + S >= 256) && (run + hb[i] >= 256); if (here) { bstar = 8 * lane + i; cA = run; nb = hb[i]; found = true; } run += hb[i]; } }
    { const unsigned long long mown = __ballot(bstar >= 0); const int src = (int)__ffsll((long long)mown) - 1; bstar = shl_i(bstar, src); cA = shl_i(cA, src); nb = shl_i(nb, src); }
    if (nb > 512) return false;
    const int need = 256 - cA;
    LDS_WAIT(); asm volatile("" ::: "memory");
    LAS int* cand = (LAS int*)hist;
    int base = 0, cbase = 0;
#pragma unroll
    for (int j = 0; j < NV; ++j) {
        const bool gt = kb[j] > bstar, eq = kb[j] == bstar;
        const unsigned long long mg = __ballot(gt), me = __ballot(eq);
        const int pg = base + (int)__builtin_amdgcn_mbcnt_hi((unsigned)(mg >> 32), __builtin_amdgcn_mbcnt_lo((unsigned)mg, 0u));
        const int pe = cbase + (int)__builtin_amdgcn_mbcnt_hi((unsigned)(me >> 32), __builtin_amdgcn_mbcnt_lo((unsigned)me, 0u));
        if (gt && pg < 256) idxl[pg] = (unsigned short)(64 * j + lane);
        if (eq && pe < 512) cand[pe] = 64 * j + lane;
        base += __popcll(mg); cbase += __popcll(me);
    }
    LDS_WAIT(); asm volatile("" ::: "memory");
    for (int i = lane; i < nb; i += 64) {
        const int ci = cand[i]; const unsigned ki = h2key(rowh[ci]);
        int rank = 0;
        for (int j = 0; j < nb; ++j) { const int cj = cand[j]; const unsigned kj = h2key(rowh[cj]); rank += (kj > ki || (kj == ki && cj < ci)) ? 1 : 0; }
        if (rank < need) idxl[cA + rank] = (unsigned short)ci;
    }
    return true;
}
__device__ __forceinline__ void unpk8(const bf16x8& v, float (&x)[8]) { const v4u u = __builtin_bit_cast(v4u, v); x[0] = bflo(u.x); x[1] = bfhi(u.x); x[2] = bflo(u.y); x[3] = bfhi(u.y); x[4] = bflo(u.z); x[5] = bfhi(u.z); x[6] = bflo(u.w); x[7] = bfhi(u.w); }
__device__ __forceinline__ bf16x8 pk8(const float (&x)[8]) { v4u u; u.x = cvtpk_s(x[0], x[1]); u.y = cvtpk_s(x[2], x[3]); u.z = cvtpk_s(x[4], x[5]); u.w = cvtpk_s(x[6], x[7]); return __builtin_bit_cast(bf16x8, u); }
__device__ __forceinline__ void rope_frag(float (&x)[8], bool lowhalf, int pmask, int lane, const float* tab) {
#pragma unroll
    for (int i = 0; i < 8; ++i) { const float o = shx_f(x[i], pmask, lane); const float cs = tab[2 * i], sn = tab[2 * i + 1]; x[i] = lowhalf ? x[i] * cs - o * sn : x[i] * cs + o * sn; }
}
template <bool FULL> __device__ __forceinline__ void dsa_attend(Frame& F, int b, int t, int nsel_, const LAS unsigned short* idxl, LAS unsigned char* vl, int lane) {
    int nsel = FULL ? 256 : nsel_; if (!FULL) asm volatile("" : "+v"(nsel));
    const int c16 = lane & 15, q4 = lane >> 4, tq = c16 >> 2, tp = c16 & 3;
    bf16x8 qf[2];
    { const bf16* qp = F_PROJ + (size_t)(b * SEQ + t) * PROJ_LD + (c16 & 7) * 64 + 8 * q4;
      qf[0] = *(const GAS bf16x8*)qp; qf[1] = *(const GAS bf16x8*)(qp + 32);
      if (c16 >= 8) { qf[0] = (bf16x8){0, 0, 0, 0, 0, 0, 0, 0}; qf[1] = qf[0]; } }
    f32x4 lg[16];
    const bf16* kbase = F_KA + (size_t)(b * SEQ) * 64 + 8 * q4;
#pragma unroll
    for (int g = 0; g < 16; ++g) {
        const int p = 16 * g + c16; const int key = (FULL || p < nsel) ? (int)idxl[p] : 0;
        const bf16* kp = kbase + (size_t)key * 64;
        const bf16x8 k0 = *(const GAS bf16x8*)kp, k1 = *(const GAS bf16x8*)(kp + 32);
        f32x4 c = {0.f, 0.f, 0.f, 0.f};
        c = __builtin_amdgcn_mfma_f32_16x16x32_bf16(k0, qf[0], c, 0, 0, 0);
        c = __builtin_amdgcn_mfma_f32_16x16x32_bf16(k1, qf[1], c, 0, 0, 0);
        if (!FULL) {
#pragma unroll
            for (int r = 0; r < 4; ++r) if (16 * g + 4 * q4 + r >= nsel) c[r] = -INFINITY; }
        lg[g] = c;
    }
    v4u vA[8];
#define V_LOAD(dst, ch_) do { _Pragma("unroll") for (int i = 0; i < 8; ++i) { const int p_ = 64 * (ch_) + (lane >> 3) + 8 * i; const int key_ = (FULL || p_ < nsel) ? (int)idxl[p_] : 0; \
        dst[i] = *(const GAS v4u*)(F_VA + (size_t)(b * SEQ + key_) * 64 + 8 * (lane & 7)); } } while (0)
    V_LOAD(vA, 0);
    float m = -INFINITY;
#pragma unroll
    for (int g = 0; g < 16; ++g) m = fmaxf(m, fmaxf(fmaxf(lg[g][0], lg[g][1]), fmaxf(lg[g][2], lg[g][3])));
    m = fmaxf(m, shx_f(m, 16, lane)); m = fmaxf(m, shx_f(m, 32, lane));
    float ssum = 0.f;
#pragma unroll
    for (int g = 0; g < 16; ++g)
#pragma unroll
        for (int r = 0; r < 4; ++r) { const float e = __builtin_amdgcn_exp2f((lg[g][r] - m) * 1.4426950408889634f); lg[g][r] = e; ssum += e; }
    ssum += shx_f(ssum, 16, lane); ssum += shx_f(ssum, 32, lane);
    const float inv = 1.0f / ssum;
    f32x4 o[4];
#pragma unroll
    for (int db = 0; db < 4; ++db) o[db] = (f32x4){0.f, 0.f, 0.f, 0.f};
#define VSWZ(row_, chunk_) ((row_) * 128 + ((((chunk_)) ^ (2 * (((row_) >> 1) & 3))) * 16))
#define V_STEP(cur, nxt, ch_, HAS_NEXT) do { \
        _Pragma("unroll") for (int i = 0; i < 8; ++i) { const int row_ = (lane >> 3) + 8 * i; *(LAS v4u*)(vl + VSWZ(row_, lane & 7)) = cur[i]; } \
        LDS_WAIT(); asm volatile("" ::: "memory"); \
        if (HAS_NEXT) V_LOAD(nxt, (ch_) + 1); \
        _Pragma("unroll") for (int ss = 0; ss < 2; ++ss) { const int s2 = 2 * (ch_) + ss; \
            v4u w4; w4.x = cvtpk_s(lg[2 * s2][0] * inv, lg[2 * s2][1] * inv); w4.y = cvtpk_s(lg[2 * s2][2] * inv, lg[2 * s2][3] * inv); \
            w4.z = cvtpk_s(lg[2 * s2 + 1][0] * inv, lg[2 * s2 + 1][1] * inv); w4.w = cvtpk_s(lg[2 * s2 + 1][2] * inv, lg[2 * s2 + 1][3] * inv); \
            const bf16x8 pa = __builtin_bit_cast(bf16x8, w4); \
            _Pragma("unroll") for (int db = 0; db < 4; ++db) { const int r0_ = 32 * ss + 4 * q4 + tq, r1_ = r0_ + 16; \
                const v4i16_t lo = vtr(vl + VSWZ(r0_, 2 * db + (tp >> 1)) + 8 * (tp & 1)), hi2 = vtr(vl + VSWZ(r1_, 2 * db + (tp >> 1)) + 8 * (tp & 1)); \
                const bf16x8 vf = (bf16x8){lo[0], lo[1], lo[2], lo[3], hi2[0], hi2[1], hi2[2], hi2[3]}; \
                o[db] = __builtin_amdgcn_mfma_f32_16x16x32_bf16(pa, vf, o[db], 0, 0, 0); } } \
        LDS_WAIT(); asm volatile("" ::: "memory"); } while (0)
    V_STEP(vA, vA, 0, true); V_STEP(vA, vA, 1, true); V_STEP(vA, vA, 2, true); V_STEP(vA, vA, 3, false);
#undef V_LOAD
#undef V_STEP
#undef VSWZ
    if (q4 < 2) { bf16* op = F_OA + (size_t)(b * SEQ + t) * 512 + (4 * q4) * 64 + c16;
#pragma unroll
        for (int db = 0; db < 4; ++db)
#pragma unroll
            for (int r = 0; r < 4; ++r) op[r * 64 + 16 * db] = (bf16)f2bf(o[db][r]); }
}
__device__ __forceinline__ void idx_load(bf16x8 (&kb)[4], const bf16* kbase, int kt) {
    const bf16* kp = kbase + (size_t)(32 * kt) * 64;
#pragma unroll
    for (int ks = 0; ks < 4; ++ks) kb[ks] = *(const GAS bf16x8*)(kp + 16 * ks);
}
__device__ __forceinline__ f32x16 idx_chain(const bf16x8 (&q)[4], const bf16x8 (&kb)[4]) {
    f32x16 c;
#pragma unroll
    for (int i = 0; i < 16; ++i) c[i] = 0.f;
#pragma unroll
    for (int ks = 0; ks < 4; ++ks) c = __builtin_amdgcn_mfma_f32_32x32x16_bf16(q[ks], kb[ks], c, 0, 0, 0);
    return c;
}
struct IdxW { f32x4 a0, a1, b0, b1; };
__device__ __forceinline__ f32x16 idx_chain_valu(const bf16x8 (&q)[4], const bf16x8 (&kb)[4], const f32x16& co, const IdxW& w, LAS _Float16* sch, int jo, int kto, int r, int hb) {
    const f32x4 wa0 = w.a0, wa1 = w.a1, wb0 = w.b0, wb1 = w.b1;
    f32x16 c;
#pragma unroll
    for (int i = 0; i < 16; ++i) c[i] = 0.f;
#pragma unroll
    for (int ks = 0; ks < 4; ++ks) c = __builtin_amdgcn_mfma_f32_32x32x16_bf16(q[ks], kb[ks], c, 0, 0, 0);
#define RL(i_) relu_i(co[i_])
    f32x2_t a0 = (f32x2_t){wa0.x, wa0.y} * (f32x2_t){RL(0), RL(1)};
    a0 = __builtin_elementwise_fma((f32x2_t){wa0.z, wa0.w}, (f32x2_t){RL(2), RL(3)}, a0); a0 = __builtin_elementwise_fma((f32x2_t){wa1.x, wa1.y}, (f32x2_t){RL(4), RL(5)}, a0); a0 = __builtin_elementwise_fma((f32x2_t){wa1.z, wa1.w}, (f32x2_t){RL(6), RL(7)}, a0);
    f32x2_t a1 = (f32x2_t){wb0.x, wb0.y} * (f32x2_t){RL(8), RL(9)};
    a1 = __builtin_elementwise_fma((f32x2_t){wb0.z, wb0.w}, (f32x2_t){RL(10), RL(11)}, a1); a1 = __builtin_elementwise_fma((f32x2_t){wb1.x, wb1.y}, (f32x2_t){RL(12), RL(13)}, a1); a1 = __builtin_elementwise_fma((f32x2_t){wb1.z, wb1.w}, (f32x2_t){RL(14), RL(15)}, a1);
#undef RL
    const float s0 = a0.x + a0.y, s1 = a1.x + a1.y;
    sch[(4 * jo + hb) * 4096 + 32 * kto + r] = (_Float16)s0; sch[(4 * jo + hb + 2) * 4096 + 32 * kto + r] = (_Float16)s1;
#pragma unroll
    for (int g = 0; g < 4; ++g) { __builtin_amdgcn_sched_group_barrier(0x008, 1, 0); __builtin_amdgcn_sched_group_barrier(0x002, 8, 0); }
    return c;
}
__device__ __forceinline__ void dsa_item16(Frame& F, int b, int t0, int stop) {
    unsigned ones_ = ~0u; asm volatile("" : "+v"(ones_));
    const int lane = (int)__builtin_amdgcn_mbcnt_hi(ones_, __builtin_amdgcn_mbcnt_lo(ones_, 0u)), wave = F.wave;
    const int L = ((t0 >> 6) + 1) << 6;
    LAS _Float16* sch = (LAS _Float16*)(F.lds + RING_OFF);
    if (L > 256) {
        const int r = lane & 31, hb = lane >> 5;
        const int head = (r & 3) + 4 * ((r >> 3) & 1), qsub = ((r >> 2) & 1) + 2 * ((r >> 4) & 1);
        bf16x8 qa[4][4];
        LAS float* wl = (LAS float*)(F.lds + HIST_OFF) + wave * 512;
        { const f32x2_t w2 = *(const GAS f32x2_t*)(F_WIQ + (size_t)(b * SEQ + t0) * 8 + 2 * lane); *(LAS f32x2_t*)(wl + 2 * lane) = w2; }
#pragma unroll
        for (int j = 0; j < 4; ++j) {
            const bf16* qp = F_PROJ + (size_t)(b * SEQ + t0 + 4 * j + qsub) * PROJ_LD + 512 + head * 64 + 8 * hb;
#pragma unroll
            for (int ks = 0; ks < 4; ++ks) qa[j][ks] = *(const GAS bf16x8*)(qp + 16 * ks);
            { float xr[8]; unpk8(qa[j][0], xr); rope_frag(xr, hb == 0, 32, lane, F_ROPE + (size_t)(t0 + 4 * j + qsub) * 16); qa[j][0] = pk8(xr); }
        }
        LDS_WAIT(); asm volatile("" ::: "memory");
        const int ntile = L >> 5;
        const bf16* kbase = F_KI + (size_t)(b * SEQ + r) * 64 + 8 * hb;
        const int nmy = (ntile - wave + 7) >> 3;
#define IDX_CL(i_) (wave + 8 * ((i_) < nmy ? (i_) : nmy - 1))
#define IDX_STAGE(cn_, jn_, kbn_, co_, jo_, kto_) do { cn_ = idx_chain_valu(qa[jn_], kbn_, co_, W[jo_], sch, jo_, kto_, r, hb); } while (0)
        if (nmy > 0) {
            bf16x8 kbA[4], kbB[4];
            idx_load(kbA, kbase, wave);
            IdxW W[4];
#pragma unroll
            for (int j = 0; j < 4; ++j) { W[j].a0 = *(const LAS f32x4*)(wl + (4 * j + hb) * 8); W[j].a1 = *(const LAS f32x4*)(wl + (4 * j + hb) * 8 + 4); W[j].b0 = *(const LAS f32x4*)(wl + (4 * j + hb + 2) * 8); W[j].b1 = *(const LAS f32x4*)(wl + (4 * j + hb + 2) * 8 + 4); }
            f32x16 c0 = idx_chain(qa[0], kbA), c1;
            int i = 0;
#pragma unroll 1
            for (;;) {
                const int ktA = wave + 8 * i, ktB = ktA + 8;
                idx_load(kbB, kbase, IDX_CL(i + 1));
                IDX_STAGE(c1, 1, kbA, c0, 0, ktA); IDX_STAGE(c0, 2, kbA, c1, 1, ktA); IDX_STAGE(c1, 3, kbA, c0, 2, ktA); IDX_STAGE(c0, 0, kbB, c1, 3, ktA);
                if (i + 1 >= nmy) break;
                idx_load(kbA, kbase, IDX_CL(i + 2));
                IDX_STAGE(c1, 1, kbB, c0, 0, ktB); IDX_STAGE(c0, 2, kbB, c1, 1, ktB); IDX_STAGE(c1, 3, kbB, c0, 2, ktB); IDX_STAGE(c0, 0, kbA, c1, 3, ktB);
                i += 2;
                if (i >= nmy) break;
            }
        }
#undef IDX_CL
#undef IDX_STAGE
    }
    __syncthreads();
    if (stop == 1) { __syncthreads(); return; }
    LAS unsigned short* idx0 = (LAS unsigned short*)(F.lds + IDX_OFF) + wave * 512;
    LAS unsigned char* vl = (LAS unsigned char*)sch + wave * 8192;
    int nsel = 256;
    const bool early = wave < 4;
#pragma unroll 1
    for (int step = 0; step < 4; ++step) {
        const bool do_sel = early ? ((step & 1) == 0) : (step < 2);
        const int qq = early ? (step >> 1) : (step & 1);
        if (do_sel) {
            int Lq = L; asm volatile("" : "+s"(Lq));
            const LAS unsigned short* rowh = (const LAS unsigned short*)sch + (wave + 8 * qq) * 4096;
            LAS unsigned short* idxl = idx0 + 256 * qq;
            if (Lq <= 256) { nsel = Lq; for (int i = lane; i < 256; i += 64) idxl[i] = (unsigned short)((i < Lq) ? i : 0); }
            else {
                LAS unsigned* hist = (LAS unsigned*)(F.lds + HIST_OFF) + wave * 512;
                bool ok;
                if (Lq <= 1024) ok = select256_h16<16>(rowh, idxl, hist, Lq, lane); else if (Lq <= 2048) ok = select256_h16<32>(rowh, idxl, hist, Lq, lane); else if (Lq <= 3072) ok = select256_h16<48>(rowh, idxl, hist, Lq, lane); else ok = select256_h16<64>(rowh, idxl, hist, Lq, lane);
                if (!ok) select256_b16<64>(rowh, idxl, Lq, lane);
            }
            LDS_WAIT(); asm volatile("" ::: "memory");
        } else if (stop != 2) {
            if (nsel == 256) dsa_attend<true>(F, b, t0 + wave + 8 * qq, 256, idx0 + 256 * qq, vl, lane); else dsa_attend<false>(F, b, t0 + wave + 8 * qq, nsel, idx0 + 256 * qq, vl, lane);
        }
    }
    __syncthreads();
}
__device__ __forceinline__ void p3_attention(Frame& F, int rep) {
    const int stop = (rep == 1 && P3_MODE >= 2) ? P3_MODE - 1 : 0;
    if (!(rep == 1 && P3_MODE >= 2)) { for (int item = blockIdx.x; item < 512; item += F.G) sb_item_mfma(F, item);
    __syncthreads(); }
    if (rep == 1 && P3_MODE == 1) return;
    {
    gu32* qh = F.ctl + CW_QUEUE + 64 * rep;
    if (F.wave == 0 && fresh_lane() == 0) F.MISC[MI_Q] = __hip_atomic_fetch_add(qh, 1u, RLX_AGENT);
    __syncthreads();
    for (int par = 0;; par ^= 1) {
        const int it = (int)F.MISC[MI_Q + par];
        if (it >= 1024) break;
        if (F.wave == 0 && fresh_lane() == 0) F.MISC[MI_Q + (par ^ 1)] = __hip_atomic_fetch_add(qh, 1u, RLX_AGENT);
        const int chunk = 63 - (it >> 4), within = it & 15, b = within >> 2, g4 = within & 3;
        dsa_item16(F, b, chunk * 64 + g4 * 16, stop);
    }
    }
}

__device__ __forceinline__ void p6_router(Frame& F, int rep) {
    const size_t sh4 = rep ? (size_t)(WS_ACT - WS_TOKE) / 4 : 0, sh2 = rep ? (size_t)(WS_Y - WS_XN) / 2 : 0;
    const int lane = F.lane, w4 = F.wave & 3, hbk = F.wave >> 2, lt = F.tid & 255, r32 = lane & 31, hb = lane >> 5;
    LAS float* hs = (LAS float*)(F.lds + hbk * 70912);
    LAS float* red = hs;
    LAS float* lgt = hs + 32 * 516;
    LAS float* rrs = lgt + 32 * 33;
    LAS int* ent = (LAS int*)(rrs + 32);
    const float* H = (F.a->out);
    for (int tile0 = blockIdx.x * 2; tile0 < NTOK / 32; tile0 += 2 * F.G) {
        const int tok0 = (tile0 + hbk) * 32;
        f32x16 acc;
#pragma unroll
        for (int i = 0; i < 16; ++i) acc[i] = 0.f;
        f32x4 st[16];
#pragma unroll
        for (int i = 0; i < 16; ++i) { const int idx = lt + 256 * i; st[i] = *(const GAS f32x4*)(H + (size_t)(tok0 + (idx >> 7)) * DM + 4 * (idx & 127)); }
#pragma unroll 1
        for (int half = 0; half < 2; ++half) {
#pragma unroll
            for (int i = 0; i < 16; ++i) { const int idx = lt + 256 * i; *(LAS f32x4*)(hs + (idx >> 7) * 516 + 4 * (idx & 127)) = st[i]; }
            __syncthreads();
            if (half == 0) {
#pragma unroll
                for (int i = 0; i < 16; ++i) { const int idx = lt + 256 * i; st[i] = *(const GAS f32x4*)(H + (size_t)(tok0 + (idx >> 7)) * DM + 512 + 4 * (idx & 127)); } }
            {
                const int kl = w4 * 128 + 64 * hb;
                const float* wp = F_WRG + (size_t)(512 * half + kl) * 32 + r32;
                const LAS float* ap = hs + r32 * 516 + kl;
#pragma unroll
                for (int c = 0; c < 4; ++c) {
                    f32x4 a4[4]; float b1[16];
#pragma unroll
                    for (int j = 0; j < 4; ++j) a4[j] = *(const LAS f32x4*)(ap + 16 * c + 4 * j);
#pragma unroll
                    for (int j = 0; j < 16; ++j) b1[j] = wp[(size_t)(16 * c + j) * 32];
#pragma unroll
                    for (int j = 0; j < 16; ++j) acc = __builtin_amdgcn_mfma_f32_32x32x2f32(a4[j >> 2][j & 3], b1[j], acc, 0, 0, 0);
                }
            }
            __syncthreads();
        }
#pragma unroll
        for (int i = 0; i < 16; ++i) red[(w4 * 32 + (i & 3) + 8 * (i >> 2) + 4 * hb) * 33 + r32] = acc[i];
        if (lt < 32) { float ssq = 0.f;
#pragma unroll
            for (int i = 0; i < 16; ++i) ssq += F_SSQP[(size_t)(tok0 + lt) * 16 + i];
            rrs[lt] = 1.0f / sqrtf(ssq * (1.f / DM) + RMS_EPS); }
        __syncthreads();
        float sums[4];
#pragma unroll
        for (int q = 0; q < 4; ++q) { const int idx = lt + 256 * q, tk = idx >> 5, e = idx & 31; float sum = 0.f;
#pragma unroll
            for (int w2 = 0; w2 < 4; ++w2) sum += red[(w2 * 32 + tk) * 33 + e];
            sums[q] = sum; }
#pragma unroll
        for (int q = 0; q < 4; ++q) { const int idx = lt + 256 * q; lgt[(idx >> 5) * 33 + (idx & 31)] = sums[q]; }
        __syncthreads();
#pragma unroll
        for (int pass = 0; pass < 4; ++pass) {
            const int tl = 8 * w4 + 2 * pass + hb;
            float v = lgt[tl * 33 + r32] * rrs[tl] + (F.a->in[10])[r32];
            float tv[4]; int te[4];
#pragma unroll
            for (int k = 0; k < 4; ++k) { float bv = v; int be = r32;
#pragma unroll
                for (int o = 1; o < 32; o <<= 1) { const float ov = __shfl_xor(bv, o); const int oe = __shfl_xor(be, o); if (ov > bv || (ov == bv && oe < be)) { bv = ov; be = oe; } }
                tv[k] = bv; te[k] = be; if (r32 == be) v = -INFINITY; }
            float gk[4], gs = 0.f;
#pragma unroll
            for (int k = 0; k < 4; ++k) { gk[k] = __expf(tv[k] - tv[0]); gs += gk[k]; }
            const float ginv = 1.0f / gs;
            if (r32 < 4) { const int m = (tok0 + tl) * 4 + r32; const int ee = r32 == 0 ? te[0] : (r32 == 1 ? te[1] : (r32 == 2 ? te[2] : te[3])); const float gg = r32 == 0 ? gk[0] : (r32 == 1 ? gk[1] : (r32 == 2 ? gk[2] : gk[3]));
                (F_TOKE + sh4)[m] = ee; (F_TOKG + sh4)[m] = gg * ginv; ent[tl * 4 + r32] = ee; }
        }
        __syncthreads();
        if (w4 == 0) {
            const int e0 = ent[lane], e1 = ent[lane + 64];
            int mycnt = 0, r0 = 0, r1 = 0;
            for (int j = 0; j < 32; ++j) { const unsigned long long m0 = __ballot(e0 == j), m1 = __ballot(e1 == j); const int c0 = __popcll(m0);
                if (e0 == j) r0 = (int)__builtin_amdgcn_mbcnt_hi((unsigned)(m0 >> 32), __builtin_amdgcn_mbcnt_lo((unsigned)m0, 0u));
                if (e1 == j) r1 = c0 + (int)__builtin_amdgcn_mbcnt_hi((unsigned)(m1 >> 32), __builtin_amdgcn_mbcnt_lo((unsigned)m1, 0u));
                if (lane == j) mycnt = c0 + __popcll(m1); }
            int mybase = 0; if (lane < 32 && mycnt > 0) mybase = (int)__hip_atomic_fetch_add(F.ctl + CW_CNT + 64 * rep + lane, (unsigned)mycnt, RLX_AGENT);
            const int p0 = __shfl(mybase, e0) + r0, p1 = __shfl(mybase, e1) + r1;
            const int m0i = tok0 * 4 + lane, m1i = tok0 * 4 + lane + 64;
            (F_TOKP + sh4)[m0i] = p0; (F_LIST + sh4)[(size_t)e0 * NTOK + p0] = m0i;
            (F_TOKP + sh4)[m1i] = p1; (F_LIST + sh4)[(size_t)e1 * NTOK + p1] = m1i;
        }
#pragma unroll 2
        for (int i = 0; i < 8; ++i) { const int tl = w4 * 8 + i; const float rr = rrs[tl];
            const GAS f32x4* hr = (const GAS f32x4*)(H + (size_t)(tok0 + tl) * DM) + lane; const GAS f32x4* gr = (const GAS f32x4*)(F.a->in[8]) + lane;
            GAS int* o4 = (GAS int*)((unsigned char*)F_XN + sh2 + (size_t)(tok0 + tl) * DM) + lane;
#pragma unroll
            for (int j = 0; j < 4; ++j) { const f32x4 v = hr[64 * j], g = gr[64 * j]; int pk = __builtin_amdgcn_cvt_pk_fp8_f32(v.x * rr * g.x, v.y * rr * g.y, 0, false); pk = __builtin_amdgcn_cvt_pk_fp8_f32(v.z * rr * g.z, v.w * rr * g.w, pk, true); o4[64 * j] = pk; } }
        __syncthreads();
    }
}
__device__ __forceinline__ void compute_ts(Frame& F) {
    if (F.tid < 32) F.MISC[MI_CNT + F.tid] = __hip_atomic_load(F.ctl + CW_CNT + F.tid, RLX_AGENT);
    __syncthreads();
    if (F.tid == 0) { unsigned run = 0; for (int e = 0; e < 32; ++e) { F.MISC[MI_TS + e] = run; run += (F.MISC[MI_CNT + e] + 255u) >> 8; } F.MISC[MI_TS + 32] = run; }
    __syncthreads();
}
__device__ __forceinline__ void p7_gather(Frame& F) {
    const int gw = blockIdx.x * NWAVES + F.wave, NGW = F.G * NWAVES; const int T = (int)F.MISC[MI_TS + 32];
    for (int r = gw; r < T * 256; r += NGW) {
        const int rt = r >> 8; int e = 0; while (e < 31 && (int)F.MISC[MI_TS + e + 1] <= rt) ++e;
        const int local = r - 256 * (int)F.MISC[MI_TS + e]; const bool valid = local < (int)F.MISC[MI_CNT + e];
        v4u a = {0u, 0u, 0u, 0u};
        if (valid) { const int tok = F_LIST[(size_t)e * NTOK + local] >> 2; a = ((const GAS v4u*)((unsigned char*)F_XN + (size_t)tok * DM))[F.lane]; }
        ((GAS v4u*)((unsigned char*)F_XG + (size_t)r * DM))[F.lane] = a;
    }
}
__device__ __forceinline__ void p10_combine(Frame& F, int rep) {
    const int gw = blockIdx.x * NWAVES + F.wave, NGW = F.G * NWAVES;
    for (int tok = gw; tok < NTOK; tok += NGW) {
        float g[4]; const unsigned char* yr[4];
#pragma unroll
        for (int k = 0; k < 4; ++k) { const int m = tok * 4 + k; const int e = F_TOKE[m]; g[k] = F_TOKG[m]; yr[k] = (const unsigned char*)F_Y + (size_t)(256 * (int)F.MISC[MI_TS + e] + F_TOKP[m]) * DM; }
        GAS f32x4* hr = (GAS f32x4*)((F.a->out) + (size_t)tok * DM) + F.lane;
#pragma unroll
        for (int j = 0; j < 4; ++j) { f32x4 v = hr[64 * j];
#pragma unroll
            for (int k = 0; k < 4; ++k) { const int y = *((const GAS int*)yr[k] + 64 * j + F.lane); const f32x2_t lo = __builtin_amdgcn_cvt_pk_f32_fp8(y, false), hi = __builtin_amdgcn_cvt_pk_f32_fp8(y, true);
                v.x += g[k] * lo.x; v.y += g[k] * lo.y; v.z += g[k] * hi.x; v.w += g[k] * hi.y; }
            if (rep) ((GAS f32x4*)(WSP(float, WS_XG) + (size_t)tok * DM) + F.lane)[64 * j] = v; else hr[64 * j] = v; }
    }
}

__global__ void __launch_bounds__(NWAVES * 64, 2) mk_fwd(Args args) {
    extern __shared__ __attribute__((aligned(16))) unsigned char lds[];
    Frame F;
    F.lds = (LAS unsigned char*)lds;
    F.MISC = (volatile LAS unsigned*)(F.lds + MISC_OFF);
    F.tid = threadIdx.x; F.lane = F.tid & 63; F.wave = __builtin_amdgcn_readfirstlane(F.tid >> 6);
    F.G = gridDim.x;
    F.a = &args;
    F.ctl = (gu32*)(args.ws + WS_CTL);
    for (int u = F.tid; u < (LDS_BYTES - LDSCTL_OFF) / 4; u += NWAVES * 64) ((LAS unsigned*)(F.lds + LDSCTL_OFF))[u] = 0u;
    __syncthreads();
    XcdBarrier bar; bar.bar = (unsigned*)(F.ctl + CW_BAR); bar.x = 0; bar.st = nullptr;
    if (N_LAUNCHES == 1) bar = xcd_barrier_post((unsigned*)(F.ctl + CW_BAR), F.MISC + MI_BAR);
    const int lo = args.ph_lo, hi = args.ph_hi;
#ifdef PHASE_ONLY
#define IN(k) ((k) == PHASE_ONLY && lo <= (k) && (k) < hi)
#else
#define IN(k) (lo <= (k) && (k) < hi)
#endif
#ifndef REPEAT_PHASE
#define REPEAT_PHASE -1
#endif
#define REFRESH() do { F.lane = fresh_lane(); F.tid = F.lane + 64 * F.wave; } while (0)
#ifndef P1_MODE
#define P1_MODE 0
#endif
#ifndef DOUBLE_BAR
#define DOUBLE_BAR 0
#endif
#define SEAM(k) do { if (IN(k) && IN((k) + 1)) { xcd_barrier(bar, F.wave == 0 && fresh_lane() == 0); if (DOUBLE_BAR) xcd_barrier(bar, F.wave == 0 && fresh_lane() == 0); } } while (0)
    const bool split = (F.G & 31) == 0 && F.G >= 64;
    const int NCV = split ? F.G / 4 : 0;
    if (IN(0)) { REFRESH(); p0_prologue(F, split ? MOE_P1_ITEMS : 0); __syncthreads(); } SEAM(0);
    if (IN(1)) { REFRESH(); pg8::Gemm g{F_XN, F_WI, NTOK, NPROJ_PAD, DM}; pg8::StaticOrder S; S.init(NTOK, NPROJ_PAD, F.G, (int)blockIdx.x);
        if (split) { const int slot = (int)blockIdx.x >> 3, xcd = (int)blockIdx.x & 7;
            if ((slot & 3) == 3) { const int cc = (slot >> 2) * 8 + xcd; if (!(P1_MODE == 1 && args.rep)) p1_convert(F, cc, NCV, MOE_P1_ITEMS); __syncthreads(); S.G = NCV; S.c = S.nwg - NCV + cc; }
            else { S.G = F.G - NCV; S.c = (slot - (slot >> 2)) * 8 + xcd; S.lim = S.nwg - NCV; } }
        if (P1_MODE == 2 && args.rep) S.lim = 0;
        pg8::EpiProj E{F_PROJ, F_SMALLF}; pg8::gemm_phase<pg8::EpiProj, pg8::StaticOrder, true, true>(F.lds + RING_OFF, g, S, E, F.wave); } SEAM(1);
    if (IN(2)) { REFRESH(); p2_prep(F, args.rep); } SEAM(2);
    if (IN(3)) { REFRESH(); p3_attention(F, args.rep); } SEAM(3);
    if (IN(4)) { REFRESH(); pg8::StaticOrder S; S.init(NTOK, DM, F.G, (int)blockIdx.x);
        { pg8::Gemm g{F_OA, F_WPA, NTOK, DM, 512}; pg8::EpiGate<true> E{F_PROJ, 2560, F_MERGED}; pg8::gemm_phase<pg8::EpiGate<true>, pg8::StaticOrder, true, true>(F.lds + RING_OFF, g, S, E, F.wave); }
        { pg8::Gemm g{F_OB, F_WPB, NTOK, DM, 512}; pg8::EpiGate<false> E{F_PROJ, 3584, F_MERGED}; pg8::gemm_phase<pg8::EpiGate<false>, pg8::StaticOrder, true, true>(F.lds + RING_OFF, g, S, E, F.wave); } } SEAM(4);
    if (IN(5)) { REFRESH(); pg8::Gemm g{F_MERGED, F_WO, NTOK, DM, DM}; pg8::StaticOrder S; S.init(NTOK, DM, F.G, (int)blockIdx.x);
        pg8::EpiOut E{(F.a->in[0]), (F.a->out), F_SSQP}; pg8::gemm_phase<pg8::EpiOut, pg8::StaticOrder, true, true>(F.lds + RING_OFF, g, S, E, F.wave); } SEAM(5);
    if (IN(6)) { REFRESH(); p6_router(F, args.rep); } SEAM(6);
    REFRESH();
    if (hi > 7) compute_ts(F);
    if (IN(8)) { REFRESH(); pg8::Gemm g{F_XN, F_WGU, 0, 2048, DM / 2}; pg8::MoeOrder S; S.init((const volatile LAS int*)(F.MISC + MI_TS), (const volatile LAS int*)(F.MISC + MI_CNT), F_LIST, 8, F.G, (int)blockIdx.x);
        pg8::EpiAct E{(F.a->in[12]), (unsigned char*)F_ACT}; pg8::gemm_phase<pg8::EpiAct, pg8::MoeOrder, true, true, true, true>(F.lds + RING_OFF, g, S, E, F.wave); } SEAM(8);
    if (IN(9)) { REFRESH(); pg8::Gemm g{F_ACT, F_WD, 0, DM, DM / 2}; pg8::MoeOrder S; S.init((const volatile LAS int*)(F.MISC + MI_TS), (const volatile LAS int*)(F.MISC + MI_CNT), F_LIST, 4, F.G, (int)blockIdx.x);
        pg8::EpiDown E{(F.a->in[14]), (unsigned char*)F_Y}; pg8::gemm_phase<pg8::EpiDown, pg8::MoeOrder, true, true, true>(F.lds + RING_OFF, g, S, E, F.wave); } SEAM(9);
    if (IN(10)) { REFRESH(); p10_combine(F, args.rep);
        if (N_LAUNCHES == 1) {
            const unsigned bad = __hip_atomic_load((gu32*)((unsigned*)(F.ctl + CW_BAR) + XB_TMO), RLX_AGENT);
            if (bad) { const float q = __builtin_nanf(""); for (size_t i = (size_t)blockIdx.x * 512 + F.tid; i < (size_t)NTOK * DM; i += (size_t)F.G * 512) (F.a->out)[i] = q; } } }
#undef IN
#undef SEAM
}

extern "C" void kernel_launch(void* const* d_in, const int* in_sizes, int n_in, void* d_out, int out_size, void* d_ws, size_t ws_size, hipStream_t stream) {
    static int grid = 0;
    if (grid == 0) {
        if (n_in != 15 || in_sizes[0] != NTOK * DM || out_size != NTOK * DM || ws_size < WS_END) { fprintf(stderr, "kernel_launch: unexpected shapes / workspace (n_in %d, in0 %d, out %d, ws %zu); nothing launched\n", n_in, n_in > 0 ? in_sizes[0] : -1, out_size, ws_size); grid = -1; return; }
        int dev = 0, cus = 0, per_cu = 0;
        if (hipGetDevice(&dev) != hipSuccess || hipDeviceGetAttribute(&cus, hipDeviceAttributeMultiprocessorCount, dev) != hipSuccess) { fprintf(stderr, "kernel_launch: device query failed\n"); grid = -1; return; }
        if (hipFuncSetAttribute((const void*)mk_fwd, hipFuncAttributeMaxDynamicSharedMemorySize, LDS_BYTES) != hipSuccess) { fprintf(stderr, "kernel_launch: hipFuncSetAttribute failed\n"); grid = -1; return; }
        if (hipOccupancyMaxActiveBlocksPerMultiprocessor(&per_cu, (const void*)mk_fwd, NWAVES * 64, LDS_BYTES) != hipSuccess || per_cu < 1) { fprintf(stderr, "kernel_launch: occupancy query says %d workgroups per CU; nothing launched\n", per_cu); (void)hipGetLastError(); grid = -1; return; }
        grid = cus;
    }
    if (grid < 0) return;
    if (hipMemsetAsync((char*)d_ws + WS_CTL, 0, CTL_ZERO_BYTES, stream) != hipSuccess) { fprintf(stderr, "kernel_launch: hipMemsetAsync failed\n"); return; }
    Args a{};
    for (int i = 0; i < 15; ++i) a.in[i] = (const float*)d_in[i];
    a.out = (float*)d_out; a.ws = (unsigned char*)d_ws;
    for (int li = 0; li < N_LAUNCHES; ++li) {
        a.ph_lo = (N_LAUNCHES == 1) ? 0 : li; a.ph_hi = (N_LAUNCHES == 1) ? N_PHASES : li + 1;
        for (int rep = 0; rep < ((N_LAUNCHES != 1 && li == REPEAT_PHASE) ? 2 : 1); ++rep) {
            a.rep = rep;
            hipLaunchKernelGGL(mk_fwd, dim3(grid), dim3(NWAVES * 64), LDS_BYTES, stream, a);
            const hipError_t le = hipPeekAtLastError();
            if (le != hipSuccess) { fprintf(stderr, "kernel_launch: launch %d failed: %s\n", li, hipGetErrorName(le)); return; }
        }
    }
}
```

```cpp
#include <hip/hip_runtime.h>
#include <cstdio>
#include <cstdint>
namespace pg8 {
#define PG8_LAS __attribute__((address_space(3)))
typedef unsigned short bf16_t;
typedef short bf16x8 __attribute__((ext_vector_type(8)));
typedef float f32x4 __attribute__((ext_vector_type(4)));
typedef unsigned u32x4 __attribute__((ext_vector_type(4)));
constexpr int BM = 256, BK = 64, HALF = 128, HTB = HALF * BK * 2  , STAGE_BYTES = 8 * HTB, NXCD = 8, WGM = 8;

__host__ __device__ __forceinline__ int lds_byte(int r, int c) { const int st = (r >> 4) * 2 + (c >> 5), rr = r & 15, cc = c & 31, ob = rr * 64 + cc * 2; return st * 1024 + (ob ^ (((ob >> 9) & 1) << 5)); }
__host__ __device__ __forceinline__ void stage_rc(int b, int& R, int& C) { const int st = b / 1024, sb = b % 1024, swz = sb ^ (((sb >> 9) & 1) << 5); R = (st >> 1) * 16 + swz / 64; C = (st & 1) * 32 + (swz % 64) / 2; }
__host__ __device__ __forceinline__ int perm32(int rho) { const int n = rho >> 4, i = rho & 15; return 8 * (i >> 2) + 4 * n + (i & 3); }

struct Unit { int pm, pn, pb, e; };
struct Gemm { const bf16_t* A; const bf16_t* Bt; int M, N, K; };

struct StaticOrder {
    int nM, nN, nwg, G, c, lim;
    __host__ __device__ void init(int M, int N, int G_, int c_) { nM = M / BM; nN = N / BM; nwg = nM * nN; G = G_; c = c_; lim = nwg; }
    __host__ __device__ bool next(int i, Unit& u) const {
        const long L = (long)i * G + c; if (L >= lim) return false;
        int wgid = (int)L; { const int q = nwg / NXCD, r = nwg % NXCD, xcd = wgid % NXCD, off = wgid / NXCD; wgid = (xcd < r ? xcd * (q + 1) : r * (q + 1) + (xcd - r) * q) + off; }
        const int nig = WGM * nN, gid = wgid / nig, fm = gid * WGM, gsz = (nM - fm) < WGM ? (nM - fm) : WGM;
        u.pm = fm + ((wgid % nig) % gsz); u.pn = (wgid % nig) / gsz; u.pb = u.pn; u.e = 0; return true;
    }
    __device__ __forceinline__ void a_ready(const Unit&) const {}
    __device__ __forceinline__ void done(const Unit&) const {}
    __device__ __forceinline__ int tok(const Unit&, int) const { return 0; }
};


__device__ __forceinline__ unsigned cvt_pk_bf16(float lo, float hi) { unsigned r; asm volatile("v_cvt_pk_bf16_f32 %0, %1, %2" : "=v"(r) : "v"(lo), "v"(hi)); return r; }
__device__ __forceinline__ float bf_lo(unsigned w) { return __uint_as_float(w << 16); }
__device__ __forceinline__ float bf_hi(unsigned w) { return __uint_as_float(w & 0xffff0000u); }
__device__ __forceinline__ float sigmoidf_(float x) { return 1.0f / (1.0f + __expf(-x)); }
__device__ __forceinline__ u32x4 pack8(const f32x4& v0, const f32x4& v1) { u32x4 w; w.x = cvt_pk_bf16(v0[0], v0[1]); w.y = cvt_pk_bf16(v0[2], v0[3]); w.z = cvt_pk_bf16(v1[0], v1[1]); w.w = cvt_pk_bf16(v1[2], v1[3]); return w; }
__device__ __forceinline__ void unpack8(const u32x4& w, f32x4& v0, f32x4& v1) { v0 = (f32x4){bf_lo(w.x), bf_hi(w.x), bf_lo(w.y), bf_hi(w.y)}; v1 = (f32x4){bf_lo(w.z), bf_hi(w.z), bf_lo(w.w), bf_hi(w.w)}; }

struct EpiProj {
    static constexpr bool PERM = true, AFTER_DRAIN = false;
    bf16_t* PROJ; float* SMALLF;
    __device__ __forceinline__ void operator()(const f32x4 (&acc)[2][2][4][2], const Unit& u, int wr, int wc, int fr, int fq) const {
        const int row0 = u.pm * BM + wr * 64 + fr, cl = wc * 32 + 8 * fq;
        if (u.pn < 18) {
            const int mode = (u.pn >= 10) ? 2 : ((u.pn == 4 || u.pn == 5) ? 1 : 0);
#pragma unroll
            for (int ai = 0; ai < 2; ++ai)
#pragma unroll
                for (int m = 0; m < 4; ++m) { bf16_t* rowp = PROJ + (size_t)(row0 + ai * HALF + m * 16) * 4608 + u.pn * BM + cl;
#pragma unroll
                    for (int bj = 0; bj < 2; ++bj) { f32x4 v0 = acc[ai][bj][m][0], v1 = acc[ai][bj][m][1];
                        if (mode == 1) { v0 = v0 * 0.125f; v1 = v1 * 0.125f; }
                        else if (mode == 2) {
#pragma unroll
                            for (int j = 0; j < 4; ++j) { v0[j] = sigmoidf_(v0[j]); v1[j] = sigmoidf_(v1[j]); } }
                        *(u32x4*)(rowp + bj * HALF) = pack8(v0, v1); } }
        } else {
#pragma unroll
            for (int ai = 0; ai < 2; ++ai)
#pragma unroll
                for (int m = 0; m < 4; ++m) { float* rowp = SMALLF + (size_t)(row0 + ai * HALF + m * 16) * 256 + cl;
#pragma unroll
                    for (int bj = 0; bj < 2; ++bj) { *(f32x4*)(rowp + bj * HALF) = acc[ai][bj][m][0]; *(f32x4*)(rowp + bj * HALF + 4) = acc[ai][bj][m][1]; } }
        }
    }
};
template <bool FIRST> struct EpiGate {
    static constexpr bool PERM = true, AFTER_DRAIN = false;
    const bf16_t* PROJ; int goff; bf16_t* MERGED;
    __device__ __forceinline__ void operator()(const f32x4 (&acc)[2][2][4][2], const Unit& u, int wr, int wc, int fr, int fq) const {
        const int row0 = u.pm * BM + wr * 64 + fr, col0 = u.pn * BM + wc * 32 + 8 * fq;
#pragma unroll
        for (int ai = 0; ai < 2; ++ai)
#pragma unroll
            for (int m = 0; m < 4; ++m) { const size_t row = (size_t)(row0 + ai * HALF + m * 16);
#pragma unroll
                for (int bj = 0; bj < 2; ++bj) { const int col = col0 + bj * HALF;
                    const u32x4 gw = *(const u32x4*)(PROJ + row * 4608 + goff + col); f32x4 g0, g1; unpack8(gw, g0, g1);
                    f32x4 v0 = acc[ai][bj][m][0] * g0, v1 = acc[ai][bj][m][1] * g1;
                    bf16_t* mp = MERGED + row * 1024 + col;
                    if (!FIRST) { const u32x4 pw = *(const u32x4*)mp; f32x4 p0, p1; unpack8(pw, p0, p1); v0 = v0 + p0; v1 = v1 + p1; }
                    *(u32x4*)mp = pack8(v0, v1); } }
    }
};
struct EpiOut {
    static constexpr bool PERM = true, AFTER_DRAIN = false;
    const float* X; float* OUT; float* SSQP;
    __device__ __forceinline__ void operator()(const f32x4 (&acc)[2][2][4][2], const Unit& u, int wr, int wc, int fr, int fq) const {
        const int row0 = u.pm * BM + wr * 64 + fr, col0 = u.pn * BM + wc * 32 + 8 * fq;
#pragma unroll
        for (int ai = 0; ai < 2; ++ai)
#pragma unroll
            for (int m = 0; m < 4; ++m) { const size_t row = (size_t)(row0 + ai * HALF + m * 16); float s = 0.f;
#pragma unroll
                for (int bj = 0; bj < 2; ++bj) { const size_t off = row * 1024 + col0 + bj * HALF;
                    const f32x4 x0 = *(const f32x4*)(X + off), x1 = *(const f32x4*)(X + off + 4);
                    const f32x4 h0 = x0 + acc[ai][bj][m][0], h1 = x1 + acc[ai][bj][m][1];
                    *(f32x4*)(OUT + off) = h0; *(f32x4*)(OUT + off + 4) = h1;
                    s += (h0[0] * h0[0] + h0[1] * h0[1]) + (h0[2] * h0[2] + h0[3] * h0[3]) + (h1[0] * h1[0] + h1[1] * h1[1]) + (h1[2] * h1[2] + h1[3] * h1[3]); }
                s += __shfl_xor(s, 16); s += __shfl_xor(s, 32);
                if (fq == 0) SSQP[row * 16 + u.pn * 4 + wc] = s; }
    }
};
struct EpiAct {
    static constexpr bool PERM = true, AFTER_DRAIN = false;
    const float* BGU; unsigned char* ACT;
    __device__ __forceinline__ void operator()(const f32x4 (&acc)[2][2][4][2], const Unit& u, int wr, int wc, int fr, int fq) const {
        const int row0 = u.pm * BM + wr * 64 + fr, j0 = u.pn * HALF + wc * 32 + 8 * fq;
        const float* bg = BGU + (size_t)u.e * 2048 + j0;
        const f32x4 bg0 = *(const f32x4*)bg, bg1 = *(const f32x4*)(bg + 4), bu0 = *(const f32x4*)(bg + 1024), bu1 = *(const f32x4*)(bg + 1028);
#pragma unroll
        for (int ai = 0; ai < 2; ++ai)
#pragma unroll
            for (int m = 0; m < 4; ++m) { f32x4 o[2];
#pragma unroll
                for (int n = 0; n < 2; ++n) { const f32x4 g = acc[ai][0][m][n] + (n ? bg1 : bg0), up = acc[ai][1][m][n] + (n ? bu1 : bu0);
#pragma unroll
                    for (int j = 0; j < 4; ++j) { const float gc = fminf(g[j], 7.0f), uc = fminf(fmaxf(up[j], -7.0f), 7.0f); o[n][j] = (uc + 1.0f) * gc * sigmoidf_(1.702f * gc); } }
                int p0 = __builtin_amdgcn_cvt_pk_fp8_f32(o[0][0], o[0][1], 0, false); p0 = __builtin_amdgcn_cvt_pk_fp8_f32(o[0][2], o[0][3], p0, true);
                int p1 = __builtin_amdgcn_cvt_pk_fp8_f32(o[1][0], o[1][1], 0, false); p1 = __builtin_amdgcn_cvt_pk_fp8_f32(o[1][2], o[1][3], p1, true);
                typedef int i32x2 __attribute__((ext_vector_type(2)));
                *(i32x2*)(ACT + (size_t)(row0 + ai * HALF + m * 16) * 1024 + j0) = (i32x2){p0, p1}; }
    }
};
struct EpiDown {
    static constexpr bool PERM = true, AFTER_DRAIN = false;
    const float* BD; unsigned char* Y;
    __device__ __forceinline__ void operator()(const f32x4 (&acc)[2][2][4][2], const Unit& u, int wr, int wc, int fr, int fq) const {
        const int row0 = u.pm * BM + wr * 64 + fr, col0 = u.pn * BM + wc * 32 + 8 * fq;
        f32x4 bv[2][2];
#pragma unroll
        for (int bj = 0; bj < 2; ++bj)
#pragma unroll
            for (int n = 0; n < 2; ++n) bv[bj][n] = *(const f32x4*)(BD + (size_t)u.e * 1024 + col0 + bj * HALF + 4 * n);
#pragma unroll
        for (int ai = 0; ai < 2; ++ai)
#pragma unroll
            for (int m = 0; m < 4; ++m) { unsigned char* rowp = Y + (size_t)(row0 + ai * HALF + m * 16) * 1024 + col0;
#pragma unroll
                for (int bj = 0; bj < 2; ++bj) { const f32x4 v0 = acc[ai][bj][m][0] + bv[bj][0], v1 = acc[ai][bj][m][1] + bv[bj][1];
                    int p0 = __builtin_amdgcn_cvt_pk_fp8_f32(v0[0], v0[1], 0, false); p0 = __builtin_amdgcn_cvt_pk_fp8_f32(v0[2], v0[3], p0, true);
                    int p1 = __builtin_amdgcn_cvt_pk_fp8_f32(v1[0], v1[1], 0, false); p1 = __builtin_amdgcn_cvt_pk_fp8_f32(v1[2], v1[3], p1, true);
                    typedef int i32x2 __attribute__((ext_vector_type(2)));
                    *(i32x2*)(rowp + bj * HALF) = (i32x2){p0, p1}; } }
    }
};
struct MoeOrder {
    const volatile PG8_LAS int* ts; const volatile PG8_LAS int* cnt; const int* LIST; int T, nN, nwg, G, c;
    __device__ void init(const volatile PG8_LAS int* ts_, const volatile PG8_LAS int* cnt_, const int* LIST_, int nN_, int G_, int c_) { ts = ts_; cnt = cnt_; LIST = LIST_; T = ts_[32]; nN = nN_; nwg = T * nN_; G = G_; c = c_; }
    __device__ __forceinline__ int tok(const Unit& u, int r) const { const int pos = 256 * (u.pm - ts[u.e]) + r; return pos < cnt[u.e] ? (LIST[(size_t)u.e * 16384 + pos] >> 2) : 0; }
    __device__ bool next(int i, Unit& u) const {
        const long L = (long)i * G + c; if (L >= nwg) return false;
        int wgid = (int)L; { const int q = nwg / NXCD, r = nwg % NXCD, xcd = wgid % NXCD, off = wgid / NXCD; wgid = (xcd < r ? xcd * (q + 1) : r * (q + 1) + (xcd - r) * q) + off; }
        const int nig = WGM * nN, gid = wgid / nig, fm = gid * WGM, gsz = (T - fm) < WGM ? (T - fm) : WGM;
        u.pm = fm + ((wgid % nig) % gsz); u.pn = (wgid % nig) / gsz;
        int e = 0; while (e < 31 && ts[e + 1] <= u.pm) ++e;
        u.e = e; u.pb = e * nN + u.pn; return true;
    }
    __device__ __forceinline__ void a_ready(const Unit&) const {}
    __device__ __forceinline__ void done(const Unit&) const {}
};

typedef int v4i_t __attribute__((ext_vector_type(4))); typedef int v8i_t __attribute__((ext_vector_type(8)));
__device__ __forceinline__ v8i_t cat8(bf16x8 a, bf16x8 b) { const v4i_t x = __builtin_bit_cast(v4i_t, a), y = __builtin_bit_cast(v4i_t, b); return __builtin_shufflevector(x, y, 0, 1, 2, 3, 4, 5, 6, 7); }
__device__ __forceinline__ void mfma_f8(f32x4& acc, const v8i_t& wfrag, const v8i_t& afrag) {
    asm volatile("s_nop 1\n\tv_mfma_scale_f32_16x16x128_f8f6f4 %0, %1, %2, %0, %3, %4 op_sel_hi:[0,0,0]" : "+v"(acc) : "v"(wfrag), "v"(afrag), "v"(0x7a7a7a7a), "v"(0x7f7f7f7f));
}
template <class Epi, class Sched, bool ALIGN_EPI = false, bool SP2 = false, bool FP8 = false, bool GATHER = false>
__device__ __forceinline__ void gemm_phase(PG8_LAS unsigned char* lds, const Gemm g, const Sched& S, const Epi& E, const int wave_id) {
    unsigned ones_ = ~0u; asm volatile("" : "+v"(ones_));
    const int wid = wave_id, tid = (int)__builtin_amdgcn_mbcnt_hi(ones_, __builtin_amdgcn_mbcnt_lo(ones_, 0u)) + 64 * wave_id, lane = tid & 63, wr = wid >> 2, wc = wid & 3, fr = lane & 15, fq = lane >> 4;
    const int K = g.K, nt = K / BK;
    unsigned voffA[2], voffB[2]; int stR[2], stC[2];
#pragma unroll
    for (int i = 0; i < 2; ++i) { int R, C; stage_rc(tid * 16 + i * 8192, R, C); const int Rb = Epi::PERM ? ((R & ~31) + perm32(R & 31)) : R;
        voffA[i] = (unsigned)(R * K + C) * 2u; voffB[i] = (unsigned)(Rb * K + C) * 2u; stR[i] = R; stC[i] = C; }
    const size_t kstep = (size_t)(BK * 2);
    const size_t hstep = (size_t)HALF * K * 2;
    const size_t tstep = 2 * hstep;
    const unsigned ldsw = (unsigned)wid * 1024u;
    const int aoff = lds_byte(wr * 64 + fr, fq * 8), boff = lds_byte(wc * 32 + fr, fq * 8);
#define PG8_SA(b, h) (((b) * 2 + (h)) * HTB)
#define PG8_SB(b, h) ((4 + (b) * 2 + (h)) * HTB)
#define PG8_STAGE(bufoff, gbase, voff) do { _Pragma("unroll") for (int _i = 0; _i < 2; ++_i) \
        __builtin_amdgcn_global_load_lds((const unsigned*)((const char*)(gbase) + (voff)[_i]), (PG8_LAS unsigned*)(lds + (bufoff) + ldsw + _i * 8192), 16, 0, 0); } while (0)
#define PG8_LDA(dst, b, h) do { _Pragma("unroll") for (int m = 0; m < 4; ++m) { _Pragma("unroll") for (int k = 0; k < 2; ++k) dst[m][k] = *(const PG8_LAS bf16x8*)(lds + PG8_SA(b, h) + aoff + m * 2048 + k * 1024); if constexpr (FP8) dst##8[m] = cat8(dst[m][0], dst[m][1]); } } while (0)
#define PG8_LDB(dst, b, h) do { _Pragma("unroll") for (int n = 0; n < 2; ++n) { _Pragma("unroll") for (int k = 0; k < 2; ++k) dst[n][k] = *(const PG8_LAS bf16x8*)(lds + PG8_SB(b, h) + boff + n * 2048 + k * 1024); if constexpr (FP8) dst##8[n] = cat8(dst[n][0], dst[n][1]); } } while (0)
#define PG8_MMA(ai, bj, At, Bt) do { __builtin_amdgcn_s_setprio(1); _Pragma("unroll") for (int m = 0; m < 4; ++m) _Pragma("unroll") for (int n = 0; n < 2; ++n) { \
        if constexpr (FP8) { mfma_f8(acc[ai][bj][m][n], Bt##8[n], At##8[m]); } \
        else { _Pragma("unroll") for (int k = 0; k < 2; ++k) acc[ai][bj][m][n] = __builtin_amdgcn_mfma_f32_16x16x32_bf16(Bt[n][k], At[m][k], acc[ai][bj][m][n], 0, 0, 0); } } \
        __builtin_amdgcn_s_setprio(0); } while (0)
#define PG8_WAIT_V(n) asm volatile("s_waitcnt vmcnt(" #n ")" ::: "memory")
#define PG8_WAIT_L(n) asm volatile("s_waitcnt lgkmcnt(" #n ")" ::: "memory")
#define PG8_BAR __builtin_amdgcn_s_barrier()
#define PG8_SCHED __builtin_amdgcn_sched_barrier(0)
    Unit cur, nxt; int ui = 0;
    if (!S.next(0, cur)) return;
    f32x4 acc[2][2][4][2];
#pragma unroll
    for (int a = 0; a < 2; ++a)
#pragma unroll
        for (int b = 0; b < 2; ++b)
#pragma unroll
            for (int m = 0; m < 4; ++m)
#pragma unroll
                for (int n = 0; n < 2; ++n) acc[a][b][m][n] = (f32x4){0.f, 0.f, 0.f, 0.f};
    bf16x8 At[4][2], B0[2][2], B1[2][2]; v8i_t At8[4], B08[2], B18[2];
    const char* cA = GATHER ? (const char*)g.A : (const char*)g.A + (size_t)cur.pm * tstep; const char* cB = (const char*)g.Bt + (size_t)cur.pb * tstep;
    unsigned vC[2][2], vN[2][2];
#define PG8_GROWS(V, u_) do { _Pragma("unroll") for (int h_ = 0; h_ < 2; ++h_) _Pragma("unroll") for (int i_ = 0; i_ < 2; ++i_) V[h_][i_] = (unsigned)S.tok(u_, 128 * h_ + stR[i_]) * (unsigned)(K * 2) + (unsigned)stC[i_] * 2u; } while (0)
    if constexpr (GATHER) { PG8_GROWS(vC, cur); }
    else {
#pragma unroll
        for (int h_ = 0; h_ < 2; ++h_)
#pragma unroll
            for (int i_ = 0; i_ < 2; ++i_) vC[h_][i_] = voffA[i_] + (unsigned)(h_ * hstep); }
#pragma unroll
    for (int h_ = 0; h_ < 2; ++h_)
#pragma unroll
        for (int i_ = 0; i_ < 2; ++i_) vN[h_][i_] = vC[h_][i_];
    S.a_ready(cur);
    if constexpr (SP2) {
        PG8_STAGE(PG8_SB(0, 0), cB, voffB); PG8_STAGE(PG8_SB(0, 1), cB + hstep, voffB); PG8_STAGE(PG8_SA(0, 0), cA, vC[0]); PG8_STAGE(PG8_SA(0, 1), cA, vC[1]);
        if (wr == 1) PG8_BAR;
        PG8_WAIT_V(2); PG8_BAR;
        PG8_STAGE(PG8_SB(1, 0), cB + kstep, voffB); PG8_STAGE(PG8_SA(1, 0), cA + kstep, vC[0]); PG8_STAGE(PG8_SB(1, 1), cB + hstep + kstep, voffB);
        PG8_WAIT_V(6); PG8_BAR;
    } else {
        PG8_STAGE(PG8_SB(0, 0), cB, voffB); PG8_STAGE(PG8_SA(0, 0), cA, vC[0]); PG8_STAGE(PG8_SB(0, 1), cB + hstep, voffB); PG8_STAGE(PG8_SA(0, 1), cA, vC[1]);
        if (wr == 1) PG8_BAR;
        PG8_WAIT_V(4); PG8_BAR;
        PG8_STAGE(PG8_SB(1, 0), cB + kstep, voffB); PG8_STAGE(PG8_SA(1, 0), cA + kstep, vC[0]); PG8_STAGE(PG8_SB(1, 1), cB + hstep + kstep, voffB);
        PG8_WAIT_V(6); PG8_BAR;
    }
    for (;;) {
        const bool has_next = S.next(ui + 1, nxt);
        if constexpr (GATHER) { if (has_next) { PG8_GROWS(vN, nxt); } }
        const char* nA = has_next ? (GATHER ? (const char*)g.A : (const char*)g.A + (size_t)nxt.pm * tstep) : cA; const char* nB = has_next ? (const char*)g.Bt + (size_t)nxt.pb * tstep : cB;
        for (int t = 0; t < nt; t += 2) {
            const bool last = (t == nt - 2);
            const char* a1 = cA + (size_t)(t + 1) * kstep;
            const char* a2 = last ? nA : cA + (size_t)(t + 2) * kstep; const char* b2 = last ? nB : cB + (size_t)(t + 2) * kstep;
            const char* a3 = a2 + kstep; const char* b3 = b2 + kstep;
            unsigned vS[2][2];
#pragma unroll
            for (int h_ = 0; h_ < 2; ++h_)
#pragma unroll
                for (int i_ = 0; i_ < 2; ++i_) vS[h_][i_] = (GATHER && last) ? vN[h_][i_] : vC[h_][i_];
            if (last && has_next) S.a_ready(nxt);
            if constexpr (SP2) {
            PG8_LDB(B0, 0, 0); PG8_LDB(B1, 0, 1); PG8_SCHED; PG8_LDA(At, 0, 0); PG8_STAGE(PG8_SA(1, 1), a1, vC[1]);
            PG8_WAIT_V(8); PG8_WAIT_L(0); PG8_BAR; PG8_MMA(0, 0, At, B0); PG8_MMA(0, 1, At, B1); PG8_BAR; PG8_SCHED;
            PG8_LDA(At, 0, 1); PG8_STAGE(PG8_SB(0, 0), b2, voffB); PG8_STAGE(PG8_SB(0, 1), b2 + hstep, voffB); PG8_STAGE(PG8_SA(0, 0), a2, vS[0]);
            PG8_WAIT_V(8); PG8_WAIT_L(0); PG8_BAR; PG8_MMA(1, 0, At, B0); PG8_MMA(1, 1, At, B1); PG8_BAR; PG8_SCHED;
            PG8_LDB(B0, 1, 0); PG8_LDB(B1, 1, 1); PG8_SCHED; PG8_LDA(At, 1, 0); PG8_STAGE(PG8_SA(0, 1), a2, vS[1]);
            PG8_WAIT_V(8); PG8_WAIT_L(0); PG8_BAR; PG8_MMA(0, 0, At, B0); PG8_MMA(0, 1, At, B1); PG8_BAR; PG8_SCHED;
            PG8_LDA(At, 1, 1); PG8_STAGE(PG8_SB(1, 0), b3, voffB); PG8_STAGE(PG8_SB(1, 1), b3 + hstep, voffB); PG8_STAGE(PG8_SA(1, 0), a3, vS[0]);
            PG8_WAIT_V(8); PG8_WAIT_L(0); PG8_BAR; PG8_MMA(1, 0, At, B0); PG8_MMA(1, 1, At, B1); PG8_BAR; PG8_SCHED;
            } else {
            PG8_LDB(B0, 0, 0); PG8_SCHED; PG8_LDA(At, 0, 0); PG8_STAGE(PG8_SA(1, 1), a1, vC[1]);
            PG8_WAIT_L(8); PG8_BAR; PG8_WAIT_L(0); PG8_MMA(0, 0, At, B0); PG8_BAR; PG8_SCHED;
            PG8_LDB(B1, 0, 1); PG8_STAGE(PG8_SB(0, 0), b2, voffB);
            PG8_BAR; PG8_WAIT_L(0); PG8_MMA(0, 1, At, B1); PG8_BAR;
            PG8_LDA(At, 0, 1); PG8_STAGE(PG8_SA(0, 0), a2, vS[0]);
            PG8_BAR; PG8_WAIT_L(0); PG8_MMA(1, 0, At, B0); PG8_BAR; PG8_SCHED;
            PG8_STAGE(PG8_SB(0, 1), b2 + hstep, voffB);
            PG8_WAIT_V(6); PG8_BAR; PG8_MMA(1, 1, At, B1); PG8_BAR;
            PG8_LDB(B0, 1, 0); PG8_SCHED; PG8_LDA(At, 1, 0); PG8_STAGE(PG8_SA(0, 1), a2, vS[1]);
            PG8_WAIT_L(8); PG8_BAR; PG8_WAIT_L(0); PG8_MMA(0, 0, At, B0); PG8_BAR; PG8_SCHED;
            PG8_LDB(B1, 1, 1); PG8_STAGE(PG8_SB(1, 0), b3, voffB);
            PG8_BAR; PG8_WAIT_L(0); PG8_MMA(0, 1, At, B1); PG8_BAR;
            PG8_LDA(At, 1, 1); PG8_STAGE(PG8_SA(1, 0), a3, vS[0]);
            PG8_BAR; PG8_WAIT_L(0); PG8_MMA(1, 0, At, B0); PG8_BAR; PG8_SCHED;
            PG8_STAGE(PG8_SB(1, 1), b3 + hstep, voffB);
            PG8_WAIT_V(6); PG8_BAR; PG8_MMA(1, 1, At, B1); PG8_BAR;
            }
        }
        if constexpr (FP8) asm volatile("s_nop 15\n\ts_nop 15" ::: "memory");
        if constexpr (ALIGN_EPI) { if (wr == 0) PG8_BAR; }
        if constexpr (!Epi::AFTER_DRAIN) { E(acc, cur, wr, wc, fr, fq); S.done(cur); }
        if (!has_next) break;
#pragma unroll
        for (int a = 0; a < 2; ++a)
#pragma unroll
            for (int b = 0; b < 2; ++b)
#pragma unroll
                for (int m = 0; m < 4; ++m)
#pragma unroll
                    for (int n = 0; n < 2; ++n) acc[a][b][m][n] = (f32x4){0.f, 0.f, 0.f, 0.f};
        cur = nxt; cA = nA; cB = nB; ++ui;
        if constexpr (GATHER) {
#pragma unroll
            for (int h_ = 0; h_ < 2; ++h_)
#pragma unroll
                for (int i_ = 0; i_ < 2; ++i_) vC[h_][i_] = vN[h_][i_]; }
        if constexpr (ALIGN_EPI) { if (wr == 1) PG8_BAR; }
    }
    PG8_WAIT_V(0);
    if constexpr (!ALIGN_EPI) { if (wr == 0) PG8_BAR; }
    PG8_BAR;
    if constexpr (Epi::AFTER_DRAIN) { E.fused(acc, cur, wr, wc, fr, fq, lds, wid, lane); S.done(cur); }
#undef PG8_GROWS
#undef PG8_SA
#undef PG8_SB
#undef PG8_STAGE
#undef PG8_LDA
#undef PG8_LDB
#undef PG8_MMA
#undef PG8_WAIT_V
#undef PG8_WAIT_L
#undef PG8_BAR
#undef PG8_SCHED
}
}

constexpr int NWAVES = 8;
#ifndef MK_N_LAUNCHES
#define MK_N_LAUNCHES 1
#endif
constexpr int N_PHASES = 11;
constexpr int N_LAUNCHES = MK_N_LAUNCHES;

constexpr int NB = 4, SEQ = 4096, DM = 1024, NTOK = NB * SEQ;
constexpr int NPROJ = 4808, NPROJ_PAD = 4864, PROJ_LD = 4608;
constexpr int NEXP = 32, MAXTILES = 288;
constexpr float RMS_EPS = 1e-6f;

constexpr size_t MiB = 1u << 20;
constexpr size_t WS_CTL = 0, CTL_ZERO_BYTES = 1 * MiB;
constexpr size_t WS_WI = 2 * MiB, WS_WPA = 12 * MiB, WS_WPB = 13 * MiB, WS_WO = 14 * MiB, WS_WGU = 16 * MiB, WS_WD = 144 * MiB;
constexpr size_t WS_XN = 208 * MiB, WS_PROJ = 240 * MiB, WS_SMALLF = 384 * MiB, WS_KA = 400 * MiB, WS_VA = 402 * MiB, WS_KI = 404 * MiB, WS_WIQ = 406 * MiB;
constexpr size_t WS_OA = 408 * MiB, WS_OB = 424 * MiB, WS_MERGED = 440 * MiB, WS_SSQP = 472 * MiB;
constexpr size_t WS_TOKE = 473 * MiB, WS_TOKG = WS_TOKE + 256 * 1024, WS_TOKP = WS_TOKG + 256 * 1024, WS_LIST = 474 * MiB;
constexpr size_t WS_WRG = 478 * MiB;
constexpr size_t WS_ROPE = 479 * MiB;
constexpr size_t WS_XG = 480 * MiB, WS_ACT = 624 * MiB, WS_Y = 768 * MiB, WS_END = 912 * MiB;
constexpr int CW_TMO = 0, CW_CODE = 1;
constexpr int CW_BAR = 4096;
constexpr int CW_CNT = 8192;
constexpr int CW_QUEUE = 8448;
constexpr int CW_WDQ = 8576;
constexpr int RING_OFF = 0, RING_BYTES = 131072;
constexpr int IDX_OFF = 131072;
constexpr int HIST_OFF = 139264;
constexpr int LDSCTL_OFF = 155648, MISC_OFF = LDSCTL_OFF + 320;
constexpr int LDS_BYTES = 159744;
constexpr int MI_BAR = 8, MI_TS = 16  , MI_CNT = 64  , MI_Q = 100, MI_STAMP = 104  ;

#define GAS __attribute__((address_space(1)))
#define LAS __attribute__((address_space(3)))
typedef unsigned short bf16;
typedef unsigned v4u __attribute__((ext_vector_type(4)));
typedef float f32x4 __attribute__((ext_vector_type(4)));
typedef short bf16x8 __attribute__((ext_vector_type(8)));
typedef GAS unsigned gu32;
typedef GAS unsigned long long gu64;
#define RLX_AGENT __ATOMIC_RELAXED, __HIP_MEMORY_SCOPE_AGENT
#define LDS_WAIT() asm volatile("s_waitcnt lgkmcnt(0)" ::: "memory")
#define VM_WAIT() asm volatile("s_waitcnt vmcnt(0)" ::: "memory")
__device__ __forceinline__ unsigned long long rt() { return __builtin_amdgcn_s_memrealtime(); }
__device__ __forceinline__ unsigned f2bf(float f) { unsigned u = __builtin_bit_cast(unsigned, f); return (u + 0x7fffu + ((u >> 16) & 1u)) >> 16; }
__device__ __forceinline__ unsigned pk2(float lo, float hi) { return f2bf(lo) | (f2bf(hi) << 16); }

#define XB_TMO      128
#define XB_XCNT(j)  (256  + 64 * (j))
#define XB_XSUB(j)  (1280 + 64 * (j))
#define XB_XGEN(j)  (2304 + 64 * (j))
#define XB_TOP      3328
#define XB_TOPGEN   3392
#define XCD_BAR_WORDS 3456
#define XB_SPIN_CAP (1u << 18)

__device__ __forceinline__ unsigned xb_ld(unsigned* p)              { return __hip_atomic_load(p, __ATOMIC_RELAXED, __HIP_MEMORY_SCOPE_AGENT); }
__device__ __forceinline__ unsigned xb_add(unsigned* p, unsigned v) { return __hip_atomic_fetch_add(p, v, __ATOMIC_RELAXED, __HIP_MEMORY_SCOPE_AGENT); }
__device__ __forceinline__ unsigned xb_xcc_id() { return (unsigned)__builtin_amdgcn_s_getreg((3 << 11) | 20) & 0xFu; }
#define XB_SPIN(cond, bar) do { unsigned _sp = 0; while (cond) { __builtin_amdgcn_s_sleep(1); \
    if ((++_sp & 255u) == 0u) { if (xb_ld(&(bar)[XB_TMO])) break; if (_sp > XB_SPIN_CAP) { atomicAdd(&(bar)[XB_TMO], 1u); break; } } } } while (0)

struct XcdBarrier {
    unsigned* bar; unsigned x;
    volatile LAS unsigned* st;
};

__device__ __forceinline__ XcdBarrier xcd_barrier_post(unsigned* bar, volatile LAS unsigned* st) {
    XcdBarrier b; b.bar = bar; b.x = xb_xcc_id(); b.st = st;
    if (threadIdx.x == 0) (void)xb_add(&bar[XB_XCNT(b.x)], 1u);
    return b;
}
__device__ __forceinline__ void xcd_barrier_complete(unsigned* bar, unsigned x, unsigned& nloc, unsigned& nx) {
    const unsigned G = gridDim.x * gridDim.y * gridDim.z;
    unsigned sum, cnt, mine, sp = 0u;
    for (;;) {
        sum = 0u; cnt = 0u; mine = 0u;
#pragma unroll
        for (unsigned j = 0; j < 16; ++j) { const unsigned c = xb_ld(&bar[XB_XCNT(j)]); sum += c; cnt += (c > 0u) ? 1u : 0u; mine = (j == x) ? c : mine; }
        if (sum == G) break;
        __builtin_amdgcn_s_sleep(1);
        if ((++sp & 255u) == 0u) { if (xb_ld(&bar[XB_TMO])) break; if (sp > XB_SPIN_CAP) { atomicAdd(&bar[XB_TMO], 1u); break; } }
    }
    nloc = mine > 0u ? mine : 1u; nx = cnt > 0u ? cnt : 1u;
}

__device__ __forceinline__ void xcd_barrier(const XcdBarrier& b, const bool lead  ) {
    asm volatile("s_waitcnt vmcnt(0)" ::: "memory");
    __syncthreads();
    if (lead) {
        unsigned* bar = b.bar;
        __builtin_amdgcn_s_waitcnt(0);
        unsigned nloc = b.st[0], nx = b.st[1];
        if (nloc == 0u) { xcd_barrier_complete(bar, b.x, nloc, nx); b.st[0] = nloc; b.st[1] = nx; }
        const unsigned old = xb_add(&bar[XB_XSUB(b.x)], 1u);
        const unsigned gen = old / nloc;
        if (old + 1u == (gen + 1u) * nloc) {
            __builtin_amdgcn_fence(__ATOMIC_RELEASE, "agent");
            asm volatile("s_waitcnt vmcnt(0)" ::: "memory");
            const unsigned og = xb_add(&bar[XB_TOP], 1u);
            const unsigned tg = og / nx;
            if (og + 1u == (tg + 1u) * nx) xb_add(&bar[XB_TOPGEN], 1u);
            else XB_SPIN(xb_ld(&bar[XB_TOPGEN]) == tg, bar);
            __builtin_amdgcn_fence(__ATOMIC_ACQUIRE, "agent");
            xb_add(&bar[XB_XGEN(b.x)], 1u);
            asm volatile("s_waitcnt vmcnt(0)" ::: "memory");
        } else {
            XB_SPIN(xb_ld(&bar[XB_XGEN(b.x)]) == gen, bar);
            __builtin_amdgcn_fence(__ATOMIC_ACQUIRE, "agent");
            asm volatile("s_waitcnt vmcnt(0)" ::: "memory");
        }
    }
    __syncthreads();
}


__device__ __forceinline__ float bf2f(unsigned short b) { return __uint_as_float((unsigned)b << 16); }
__device__ __forceinline__ float bflo(unsigned w) { return __uint_as_float(w << 16); }
__device__ __forceinline__ float bfhi(unsigned w) { return __uint_as_float(w & 0xffff0000u); }

struct Args { const float* in[15]; float* out; unsigned char* ws; int ph_lo, ph_hi, rep, pad; };
struct Frame {
    const Args* a;
    LAS unsigned char* lds;
    volatile LAS unsigned* MISC;
    gu32* ctl;
    int tid, lane, wave;
    int G;
};
#define WSP(T, off) ((T*)((F.a->ws) + (off)))
#define F_WI WSP(bf16, WS_WI)
#define F_WPA WSP(bf16, WS_WPA)
#define F_WPB WSP(bf16, WS_WPB)
#define F_WO WSP(bf16, WS_WO)
#define F_WGU WSP(bf16, WS_WGU)
#define F_WD WSP(bf16, WS_WD)
#define F_XN WSP(bf16, WS_XN)
#define F_PROJ WSP(bf16, WS_PROJ)
#define F_KA WSP(bf16, WS_KA)
#define F_VA WSP(bf16, WS_VA)
#define F_KI WSP(bf16, WS_KI)
#define F_OA WSP(bf16, WS_OA)
#define F_OB WSP(bf16, WS_OB)
#define F_MERGED WSP(bf16, WS_MERGED)
#define F_XG WSP(bf16, WS_XG)
#define F_ACT WSP(bf16, WS_ACT)
#define F_Y WSP(bf16, WS_Y)
#define F_SMALLF WSP(float, WS_SMALLF)
#define F_WIQ WSP(float, WS_WIQ)
#define F_SSQP WSP(float, WS_SSQP)
#define F_TOKG WSP(float, WS_TOKG)
#define F_TOKE WSP(int, WS_TOKE)
#define F_TOKP WSP(int, WS_TOKP)
#define F_LIST WSP(int, WS_LIST)
#define F_WRG WSP(float, WS_WRG)
#define F_ROPE WSP(float, WS_ROPE)

__device__ __forceinline__ int fresh_lane() { unsigned ones_ = ~0u; asm volatile("" : "+v"(ones_)); return (int)__builtin_amdgcn_mbcnt_hi(ones_, __builtin_amdgcn_mbcnt_lo(ones_, 0u)); }
__device__ __forceinline__ float wave_sum(float v) {
#pragma unroll
    for (int o = 1; o < 64; o <<= 1) v += __shfl_xor(v, o);
    return v;
}
__device__ __forceinline__ float wave_max(float v) {
#pragma unroll
    for (int o = 1; o < 64; o <<= 1) v = fmaxf(v, __shfl_xor(v, o));
    return v;
}

__device__ __forceinline__ int wi_rowmap(int n) {
    if (n < 512) return n;
    if (n < 576) return 4608 + (n - 512);
    if (n < 640) return 4672 + (n - 576);
    if (n < 1152) return 512 + (n - 640);
    if (n < 1216) return 4736 + (n - 1152);
    if (n < 1224) return 4800 + (n - 1216);
    if (n < 1736) return 1024 + (n - 1224);
    if (n < 2248) return 1536 + (n - 1736);
    if (n < 2760) return 2048 + (n - 2248);
    if (n < 3784) return 2560 + (n - 2760);
    return 3584 + (n - 3784);
}
template <int MAP> __device__ __forceinline__ void transpose_item(const float* W, int K, int N, bf16* WT, int row_base, LAS float* scr, int item, int lane) {
    const int nblk = (N + 31) / 32, kb = item / nblk, nb = item % nblk, k0 = 64 * kb, n0 = 32 * nb;
    const int nsrc = n0 + (lane & 31); const bool ok = nsrc < N; const int ncl = ok ? nsrc : 0;
#pragma unroll 8
    for (int i = 0; i < 32; ++i) { const int kk = 2 * i + (lane >> 5); const float v = W[(size_t)(k0 + kk) * N + ncl]; scr[kk * 33 + (lane & 31)] = v; }
    LDS_WAIT(); asm volatile("" ::: "memory");
    const int c = lane & 7;
#pragma unroll
    for (int j = 0; j < 4; ++j) { const int nl = (lane >> 3) + 8 * j, n = n0 + nl; const LAS float* s = scr + (8 * c) * 33 + nl;
        if (n < N) { int dr;
            if (MAP == 0) dr = n; else if (MAP == 1) dr = wi_rowmap(n); else { const int jj = n & 1023; dr = 256 * (jj >> 7) + 128 * (n >> 10) + (jj & 127); }
            v4u o; o.x = pk2(s[0 * 33], s[1 * 33]); o.y = pk2(s[2 * 33], s[3 * 33]); o.z = pk2(s[4 * 33], s[5 * 33]); o.w = pk2(s[6 * 33], s[7 * 33]);
            *(GAS v4u*)(WT + (size_t)(row_base + dr) * K + k0 + 8 * c) = o; } }
    LDS_WAIT(); asm volatile("" ::: "memory");
}
template <int MAP> __device__ __forceinline__ void transpose_item_f8(const float* W, int K, int N, unsigned char* WT, int row_base, LAS float* scr, int item, int lane, float scale) {
    const int nblk = (N + 31) / 32, kb = item / nblk, nb = item % nblk, k0 = 64 * kb, n0 = 32 * nb;
    const int nsrc = n0 + (lane & 31); const bool ok = nsrc < N; const int ncl = ok ? nsrc : 0;
#pragma unroll 8
    for (int i = 0; i < 32; ++i) { const int kk = 2 * i + (lane >> 5); const float v = W[(size_t)(k0 + kk) * N + ncl]; scr[kk * 33 + (lane & 31)] = v; }
    LDS_WAIT(); asm volatile("" ::: "memory");
    const int c = lane & 7;
#pragma unroll
    for (int j = 0; j < 4; ++j) { const int nl = (lane >> 3) + 8 * j, n = n0 + nl; const LAS float* s = scr + (8 * c) * 33 + nl;
        if (n < N) { int dr;
            if (MAP == 0) dr = n; else { const int jj = n & 1023; dr = 256 * (jj >> 7) + 128 * (n >> 10) + (jj & 127); }
            int lo = __builtin_amdgcn_cvt_pk_fp8_f32(s[0 * 33] * scale, s[1 * 33] * scale, 0, false); lo = __builtin_amdgcn_cvt_pk_fp8_f32(s[2 * 33] * scale, s[3 * 33] * scale, lo, true);
            int hi = __builtin_amdgcn_cvt_pk_fp8_f32(s[4 * 33] * scale, s[5 * 33] * scale, 0, false); hi = __builtin_amdgcn_cvt_pk_fp8_f32(s[6 * 33] * scale, s[7 * 33] * scale, hi, true);
            typedef int i32x2 __attribute__((ext_vector_type(2)));
            *(GAS i32x2*)(WT + (size_t)(row_base + dr) * K + k0 + 8 * c) = (i32x2){lo, hi}; } }
    LDS_WAIT(); asm volatile("" ::: "memory");
}
template <int MAP> __device__ __forceinline__ void convert_item_f8(const float* W, int K, int N, unsigned char* WT, int row_base, LAS unsigned char* tile, int item, int lane, float scale) {
    const int nblk = N / 64, kb = item / nblk, nb = item % nblk, k0 = 128 * kb, n0 = 64 * nb, ng = lane & 15, ko = lane >> 4;
    const float* src = W + (size_t)(k0 + 8 * ko) * N + n0 + 4 * ng;
    typedef int i32x2 __attribute__((ext_vector_type(2)));
#pragma unroll
    for (int q = 0; q < 4; ++q) {
        f32x4 v[8];
#pragma unroll
        for (int k = 0; k < 8; ++k) v[k] = *(const GAS f32x4*)(src + (size_t)(32 * q + k) * N);
#pragma unroll
        for (int j = 0; j < 4; ++j) {
            int lo = __builtin_amdgcn_cvt_pk_fp8_f32(v[0][j] * scale, v[1][j] * scale, 0, false); lo = __builtin_amdgcn_cvt_pk_fp8_f32(v[2][j] * scale, v[3][j] * scale, lo, true);
            int hi = __builtin_amdgcn_cvt_pk_fp8_f32(v[4][j] * scale, v[5][j] * scale, 0, false); hi = __builtin_amdgcn_cvt_pk_fp8_f32(v[6][j] * scale, v[7][j] * scale, hi, true);
            *(LAS i32x2*)(tile + (4 * ng + j) * 144 + 32 * q + 8 * ko) = (i32x2){lo, hi}; }
    }
    LDS_WAIT(); asm volatile("" ::: "memory");
#pragma unroll
    for (int i = 0; i < 8; ++i) { const int rl = (lane >> 3) + 8 * i, n = n0 + rl; int dr; if (MAP == 0) dr = n; else { const int jj = n & 1023; dr = 256 * (jj >> 7) + 128 * (n >> 10) + (jj & 127); }
        const v4u w = *(const LAS v4u*)(tile + rl * 144 + 16 * (lane & 7));
        *(GAS v4u*)(WT + (size_t)(row_base + dr) * K + k0 + 16 * (lane & 7)) = w; }
    LDS_WAIT(); asm volatile("" ::: "memory");
}
template <int MAP> __device__ __forceinline__ void convert_stream_f8(const float* Wall, int N, int items_per_e, unsigned char* WT, LAS unsigned char* tile, int first, int stride, int end, int lane, float scale) {
    if (first >= end) return;
    const int ng = lane & 15, ko = lane >> 4, nblk = N / 64;
    typedef int i32x2 __attribute__((ext_vector_type(2)));
    f32x4 v[4][8];
    { const int e = first / items_per_e, item = first % items_per_e, kb = item / nblk, nb = item % nblk;
      const float* src = Wall + (size_t)e * 1024 * N + (size_t)(128 * kb + 8 * ko) * N + 64 * nb + 4 * ng;
#pragma unroll
      for (int q = 0; q < 4; ++q)
#pragma unroll
          for (int k = 0; k < 8; ++k) v[q][k] = __builtin_nontemporal_load((const GAS f32x4*)(src + (size_t)(32 * q + k) * N)); }
#pragma unroll 1
    for (int r = first; r < end; r += stride) {
        const int rn = r + stride; const bool hn = rn < end; const int rr = hn ? rn : r;
        const int en = rr / items_per_e, itn = rr % items_per_e;
        const float* nsrc = Wall + (size_t)en * 1024 * N + (size_t)(128 * (itn / nblk) + 8 * ko) * N + 64 * (itn % nblk) + 4 * ng;
#pragma unroll
        for (int q = 0; q < 4; ++q) {
#pragma unroll
            for (int j = 0; j < 4; ++j) {
                int lo = __builtin_amdgcn_cvt_pk_fp8_f32(v[q][0][j] * scale, v[q][1][j] * scale, 0, false); lo = __builtin_amdgcn_cvt_pk_fp8_f32(v[q][2][j] * scale, v[q][3][j] * scale, lo, true);
                int hi = __builtin_amdgcn_cvt_pk_fp8_f32(v[q][4][j] * scale, v[q][5][j] * scale, 0, false); hi = __builtin_amdgcn_cvt_pk_fp8_f32(v[q][6][j] * scale, v[q][7][j] * scale, hi, true);
                *(LAS i32x2*)(tile + (4 * ng + j) * 144 + 32 * q + 8 * ko) = (i32x2){lo, hi}; }
            if (hn) {
#pragma unroll
                for (int k = 0; k < 8; ++k) v[q][k] = __builtin_nontemporal_load((const GAS f32x4*)(nsrc + (size_t)(32 * q + k) * N)); }
        }
        LDS_WAIT(); asm volatile("" ::: "memory");
        const int e = r / items_per_e, item = r % items_per_e, k0 = 128 * (item / nblk), n0 = 64 * (item % nblk);
#pragma unroll
        for (int i = 0; i < 8; ++i) { const int rl = (lane >> 3) + 8 * i, n = n0 + rl; int dr; if (MAP == 0) dr = n; else { const int jj = n & 1023; dr = 256 * (jj >> 7) + 128 * (n >> 10) + (jj & 127); }
            const v4u w = *(const LAS v4u*)(tile + rl * 144 + 16 * (lane & 7));
            *(GAS v4u*)(WT + (size_t)(e * N + dr) * 1024 + k0 + 16 * (lane & 7)) = w; }
        LDS_WAIT(); asm volatile("" ::: "memory");
    }
}
constexpr int I_GU = 8 * 32, I_D = 8 * 16, NMOE_ITEMS = NEXP * (I_GU + I_D);
#ifndef MOE_P1_ITEMS
#define MOE_P1_ITEMS (NEXP * I_GU)
#endif
__device__ __forceinline__ void moe_item(Frame& F, int r, LAS float* scr) {
    if (r < NEXP * I_GU) { const int e = r / I_GU; convert_item_f8<2>((F.a->in[11]) + (size_t)e * 1024 * 2048, 1024, 2048, (unsigned char*)F_WGU, e * 2048, (LAS unsigned char*)scr, r % I_GU, F.lane, 32.0f); return; }
    r -= NEXP * I_GU;
    { const int e = r / I_D; convert_item_f8<0>((F.a->in[13]) + (size_t)e * 1024 * 1024, 1024, 1024, (unsigned char*)F_WD, e * 1024, (LAS unsigned char*)scr, r % I_D, F.lane, 32.0f); }
}
__device__ __forceinline__ void p1_convert(Frame& F, int cc, int NC, int moe_hi) {
    LAS unsigned char* scr = (LAS unsigned char*)(F.lds + RING_OFF + F.wave * 16384);
    const int w = cc * NWAVES + F.wave, nw = NC * NWAVES;
    const int hi_gu = moe_hi < NEXP * I_GU ? moe_hi : NEXP * I_GU, hi_d = moe_hi - NEXP * I_GU;
    convert_stream_f8<2>((F.a->in[11]), 2048, I_GU, (unsigned char*)F_WGU, scr, w, nw, hi_gu, F.lane, 32.0f);
    convert_stream_f8<0>((F.a->in[13]), 1024, I_D, (unsigned char*)F_WD, scr, w, nw, hi_d, F.lane, 32.0f);
}
__device__ __forceinline__ void p8_convert_wd(Frame& F, int rep) {
    LAS float* scr = (LAS float*)(F.lds + RING_OFF + F.wave * 16384);
    gu32* q = F.ctl + CW_WDQ + 64 * rep;
    unsigned nxt = 0u; if (F.lane == 0) nxt = __hip_atomic_fetch_add(q, 1u, RLX_AGENT);
    nxt = (unsigned)__builtin_amdgcn_readfirstlane((int)nxt);
    while (nxt < (unsigned)(NEXP * I_D)) {
        const int cur = (int)nxt;
        unsigned t = 0u; if (F.lane == 0) t = __hip_atomic_fetch_add(q, 1u, RLX_AGENT);
        moe_item(F, NEXP * I_GU + cur, scr);
        nxt = (unsigned)__builtin_amdgcn_readfirstlane((int)t);
    }
}
__device__ __forceinline__ void p0_prologue(Frame& F, int moe_lo) {
    LAS float* scr = (LAS float*)(F.lds + RING_OFF + F.wave * 16384);
    const int gw = blockIdx.x * NWAVES + F.wave, NGW = F.G * NWAVES;
    constexpr int I_WI = 16 * 151, I_PA = 8 * 32, I_WO = 16 * 32;
    constexpr int NITEMS = I_WI + 2 * I_PA + I_WO + NMOE_ITEMS;
    for (int it = moe_lo + gw; it < NITEMS; it += NGW) {
        int r = it;
        if (r < NMOE_ITEMS) { if (r < NEXP * I_GU) moe_item(F, r, scr); continue; } r -= NMOE_ITEMS;
        if (r < I_WI) { transpose_item<1>((F.a->in[2]), 1024, NPROJ, F_WI, 0, scr, r, F.lane); continue; } r -= I_WI;
        if (r < I_PA) { transpose_item<0>((F.a->in[5]), 512, 1024, F_WPA, 0, scr, r, F.lane); continue; } r -= I_PA;
        if (r < I_PA) { transpose_item<0>((F.a->in[6]), 512, 1024, F_WPB, 0, scr, r, F.lane); continue; } r -= I_PA;
        transpose_item<0>((F.a->in[7]), 1024, 1024, F_WO, 0, scr, r, F.lane);
    }
    { const int gt = blockIdx.x * (NWAVES * 64) + F.tid; if (gt < 7168) { v4u z = {0u, 0u, 0u, 0u}; *((GAS v4u*)(F_WI + (size_t)NPROJ * 1024) + gt) = z; } }
    { const int gt = blockIdx.x * (NWAVES * 64) + F.tid; if (gt < 1024 * 32) F_WRG[gt] = (F.a->in[8])[gt >> 5] * (F.a->in[9])[gt]; }
    { const int gt = blockIdx.x * (NWAVES * 64) + F.tid; if (gt < SEQ * 8) { const int i = gt & 7; const float inv = exp2f(-(float)i * 0.125f * 18.931568569324174f); float sn, cs; sincosf((float)(gt >> 3) * inv, &sn, &cs); F_ROPE[2 * gt] = cs; F_ROPE[2 * gt + 1] = sn; } }
    for (int m = gw; m < NTOK; m += NGW) {
        const GAS f32x4* xr = (const GAS f32x4*)((F.a->in[0]) + (size_t)m * DM) + F.lane; const GAS f32x4* gr = (const GAS f32x4*)(F.a->in[1]) + F.lane;
        f32x4 v[4]; float s = 0.f;
#pragma unroll
        for (int j = 0; j < 4; ++j) { v[j] = xr[64 * j]; s += (v[j].x * v[j].x + v[j].y * v[j].y) + (v[j].z * v[j].z + v[j].w * v[j].w); }
        const float rr = 1.0f / sqrtf(wave_sum(s) * (1.f / DM) + RMS_EPS);
        GAS unsigned long long* o8 = (GAS unsigned long long*)(F_XN + (size_t)m * DM) + F.lane;
#pragma unroll
        for (int j = 0; j < 4; ++j) { const f32x4 g = gr[64 * j]; o8[64 * j] = (unsigned long long)pk2(v[j].x * rr * g.x, v[j].y * rr * g.y) | ((unsigned long long)pk2(v[j].z * rr * g.z, v[j].w * rr * g.w) << 32); }
    }
}

__device__ __forceinline__ void rope16(float (&v)[16], const float* tab  ) {
#pragma unroll
    for (int i = 0; i < 8; ++i) { const float cs = tab[2 * i], sn = tab[2 * i + 1]; const float a = v[i], b2 = v[i + 8]; v[i] = a * cs - b2 * sn; v[i + 8] = b2 * cs + a * sn; }
}
__device__ __forceinline__ void p2_prep(Frame& F, int rep) {
    const size_t shift = rep ? (size_t)(WS_Y - WS_PROJ) / 2 : 0;
    const int gt = blockIdx.x * (NWAVES * 64) + F.tid, NGT = F.G * NWAVES * 64;
    for (int w = gt; w < NTOK * 8; w += NGT) {
        const int tk = w >> 3, h = w & 7; bf16* p = F_PROJ + (size_t)tk * PROJ_LD + h * 64; const float* g = (F.a->in[3]);
        v4u u[8]; float ss = 0.f;
#pragma unroll
        for (int c = 0; c < 8; ++c) { u[c] = *((const GAS v4u*)p + c); const float a0 = bflo(u[c].x), a1 = bfhi(u[c].x), a2 = bflo(u[c].y), a3 = bfhi(u[c].y), a4 = bflo(u[c].z), a5 = bfhi(u[c].z), a6 = bflo(u[c].w), a7 = bfhi(u[c].w);
            ss += (a0 * a0 + a1 * a1) + (a2 * a2 + a3 * a3) + (a4 * a4 + a5 * a5) + (a6 * a6 + a7 * a7); }
        const float rr = 1.0f / sqrtf(ss * (1.f / 64.f) + RMS_EPS);
        float r16[16];
#pragma unroll
        for (int c = 0; c < 2; ++c) { r16[8 * c] = bflo(u[c].x) * rr * g[8 * c]; r16[8 * c + 1] = bfhi(u[c].x) * rr * g[8 * c + 1]; r16[8 * c + 2] = bflo(u[c].y) * rr * g[8 * c + 2]; r16[8 * c + 3] = bfhi(u[c].y) * rr * g[8 * c + 3];
            r16[8 * c + 4] = bflo(u[c].z) * rr * g[8 * c + 4]; r16[8 * c + 5] = bfhi(u[c].z) * rr * g[8 * c + 5]; r16[8 * c + 6] = bflo(u[c].w) * rr * g[8 * c + 6]; r16[8 * c + 7] = bfhi(u[c].w) * rr * g[8 * c + 7]; }
        rope16(r16, F_ROPE + (size_t)(tk & (SEQ - 1)) * 16);
        const float sc = 0.125f;
#pragma unroll
        for (int c = 0; c < 8; ++c) { v4u o;
            if (c < 2) { o.x = pk2(r16[8 * c] * sc, r16[8 * c + 1] * sc); o.y = pk2(r16[8 * c + 2] * sc, r16[8 * c + 3] * sc); o.z = pk2(r16[8 * c + 4] * sc, r16[8 * c + 5] * sc); o.w = pk2(r16[8 * c + 6] * sc, r16[8 * c + 7] * sc); }
            else { const float q = rr * sc; o.x = pk2(bflo(u[c].x) * q * g[8 * c], bfhi(u[c].x) * q * g[8 * c + 1]); o.y = pk2(bflo(u[c].y) * q * g[8 * c + 2], bfhi(u[c].y) * q * g[8 * c + 3]);
                o.z = pk2(bflo(u[c].z) * q * g[8 * c + 4], bfhi(u[c].z) * q * g[8 * c + 5]); o.w = pk2(bflo(u[c].w) * q * g[8 * c + 6], bfhi(u[c].w) * q * g[8 * c + 7]); }
            *((GAS v4u*)(p + shift) + c) = o; }
    }
    for (int w = gt; w < NTOK * 4; w += NGT) {
        const int tk = w >> 2, j = w & 3;
        if (j == 3) {
#pragma unroll
            for (int h = 0; h < 8; ++h) (F_WIQ + (rep ? (size_t)(WS_ACT - WS_WIQ) / 4 + 4 * MiB : 0))[(size_t)tk * 8 + h] = F_SMALLF[(size_t)tk * 256 + 192 + h] * 0.044194173824159216f;
            continue;
        }
        const float* p = F_SMALLF + (size_t)tk * 256 + (j == 0 ? 0 : (j == 1 ? 128 : 64));
        bf16* dst = (j == 0 ? F_KA : (j == 1 ? F_KI : F_VA)) + (size_t)tk * 64 + (rep ? (size_t)(WS_ACT - WS_KA) / 2 : 0);
        float v[64];
#pragma unroll
        for (int c = 0; c < 16; ++c) { const f32x4 u = *((const GAS f32x4*)p + c); v[4 * c] = u.x; v[4 * c + 1] = u.y; v[4 * c + 2] = u.z; v[4 * c + 3] = u.w; }
        if (j == 0) { const float* g = (F.a->in[4]); float ss = 0.f;
#pragma unroll
            for (int d = 0; d < 64; ++d) ss += v[d] * v[d];
            const float rr = 1.0f / sqrtf(ss * (1.f / 64.f) + RMS_EPS);
#pragma unroll
            for (int d = 0; d < 64; ++d) v[d] = v[d] * rr * g[d]; }
        if (j < 2) { float r16[16];
#pragma unroll
            for (int d = 0; d < 16; ++d) r16[d] = v[d];
            rope16(r16, F_ROPE + (size_t)(tk & (SEQ - 1)) * 16);
#pragma unroll
            for (int d = 0; d < 16; ++d) v[d] = r16[d]; }
#pragma unroll
        for (int c = 0; c < 8; ++c) { v4u o; o.x = pk2(v[8 * c], v[8 * c + 1]); o.y = pk2(v[8 * c + 2], v[8 * c + 3]); o.z = pk2(v[8 * c + 4], v[8 * c + 5]); o.w = pk2(v[8 * c + 6], v[8 * c + 7]); *((GAS v4u*)dst + c) = o; }
    }
}

typedef float f32x16 __attribute__((ext_vector_type(16)));
__device__ __forceinline__ void sb_item(Frame& F, int item) {
    const int bh = item >> 3, tb = item & 7, b = bh >> 3, h = bh & 7, t = tb * 512 + F.tid;
    const bf16* base = F_PROJ + (size_t)(b * SEQ) * PROJ_LD + h * 64;
    float o[64]; v4u qw[8];
    { const GAS v4u* qp = (const GAS v4u*)(base + (size_t)t * PROJ_LD + 1024);
#pragma unroll
      for (int c = 0; c < 8; ++c) qw[c] = qp[c]; }
#pragma unroll
    for (int d = 0; d < 64; ++d) o[d] = 0.f;
    float R = 0.f; int s = t - 1;
    for (;;) {
        const bool active = (s >= 0) && (R <= 104.0f);
        if (!__any(active)) break;
        if (active) {
            const GAS v4u* kp = (const GAS v4u*)(base + (size_t)s * PROJ_LD + 1536);
            const GAS v4u* vp = (const GAS v4u*)(base + (size_t)s * PROJ_LD + 2048);
            float z = 0.f;
#pragma unroll
            for (int c = 0; c < 8; ++c) { const v4u u = kp[c];
                const v4u qq = qw[c]; z += bflo(qq.x) * bflo(u.x) + bfhi(qq.x) * bfhi(u.x) + bflo(qq.y) * bflo(u.y) + bfhi(qq.y) * bfhi(u.y) + bflo(qq.z) * bflo(u.z) + bfhi(qq.z) * bfhi(u.z) + bflo(qq.w) * bflo(u.w) + bfhi(qq.w) * bfhi(u.w); }
            const float sp = fmaxf(z, 0.f) + log1pf(__expf(-fabsf(z)));
            R += sp;
            const float a = __expf(z - R);
#pragma unroll
            for (int c = 0; c < 8; ++c) { const v4u u = vp[c];
                o[8 * c] += a * bflo(u.x); o[8 * c + 1] += a * bfhi(u.x); o[8 * c + 2] += a * bflo(u.y); o[8 * c + 3] += a * bfhi(u.y); o[8 * c + 4] += a * bflo(u.z); o[8 * c + 5] += a * bfhi(u.z); o[8 * c + 6] += a * bflo(u.w); o[8 * c + 7] += a * bfhi(u.w); }
        }
        --s;
    }
    GAS v4u* op = (GAS v4u*)(F_OB + (size_t)(b * SEQ + t) * 512 + h * 64);
#pragma unroll
    for (int c = 0; c < 8; ++c) { v4u w; w.x = pk2(o[8 * c], o[8 * c + 1]); w.y = pk2(o[8 * c + 2], o[8 * c + 3]); w.z = pk2(o[8 * c + 4], o[8 * c + 5]); w.w = pk2(o[8 * c + 6], o[8 * c + 7]); op[c] = w; }
}

typedef float f32x2_t __attribute__((ext_vector_type(2))); typedef __bf16 bf16x2_t __attribute__((ext_vector_type(2)));
__device__ __forceinline__ float relu_i(float x) { const int i = __builtin_bit_cast(int, x); return __builtin_bit_cast(float, i > 0 ? i : 0); }
typedef short v4i16_t __attribute__((ext_vector_type(4)));
__device__ __forceinline__ unsigned cvtpk_s(float lo, float hi) { f32x2_t v = {lo, hi}; bf16x2_t b = __builtin_convertvector(v, bf16x2_t); return __builtin_bit_cast(unsigned, b); }
__device__ __forceinline__ v4i16_t vtr(LAS unsigned char* p) { return __builtin_amdgcn_ds_read_tr16_b64_v4i16((LAS v4i16_t*)p); }
__device__ __forceinline__ void sb_item_mfma(Frame& F, int item) {
    const int lane = F.lane, wave = F.wave, r32 = lane & 31, hb = lane >> 5;
    const int bh = item >> 4, qb = item & 15, b = bh >> 3, h = bh & 7, qt = qb * 8 + wave, t0 = qt * 32;
    const bf16* base = F_PROJ + (size_t)(b * SEQ) * PROJ_LD + h * 64;
    LAS unsigned char* vl = F.lds + RING_OFF + wave * 16384;
    bf16x8 qf[4];
#pragma unroll
    for (int ks = 0; ks < 4; ++ks) qf[ks] = *(const GAS bf16x8*)(base + (size_t)(t0 + r32) * PROJ_LD + 1024 + 16 * ks + 8 * hb);
    f32x16 o0, o1;
#pragma unroll
    for (int i = 0; i < 16; ++i) { o0[i] = 0.f; o1[i] = 0.f; }
    float R = 0.f;
    const int tg = (lane >> 4) & 1, tq = (lane & 15) >> 2, tp = lane & 3;
    LAS unsigned char* trb = vl + (4 * hb + tq) * 192 + (16 * tg + 4 * tp) * 2;
    for (int kt = qt; kt >= 0; --kt) {
        const bf16* kp = base + (size_t)(32 * kt + r32) * PROJ_LD + 1536 + 8 * hb;
        bf16x8 kf[4];
#pragma unroll
        for (int ks = 0; ks < 4; ++ks) kf[ks] = *(const GAS bf16x8*)(kp + 16 * ks);
        v4u vv[4];
#pragma unroll
        for (int i = 0; i < 4; ++i) vv[i] = *(const GAS v4u*)(base + (size_t)(32 * kt + (lane >> 3) + 8 * i) * PROJ_LD + 2048 + 8 * (lane & 7));
        f32x16 c;
#pragma unroll
        for (int i = 0; i < 16; ++i) c[i] = 0.f;
#pragma unroll
        for (int ks = 0; ks < 4; ++ks) c = __builtin_amdgcn_mfma_f32_32x32x16_bf16(kf[ks], qf[ks], c, 0, 0, 0);
#pragma unroll
        for (int i = 0; i < 4; ++i) *(LAS v4u*)(vl + ((lane >> 3) + 8 * i) * 192 + 16 * (lane & 7)) = vv[i];
        const bool diag = (kt == qt);
        float sp[16];
#pragma unroll
        for (int i = 0; i < 16; ++i) { const int kk = (i & 3) + 8 * (i >> 2) + 4 * hb; const bool msk = diag && (kk >= r32); const float z = c[i];
            const float v = fmaxf(z, 0.f) + 0.6931471805599453f * __builtin_amdgcn_logf(1.0f + __builtin_amdgcn_exp2f(-fabsf(z) * 1.4426950408889634f));
            sp[i] = msk ? 0.f : v; }
        float gs[4], pg[4];
#pragma unroll
        for (int k4 = 0; k4 < 4; ++k4) { gs[k4] = (sp[4 * k4] + sp[4 * k4 + 1]) + (sp[4 * k4 + 2] + sp[4 * k4 + 3]); pg[k4] = __shfl_xor(gs[k4], 32); }
        float off[4];
        { const float so2 = gs[3], so1 = so2 + gs[2], so0 = so1 + gs[1]; const float po2 = pg[3], po1 = po2 + pg[2], po0 = po1 + pg[1];
          off[3] = 0.f; off[2] = so2 + po2; off[1] = so1 + po1; off[0] = so0 + po0;
          if (hb == 0) { off[3] += pg[3]; off[2] += pg[2]; off[1] += pg[1]; off[0] += pg[0]; }
          const float total = (so0 + gs[0]) + (po0 + pg[0]);
#pragma unroll
          for (int k4 = 0; k4 < 4; ++k4) { float run = R + off[k4];
#pragma unroll
              for (int w = 3; w >= 0; --w) { const int i = 4 * k4 + w; const int kk = w + 8 * k4 + 4 * hb; const bool msk = diag && (kk >= r32);
                  run += sp[i]; const float a = __builtin_amdgcn_exp2f((c[i] - run) * 1.4426950408889634f); c[i] = msk ? 0.f : a; } }
          R += total; }
        bf16x8 pa[2];
#pragma unroll
        for (int s2 = 0; s2 < 2; ++s2) { v4u w4; w4.x = cvtpk_s(c[8 * s2], c[8 * s2 + 1]); w4.y = cvtpk_s(c[8 * s2 + 2], c[8 * s2 + 3]); w4.z = cvtpk_s(c[8 * s2 + 4], c[8 * s2 + 5]); w4.w = cvtpk_s(c[8 * s2 + 6], c[8 * s2 + 7]); pa[s2] = __builtin_bit_cast(bf16x8, w4); }
        LDS_WAIT(); asm volatile("" ::: "memory");
#pragma unroll
        for (int s2 = 0; s2 < 2; ++s2) {
#pragma unroll
            for (int db = 0; db < 2; ++db) {
                const v4i16_t lo = vtr(trb + (16 * s2) * 192 + db * 64), hi2 = vtr(trb + (16 * s2 + 8) * 192 + db * 64);
                const bf16x8 vf = (bf16x8){lo[0], lo[1], lo[2], lo[3], hi2[0], hi2[1], hi2[2], hi2[3]};
                if (db == 0) o0 = __builtin_amdgcn_mfma_f32_32x32x16_bf16(pa[s2], vf, o0, 0, 0, 0); else o1 = __builtin_amdgcn_mfma_f32_32x32x16_bf16(pa[s2], vf, o1, 0, 0, 0);
            } }
        LDS_WAIT(); asm volatile("" ::: "memory");
        if (__all(R > 104.0f)) break;
    }
    bf16* op = F_OB + (size_t)(b * SEQ + t0) * 512 + h * 64 + r32;
#pragma unroll
    for (int i = 0; i < 16; ++i) { const int qr = (i & 3) + 8 * (i >> 2) + 4 * hb; op[(size_t)qr * 512] = (bf16)f2bf(o0[i]); op[(size_t)qr * 512 + 32] = (bf16)f2bf(o1[i]); }
}

template <int NV> __device__ __forceinline__ bool select256_hist(const LAS unsigned* rowu, LAS int* idxl, LAS unsigned* hist  , int L, int lane) {
    unsigned kv[NV]; unsigned kmin = 0xffffffffu, kmax = 0u;
    const LAS unsigned* rp = rowu + lane; asm volatile("" : "+v"(rp));
#pragma unroll
    for (int j = 0; j < NV; ++j) { unsigned u = 0u;
        if (64 * j < L) { u = rp[64 * j]; u = (u & 0x80000000u) ? ~u : (u | 0x80000000u); kmin = u < kmin ? u : kmin; kmax = u > kmax ? u : kmax; }
        kv[j] = u; }
#pragma unroll
    for (int o = 1; o < 64; o <<= 1) { const unsigned a = (unsigned)__shfl_xor((int)kmin, o), c2 = (unsigned)__shfl_xor((int)kmax, o); kmin = a < kmin ? a : kmin; kmax = c2 > kmax ? c2 : kmax; }
    const float fmin = __uint_as_float((kmin & 0x80000000u) ? (kmin ^ 0x80000000u) : ~kmin), fmax = __uint_as_float((kmax & 0x80000000u) ? (kmax ^ 0x80000000u) : ~kmax);
    const float rng = fmax - fmin, scale = rng > 0.f ? 1023.5f / rng : 0.f;
#define SEL_BIN(kk) ({ const unsigned k_ = (kk); const float f_ = __uint_as_float((k_ & 0x80000000u) ? (k_ ^ 0x80000000u) : ~k_); int b_ = (int)((f_ - fmin) * scale); b_ = b_ > 1023 ? 1023 : b_; b_; })
#pragma unroll
    for (int i = 0; i < 2; ++i) *(LAS v4u*)(hist + 4 * (lane + 64 * i)) = (v4u){0u, 0u, 0u, 0u};
    LDS_WAIT(); asm volatile("" ::: "memory");
#pragma unroll
    for (int j = 0; j < NV; ++j) if (64 * j < L) { const int b = SEL_BIN(kv[j]); __hip_atomic_fetch_add(hist + (b >> 1), 1u << (16 * (b & 1)), __ATOMIC_RELAXED, __HIP_MEMORY_SCOPE_WORKGROUP); }
    LDS_WAIT(); asm volatile("" ::: "memory");
    int hb[16];
    { const v4u w0 = *(const LAS v4u*)(hist + 8 * lane), w1 = *(const LAS v4u*)(hist + 8 * lane + 4);
      hb[0] = w0.x & 0xffff; hb[1] = w0.x >> 16; hb[2] = w0.y & 0xffff; hb[3] = w0.y >> 16; hb[4] = w0.z & 0xffff; hb[5] = w0.z >> 16; hb[6] = w0.w & 0xffff; hb[7] = w0.w >> 16;
      hb[8] = w1.x & 0xffff; hb[9] = w1.x >> 16; hb[10] = w1.y & 0xffff; hb[11] = w1.y >> 16; hb[12] = w1.z & 0xffff; hb[13] = w1.z >> 16; hb[14] = w1.w & 0xffff; hb[15] = w1.w >> 16; }
    int S = 0;
#pragma unroll
    for (int i = 0; i < 16; ++i) S += hb[i];
    int incl = S;
#pragma unroll
    for (int o = 1; o < 64; o <<= 1) { const int v = __shfl_down(incl, o); if (lane + o < 64) incl += v; }
    const int T = incl - S;
    int bstar = -1, cA = 0, nb = 0;
    { int run = T; bool found = false;
#pragma unroll
      for (int i = 15; i >= 0; --i) { const bool here = !found && (T < 256) && (T + S >= 256) && (run + hb[i] >= 256); if (here) { bstar = 16 * lane + i; cA = run; nb = hb[i]; found = true; } run += hb[i]; } }
    { const unsigned long long mown = __ballot(bstar >= 0); const int src = (int)__ffsll((long long)mown) - 1; bstar = __shfl(bstar, src); cA = __shfl(cA, src); nb = __shfl(nb, src); }
    if (nb > 512) return false;
    const int need = 256 - cA;
    LDS_WAIT(); asm volatile("" ::: "memory");
    LAS int* cand = (LAS int*)hist;
    int base = 0, cbase = 0;
#pragma unroll
    for (int j = 0; j < NV; ++j) {
        const int b = (64 * j < L) ? SEL_BIN(kv[j]) : -1;
        const bool gt = b > bstar, eq = b == bstar;
        const unsigned long long mg = __ballot(gt), me = __ballot(eq);
        const int pg = base + (int)__builtin_amdgcn_mbcnt_hi((unsigned)(mg >> 32), __builtin_amdgcn_mbcnt_lo((unsigned)mg, 0u));
        const int pe = cbase + (int)__builtin_amdgcn_mbcnt_hi((unsigned)(me >> 32), __builtin_amdgcn_mbcnt_lo((unsigned)me, 0u));
        if (gt && pg < 256) idxl[pg] = 64 * j + lane;
        if (eq && pe < 512) cand[pe] = 64 * j + lane;
        base += __popcll(mg); cbase += __popcll(me);
    }
#undef SEL_BIN
    LDS_WAIT(); asm volatile("" ::: "memory");
    for (int i = lane; i < nb; i += 64) {
        const int ci = cand[i]; unsigned ki = rowu[ci]; ki = (ki & 0x80000000u) ? ~ki : (ki | 0x80000000u);
        int rank = 0;
        for (int j = 0; j < nb; ++j) { const int cj = cand[j]; unsigned kj = rowu[cj]; kj = (kj & 0x80000000u) ? ~kj : (kj | 0x80000000u); rank += (kj > ki || (kj == ki && cj < ci)) ? 1 : 0; }
        if (rank < need) idxl[cA + rank] = ci;
    }
    return true;
}
template <int NV> __device__ __forceinline__ void select256(const LAS unsigned* rowu, LAS int* idxl, int L, int lane) {
    unsigned kv[NV]; unsigned kmin = 0xffffffffu, kmax = 0u;
    const LAS unsigned* rp = rowu + lane; asm volatile("" : "+v"(rp));
#pragma unroll
    for (int j = 0; j < NV; ++j) { unsigned u = 0u;
        if (64 * j < L) { u = rp[64 * j]; u = (u & 0x80000000u) ? ~u : (u | 0x80000000u); kmin = u < kmin ? u : kmin; kmax = u > kmax ? u : kmax; }
        kv[j] = u; }
#pragma unroll
    for (int o = 1; o < 64; o <<= 1) { const unsigned a = (unsigned)__shfl_xor((int)kmin, o), c2 = (unsigned)__shfl_xor((int)kmax, o); kmin = a < kmin ? a : kmin; kmax = c2 > kmax ? c2 : kmax; }
    unsigned lo = kmin, hi = kmax + 1u; int chi = 0;
    while (hi - lo > 1u) {
        const unsigned mid = lo + ((hi - lo) >> 1);
        int c = 0;
#pragma unroll
        for (int j = 0; j < NV; j += 8) {
            unsigned long long mk[8];
#pragma unroll
            for (int q = 0; q < 8; ++q) mk[q] = __ballot(kv[j + q] >= mid);
            asm volatile("" : "+s"(mk[0]), "+s"(mk[1]), "+s"(mk[2]), "+s"(mk[3]), "+s"(mk[4]), "+s"(mk[5]), "+s"(mk[6]), "+s"(mk[7]));
#pragma unroll
            for (int q = 0; q < 8; ++q) c += __popcll(mk[q]);
        }
        if (c >= 256) { lo = mid; if (c == 256) { hi = mid; chi = 256; break; } } else { hi = mid; chi = c; }
    }
    const int need = 256 - chi; int base = 0, tdone = 0;
#pragma unroll
    for (int j = 0; j < NV; ++j) {
        const unsigned u = kv[j];
        const bool gt = u >= hi, eq = (u == lo) && !gt;
        const unsigned long long meq = __ballot(eq);
        const int eqrank = tdone + (int)__builtin_amdgcn_mbcnt_hi((unsigned)(meq >> 32), __builtin_amdgcn_mbcnt_lo((unsigned)meq, 0u));
        const bool sel = gt || (eq && eqrank < need);
        const unsigned long long msel = __ballot(sel);
        const int pos = base + (int)__builtin_amdgcn_mbcnt_hi((unsigned)(msel >> 32), __builtin_amdgcn_mbcnt_lo((unsigned)msel, 0u));
        if (sel && pos < 256) idxl[pos] = 64 * j + lane;
        base += __popcll(msel); tdone += __popcll(meq);
    }
}
#ifndef P3_MODE
#define P3_MODE 0
#endif
__device__ __forceinline__ void dsa_item(Frame& F, int b, int t0, int stop) {
    const int lane = F.lane, wave = F.wave;
    const int L = ((t0 >> 6) + 1) << 6;
    LAS float* sc = (LAS float*)(F.lds + RING_OFF);
    if (L > 256) {
        const int r = lane & 31, hb = lane >> 5;
        const int head = (r & 3) + 4 * ((r >> 3) & 1), qsub = ((r >> 2) & 1) + 2 * ((r >> 4) & 1);
        bf16x8 qa[2][4]; float wq[2][2][8];
#pragma unroll
        for (int j = 0; j < 2; ++j) {
            const bf16* qp = F_PROJ + (size_t)(b * SEQ + t0 + 4 * j + qsub) * PROJ_LD + 512 + head * 64 + 8 * hb;
#pragma unroll
            for (int ks = 0; ks < 4; ++ks) qa[j][ks] = *(const GAS bf16x8*)(qp + 16 * ks);
#pragma unroll
            for (int x2 = 0; x2 < 2; ++x2)
#pragma unroll
                for (int hh = 0; hh < 8; ++hh) wq[j][x2][hh] = F_WIQ[(size_t)(b * SEQ + t0 + 4 * j + hb + 2 * x2) * 8 + hh];
        }
        const int ntile = L >> 5;
        const bf16* kbase = F_KI + (size_t)(b * SEQ + r) * 64 + 8 * hb;
#define IDX_LOAD(dst, kt_) do { const bf16* kp_ = kbase + (size_t)(32 * (kt_)) * 64; _Pragma("unroll") for (int ks = 0; ks < 4; ++ks) dst[ks] = *(const GAS bf16x8*)(kp_ + 16 * ks); } while (0)
#define IDX_TILE(src, kt_) do { _Pragma("unroll") for (int j = 0; j < 2; ++j) { f32x16 c; _Pragma("unroll") for (int i = 0; i < 16; ++i) c[i] = 0.f; \
            _Pragma("unroll") for (int ks = 0; ks < 4; ++ks) c = __builtin_amdgcn_mfma_f32_32x32x16_bf16(qa[j][ks], src[ks], c, 0, 0, 0); \
            float s0 = 0.f, s1 = 0.f; _Pragma("unroll") for (int i = 0; i < 8; ++i) { s0 += wq[j][0][i] * fmaxf(c[i], 0.f); s1 += wq[j][1][i] * fmaxf(c[8 + i], 0.f); } \
            sc[(4 * j + hb) * 4096 + 32 * (kt_) + r] = s0; sc[(4 * j + hb + 2) * 4096 + 32 * (kt_) + r] = s1; } } while (0)
        for (int kt = wave; kt < ntile; kt += 32) {
            bf16x8 k4[4][4];
#pragma unroll
            for (int u = 0; u < 4; ++u) { const int ku = kt + 8 * u; IDX_LOAD(k4[u], ku < ntile ? ku : ntile - 1); }
#pragma unroll
            for (int u = 0; u < 4; ++u) { const int ku = kt + 8 * u; if (ku < ntile) IDX_TILE(k4[u], ku); }
        }
#undef IDX_LOAD
#undef IDX_TILE
    }
    __syncthreads();
    if (stop == 1) { __syncthreads(); return; }
    LAS float* row = sc + wave * 4096; LAS unsigned* rowu = (LAS unsigned*)row;
    LAS int* idxl = (LAS int*)(F.lds + IDX_OFF) + wave * 256;
    int nsel;
    if (L <= 256) { nsel = L; for (int i = lane; i < 256; i += 64) idxl[i] = (i < L) ? i : 0; }
    else {
        LAS unsigned* hist = (LAS unsigned*)(F.lds + HIST_OFF) + wave * 512;
        bool ok;
        if (L <= 1024) ok = select256_hist<16>(rowu, idxl, hist, L, lane); else if (L <= 2048) ok = select256_hist<32>(rowu, idxl, hist, L, lane); else if (L <= 3072) ok = select256_hist<48>(rowu, idxl, hist, L, lane); else ok = select256_hist<64>(rowu, idxl, hist, L, lane);
        if (!ok) select256<64>(rowu, idxl, L, lane);
        nsel = 256;
    }
    LDS_WAIT(); asm volatile("" ::: "memory");
    if (stop == 2) { __syncthreads(); return; }
    const int t = t0 + wave;
    {
        const int c16 = lane & 15, q4 = lane >> 4, tq = c16 >> 2, tp = c16 & 3;
        bf16x8 qf[2];
        { const bf16* qp = F_PROJ + (size_t)(b * SEQ + t) * PROJ_LD + (c16 & 7) * 64 + 8 * q4;
          qf[0] = *(const GAS bf16x8*)qp; qf[1] = *(const GAS bf16x8*)(qp + 32);
          if (c16 >= 8) { qf[0] = (bf16x8){0, 0, 0, 0, 0, 0, 0, 0}; qf[1] = qf[0]; } }
        f32x4 lg[16];
        const bf16* kbase = F_KA + (size_t)(b * SEQ) * 64 + 8 * q4;
#pragma unroll
        for (int g = 0; g < 16; ++g) {
            const int p = 16 * g + c16; const int key = (p < nsel) ? idxl[p] : 0;
            const bf16* kp = kbase + (size_t)key * 64;
            const bf16x8 k0 = *(const GAS bf16x8*)kp, k1 = *(const GAS bf16x8*)(kp + 32);
            f32x4 c = {0.f, 0.f, 0.f, 0.f};
            c = __builtin_amdgcn_mfma_f32_16x16x32_bf16(k0, qf[0], c, 0, 0, 0);
            c = __builtin_amdgcn_mfma_f32_16x16x32_bf16(k1, qf[1], c, 0, 0, 0);
#pragma unroll
            for (int r = 0; r < 4; ++r) if (16 * g + 4 * q4 + r >= nsel) c[r] = -INFINITY;
            lg[g] = c;
        }
        v4u vA[8], vB[8];
#pragma unroll
        for (int i = 0; i < 8; ++i) { const int p_ = (lane >> 3) + 8 * i; const int key_ = (p_ < nsel) ? idxl[p_] : 0; vA[i] = *(const GAS v4u*)(F_VA + (size_t)(b * SEQ + key_) * 64 + 8 * (lane & 7)); }
        float m = -INFINITY;
#pragma unroll
        for (int g = 0; g < 16; ++g) m = fmaxf(m, fmaxf(fmaxf(lg[g][0], lg[g][1]), fmaxf(lg[g][2], lg[g][3])));
        m = fmaxf(m, __shfl_xor(m, 16)); m = fmaxf(m, __shfl_xor(m, 32));
        float ssum = 0.f;
#pragma unroll
        for (int g = 0; g < 16; ++g)
#pragma unroll
            for (int r = 0; r < 4; ++r) { const float e = __builtin_amdgcn_exp2f((lg[g][r] - m) * 1.4426950408889634f); lg[g][r] = e; ssum += e; }
        ssum += __shfl_xor(ssum, 16); ssum += __shfl_xor(ssum, 32);
        const float inv = 1.0f / ssum;
        LAS unsigned char* vl = (LAS unsigned char*)row;
        f32x4 o[4];
#pragma unroll
        for (int db = 0; db < 4; ++db) o[db] = (f32x4){0.f, 0.f, 0.f, 0.f};
#define V_LOAD(dst, ch_) do { _Pragma("unroll") for (int i = 0; i < 8; ++i) { const int p_ = 64 * (ch_) + (lane >> 3) + 8 * i; const int key_ = (p_ < nsel) ? idxl[p_] : 0; \
            dst[i] = *(const GAS v4u*)(F_VA + (size_t)(b * SEQ + key_) * 64 + 8 * (lane & 7)); } } while (0)
#define V_STEP(cur, nxt, ch_, HAS_NEXT) do { \
            _Pragma("unroll") for (int i = 0; i < 8; ++i) *(LAS v4u*)(vl + ((lane >> 3) + 8 * i) * 160 + 16 * (lane & 7)) = cur[i]; \
            LDS_WAIT(); asm volatile("" ::: "memory"); \
            if (HAS_NEXT) V_LOAD(nxt, (ch_) + 1); \
            _Pragma("unroll") for (int ss = 0; ss < 2; ++ss) { const int s2 = 2 * (ch_) + ss; \
                v4u w4; w4.x = cvtpk_s(lg[2 * s2][0] * inv, lg[2 * s2][1] * inv); w4.y = cvtpk_s(lg[2 * s2][2] * inv, lg[2 * s2][3] * inv); \
                w4.z = cvtpk_s(lg[2 * s2 + 1][0] * inv, lg[2 * s2 + 1][1] * inv); w4.w = cvtpk_s(lg[2 * s2 + 1][2] * inv, lg[2 * s2 + 1][3] * inv); \
                const bf16x8 pa = __builtin_bit_cast(bf16x8, w4); \
                _Pragma("unroll") for (int db = 0; db < 4; ++db) { \
                    const v4i16_t lo = vtr(vl + (32 * ss + 4 * q4 + tq) * 160 + (16 * db + 4 * tp) * 2), hi2 = vtr(vl + (32 * ss + 16 + 4 * q4 + tq) * 160 + (16 * db + 4 * tp) * 2); \
                    const bf16x8 vf = (bf16x8){lo[0], lo[1], lo[2], lo[3], hi2[0], hi2[1], hi2[2], hi2[3]}; \
                    o[db] = __builtin_amdgcn_mfma_f32_16x16x32_bf16(pa, vf, o[db], 0, 0, 0); } } \
            LDS_WAIT(); asm volatile("" ::: "memory"); } while (0)
        V_STEP(vA, vB, 0, true); V_STEP(vB, vA, 1, true); V_STEP(vA, vB, 2, true); V_STEP(vB, vA, 3, false);
#undef V_LOAD
#undef V_STEP
        if (q4 < 2) { bf16* op = F_OA + (size_t)(b * SEQ + t) * 512 + (4 * q4) * 64 + c16;
#pragma unroll
            for (int db = 0; db < 4; ++db)
#pragma unroll
                for (int r = 0; r < 4; ++r) op[r * 64 + 16 * db] = (bf16)f2bf(o[db][r]); }
    }
    __syncthreads();
}
__device__ __forceinline__ int shx_i(int v, int o, int lane) { return __builtin_amdgcn_ds_bpermute((lane ^ o) << 2, v); }
__device__ __forceinline__ float shx_f(float v, int o, int lane) { return __int_as_float(__builtin_amdgcn_ds_bpermute((lane ^ o) << 2, __float_as_int(v))); }
__device__ __forceinline__ int shl_i(int v, int src) { return __builtin_amdgcn_ds_bpermute(src << 2, v); }
__device__ __forceinline__ unsigned h2key(unsigned u) { return (u & 0x8000u) ? (~u & 0xffffu) : (u | 0x8000u); }
__device__ __forceinline__ float key2val(unsigned k) { const unsigned u = (k & 0x8000u) ? (k ^ 0x8000u) : (~k & 0xffffu); return (float)__builtin_bit_cast(_Float16, (unsigned short)u); }
template <int NV> __device__ __forceinline__ void select256_b16(const LAS unsigned short* rowh, LAS unsigned short* idxl, int L, int lane) {
    unsigned kv[NV]; unsigned kmin = 0xffffffffu, kmax = 0u;
    const LAS unsigned short* rp = rowh + lane; asm volatile("" : "+v"(rp));
#pragma unroll
    for (int j = 0; j < NV; ++j) { unsigned u = 0u; if (j < NV - 16 || 64 * j < L) { u = h2key(rp[64 * j]); kmin = u < kmin ? u : kmin; kmax = u > kmax ? u : kmax; } kv[j] = u; }
#pragma unroll
    for (int o = 1; o < 64; o <<= 1) { const unsigned a = (unsigned)shx_i((int)kmin, o, lane), c2 = (unsigned)shx_i((int)kmax, o, lane); kmin = a < kmin ? a : kmin; kmax = c2 > kmax ? c2 : kmax; }
    unsigned lo = kmin, hi = kmax + 1u; int chi = 0;
    while (hi - lo > 1u) {
        const unsigned mid = lo + ((hi - lo) >> 1);
        int c = 0;
#pragma unroll
        for (int j = 0; j < NV; ++j) c += __popcll(__ballot(kv[j] >= mid));
        if (c >= 256) { lo = mid; if (c == 256) { hi = mid; chi = 256; break; } } else { hi = mid; chi = c; }
    }
    const int need = 256 - chi; int base = 0, tdone = 0;
#pragma unroll
    for (int j = 0; j < NV; ++j) {
        const unsigned u = kv[j];
        const bool gt = u >= hi, eq = (u == lo) && !gt;
        const unsigned long long meq = __ballot(eq);
        const int eqrank = tdone + (int)__builtin_amdgcn_mbcnt_hi((unsigned)(meq >> 32), __builtin_amdgcn_mbcnt_lo((unsigned)meq, 0u));
        const bool sel = gt || (eq && eqrank < need);
        const unsigned long long msel = __ballot(sel);
        const int pos = base + (int)__builtin_amdgcn_mbcnt_hi((unsigned)(msel >> 32), __builtin_amdgcn_mbcnt_lo((unsigned)msel, 0u));
        if (sel && pos < 256) idxl[pos] = (unsigned short)(64 * j + lane);
        base += __popcll(msel); tdone += __popcll(meq);
    }
}
template <int NV> __device__ __forceinline__ bool select256_h16(const LAS unsigned short* rowh, LAS unsigned short* idxl, LAS unsigned* hist  , int L, int lane) {
    float kv[NV]; float fmin = INFINITY, fmax = -INFINITY;
    const LAS _Float16* rp = (const LAS _Float16*)rowh + lane; asm volatile("" : "+v"(rp));
#pragma unroll
    for (int j = 0; j < NV; ++j) { float f = -INFINITY; if (j < NV - 16 || 64 * j < L) { f = (float)rp[64 * j]; fmin = fminf(fmin, f); fmax = fmaxf(fmax, f); } kv[j] = f; }
#pragma unroll
    for (int o = 1; o < 64; o <<= 1) { fmin = fminf(fmin, shx_f(fmin, o, lane)); fmax = fmaxf(fmax, shx_f(fmax, o, lane)); }
    const float rng = fmax - fmin, scale = rng > 0.f ? 511.5f / rng : 0.f;
#pragma unroll
    for (int i = 0; i < 2; ++i) *(LAS v4u*)(hist + 4 * (lane + 64 * i)) = (v4u){0u, 0u, 0u, 0u};
    LDS_WAIT(); asm volatile("" ::: "memory");
    int kb[NV];
#pragma unroll
    for (int j = 0; j < NV; ++j) { int bq = -1;
        if (j < NV - 16 || 64 * j < L) { bq = (int)((kv[j] - fmin) * scale); bq = bq > 511 ? 511 : bq; __hip_atomic_fetch_add(hist + bq, 1u, __ATOMIC_RELAXED, __HIP_MEMORY_SCOPE_WORKGROUP); }
        kb[j] = bq; }
    LDS_WAIT(); asm volatile("" ::: "memory");
    int hb[8];
    { const v4u w0 = *(const LAS v4u*)(hist + 8 * lane), w1 = *(const LAS v4u*)(hist + 8 * lane + 4);
      hb[0] = (int)w0.x; hb[1] = (int)w0.y; hb[2] = (int)w0.z; hb[3] = (int)w0.w; hb[4] = (int)w1.x; hb[5] = (int)w1.y; hb[6] = (int)w1.z; hb[7] = (int)w1.w; }
    int S = 0;
#pragma unroll
    for (int i = 0; i < 8; ++i) S += hb[i];
    int incl = S;
#pragma unroll
    for (int o = 1; o < 64; o <<= 1) { const int v = shl_i(incl, (lane + o) & 63); if (lane + o < 64) incl += v; }
    const int T = incl - S;
    int bstar = -1, cA = 0, nb = 0;
    { int run = T; bool found = false;
#pragma unroll
      for (int i = 7; i >= 0; --i) { const bool here = !found && (T < 256) && (T + S >= 256) && (run + hb[i] >= 256); if (here) { bstar = 8 * lane + i; cA = run; nb = hb[i]; found = true; } run += hb[i]; } }
    { const unsigned long long mown = __ballot(bstar >= 0); const int src = (int)__ffsll((long long)mown) - 1; bstar = shl_i(bstar, src); cA = shl_i(cA, src); nb = shl_i(nb, src); }
    if (nb > 512) return false;
    const int need = 256 - cA;
    LDS_WAIT(); asm volatile("" ::: "memory");
    LAS int* cand = (LAS int*)hist;
    int base = 0, cbase = 0;
#pragma unroll
    for (int j = 0; j < NV; ++j) {
        const bool gt = kb[j] > bstar, eq = kb[j] == bstar;
        const unsigned long long mg = __ballot(gt), me = __ballot(eq);
        const int pg = base + (int)__builtin_amdgcn_mbcnt_hi((unsigned)(mg >> 32), __builtin_amdgcn_mbcnt_lo((unsigned)mg, 0u));
        const int pe = cbase + (int)__builtin_amdgcn_mbcnt_hi((unsigned)(me >> 32), __builtin_amdgcn_mbcnt_lo((unsigned)me, 0u));
        if (gt && pg < 256) idxl[pg] = (unsigned short)(64 * j + lane);
        if (eq && pe < 512) cand[pe] = 64 * j + lane;
        base += __popcll(mg); cbase += __popcll(me);
    }
    LDS_WAIT(); asm volatile("" ::: "memory");
    for (int i = lane; i < nb; i += 64) {
        const int ci = cand[i]; const unsigned ki = h2key(rowh[ci]);
        int rank = 0;
        for (int j = 0; j < nb; ++j) { const int cj = cand[j]; const unsigned kj = h2key(rowh[cj]); rank += (kj > ki || (kj == ki && cj < ci)) ? 1 : 0; }
        if (rank < need) idxl[cA + rank] = (unsigned short)ci;
    }
    return true;
}
__device__ __forceinline__ void unpk8(const bf16x8& v, float (&x)[8]) { const v4u u = __builtin_bit_cast(v4u, v); x[0] = bflo(u.x); x[1] = bfhi(u.x); x[2] = bflo(u.y); x[3] = bfhi(u.y); x[4] = bflo(u.z); x[5] = bfhi(u.z); x[6] = bflo(u.w); x[7] = bfhi(u.w); }
__device__ __forceinline__ bf16x8 pk8(const float (&x)[8]) { v4u u; u.x = cvtpk_s(x[0], x[1]); u.y = cvtpk_s(x[2], x[3]); u.z = cvtpk_s(x[4], x[5]); u.w = cvtpk_s(x[6], x[7]); return __builtin_bit_cast(bf16x8, u); }
__device__ __forceinline__ void rope_frag(float (&x)[8], bool lowhalf, int pmask, int lane, const float* tab) {
#pragma unroll
    for (int i = 0; i < 8; ++i) { const float o = shx_f(x[i], pmask, lane); const float cs = tab[2 * i], sn = tab[2 * i + 1]; x[i] = lowhalf ? x[i] * cs - o * sn : x[i] * cs + o * sn; }
}
template <bool FULL> __device__ __forceinline__ void dsa_attend(Frame& F, int b, int t, int nsel_, const LAS unsigned short* idxl, LAS unsigned char* vl, int lane) {
    int nsel = FULL ? 256 : nsel_; if (!FULL) asm volatile("" : "+v"(nsel));
    const int c16 = lane & 15, q4 = lane >> 4, tq = c16 >> 2, tp = c16 & 3;
    bf16x8 qf[2];
    { const bf16* qp = F_PROJ + (size_t)(b * SEQ + t) * PROJ_LD + (c16 & 7) * 64 + 8 * q4;
      qf[0] = *(const GAS bf16x8*)qp; qf[1] = *(const GAS bf16x8*)(qp + 32);
      if (c16 >= 8) { qf[0] = (bf16x8){0, 0, 0, 0, 0, 0, 0, 0}; qf[1] = qf[0]; } }
    f32x4 lg[16];
    const bf16* kbase = F_KA + (size_t)(b * SEQ) * 64 + 8 * q4;
#pragma unroll
    for (int g = 0; g < 16; ++g) {
        const int p = 16 * g + c16; const int key = (FULL || p < nsel) ? (int)idxl[p] : 0;
        const bf16* kp = kbase + (size_t)key * 64;
        const bf16x8 k0 = *(const GAS bf16x8*)kp, k1 = *(const GAS bf16x8*)(kp + 32);
        f32x4 c = {0.f, 0.f, 0.f, 0.f};
        c = __builtin_amdgcn_mfma_f32_16x16x32_bf16(k0, qf[0], c, 0, 0, 0);
        c = __builtin_amdgcn_mfma_f32_16x16x32_bf16(k1, qf[1], c, 0, 0, 0);
        if (!FULL) {
#pragma unroll
            for (int r = 0; r < 4; ++r) if (16 * g + 4 * q4 + r >= nsel) c[r] = -INFINITY; }
        lg[g] = c;
    }
    v4u vA[8];
#define V_LOAD(dst, ch_) do { _Pragma("unroll") for (int i = 0; i < 8; ++i) { const int p_ = 64 * (ch_) + (lane >> 3) + 8 * i; const int key_ = (FULL || p_ < nsel) ? (int)idxl[p_] : 0; \
        dst[i] = *(const GAS v4u*)(F_VA + (size_t)(b * SEQ + key_) * 64 + 8 * (lane & 7)); } } while (0)
    V_LOAD(vA, 0);
    float m = -INFINITY;
#pragma unroll
    for (int g = 0; g < 16; ++g) m = fmaxf(m, fmaxf(fmaxf(lg[g][0], lg[g][1]), fmaxf(lg[g][2], lg[g][3])));
    m = fmaxf(m, shx_f(m, 16, lane)); m = fmaxf(m, shx_f(m, 32, lane));
    float ssum = 0.f;
#pragma unroll
    for (int g = 0; g < 16; ++g)
#pragma unroll
        for (int r = 0; r < 4; ++r) { const float e = __builtin_amdgcn_exp2f((lg[g][r] - m) * 1.4426950408889634f); lg[g][r] = e; ssum += e; }
    ssum += shx_f(ssum, 16, lane); ssum += shx_f(ssum, 32, lane);
    const float inv = 1.0f / ssum;
    f32x4 o[4];
#pragma unroll
    for (int db = 0; db < 4; ++db) o[db] = (f32x4){0.f, 0.f, 0.f, 0.f};
#define VSWZ(row_, chunk_) ((row_) * 128 + ((((chunk_)) ^ (2 * (((row_) >> 1) & 3))) * 16))
#define V_STEP(cur, nxt, ch_, HAS_NEXT) do { \
        _Pragma("unroll") for (int i = 0; i < 8; ++i) { const int row_ = (lane >> 3) + 8 * i; *(LAS v4u*)(vl + VSWZ(row_, lane & 7)) = cur[i]; } \
        LDS_WAIT(); asm volatile("" ::: "memory"); \
        if (HAS_NEXT) V_LOAD(nxt, (ch_) + 1); \
        _Pragma("unroll") for (int ss = 0; ss < 2; ++ss) { const int s2 = 2 * (ch_) + ss; \
            v4u w4; w4.x = cvtpk_s(lg[2 * s2][0] * inv, lg[2 * s2][1] * inv); w4.y = cvtpk_s(lg[2 * s2][2] * inv, lg[2 * s2][3] * inv); \
            w4.z = cvtpk_s(lg[2 * s2 + 1][0] * inv, lg[2 * s2 + 1][1] * inv); w4.w = cvtpk_s(lg[2 * s2 + 1][2] * inv, lg[2 * s2 + 1][3] * inv); \
            const bf16x8 pa = __builtin_bit_cast(bf16x8, w4); \
            _Pragma("unroll") for (int db = 0; db < 4; ++db) { const int r0_ = 32 * ss + 4 * q4 + tq, r1_ = r0_ + 16; \
                const v4i16_t lo = vtr(vl + VSWZ(r0_, 2 * db + (tp >> 1)) + 8 * (tp & 1)), hi2 = vtr(vl + VSWZ(r1_, 2 * db + (tp >> 1)) + 8 * (tp & 1)); \
                const bf16x8 vf = (bf16x8){lo[0], lo[1], lo[2], lo[3], hi2[0], hi2[1], hi2[2], hi2[3]}; \
                o[db] = __builtin_amdgcn_mfma_f32_16x16x32_bf16(pa, vf, o[db], 0, 0, 0); } } \
        LDS_WAIT(); asm volatile("" ::: "memory"); } while (0)
    V_STEP(vA, vA, 0, true); V_STEP(vA, vA, 1, true); V_STEP(vA, vA, 2, true); V_STEP(vA, vA, 3, false);
#undef V_LOAD
#undef V_STEP
#undef VSWZ
    if (q4 < 2) { bf16* op = F_OA + (size_t)(b * SEQ + t) * 512 + (4 * q4) * 64 + c16;
#pragma unroll
        for (int db = 0; db < 4; ++db)
#pragma unroll
            for (int r = 0; r < 4; ++r) op[r * 64 + 16 * db] = (bf16)f2bf(o[db][r]); }
}
__device__ __forceinline__ void idx_load(bf16x8 (&kb)[4], const bf16* kbase, int kt) {
    const bf16* kp = kbase + (size_t)(32 * kt) * 64;
#pragma unroll
    for (int ks = 0; ks < 4; ++ks) kb[ks] = *(const GAS bf16x8*)(kp + 16 * ks);
}
__device__ __forceinline__ f32x16 idx_chain(const bf16x8 (&q)[4], const bf16x8 (&kb)[4]) {
    f32x16 c;
#pragma unroll
    for (int i = 0; i < 16; ++i) c[i] = 0.f;
#pragma unroll
    for (int ks = 0; ks < 4; ++ks) c = __builtin_amdgcn_mfma_f32_32x32x16_bf16(q[ks], kb[ks], c, 0, 0, 0);
    return c;
}
struct IdxW { f32x4 a0, a1, b0, b1; };
__device__ __forceinline__ f32x16 idx_chain_valu(const bf16x8 (&q)[4], const bf16x8 (&kb)[4], const f32x16& co, const IdxW& w, LAS _Float16* sch, int jo, int kto, int r, int hb) {
    const f32x4 wa0 = w.a0, wa1 = w.a1, wb0 = w.b0, wb1 = w.b1;
    f32x16 c;
#pragma unroll
    for (int i = 0; i < 16; ++i) c[i] = 0.f;
#pragma unroll
    for (int ks = 0; ks < 4; ++ks) c = __builtin_amdgcn_mfma_f32_32x32x16_bf16(q[ks], kb[ks], c, 0, 0, 0);
#define RL(i_) relu_i(co[i_])
    f32x2_t a0 = (f32x2_t){wa0.x, wa0.y} * (f32x2_t){RL(0), RL(1)};
    a0 = __builtin_elementwise_fma((f32x2_t){wa0.z, wa0.w}, (f32x2_t){RL(2), RL(3)}, a0); a0 = __builtin_elementwise_fma((f32x2_t){wa1.x, wa1.y}, (f32x2_t){RL(4), RL(5)}, a0); a0 = __builtin_elementwise_fma((f32x2_t){wa1.z, wa1.w}, (f32x2_t){RL(6), RL(7)}, a0);
    f32x2_t a1 = (f32x2_t){wb0.x, wb0.y} * (f32x2_t){RL(8), RL(9)};
    a1 = __builtin_elementwise_fma((f32x2_t){wb0.z, wb0.w}, (f32x2_t){RL(10), RL(11)}, a1); a1 = __builtin_elementwise_fma((f32x2_t){wb1.x, wb1.y}, (f32x2_t){RL(12), RL(13)}, a1); a1 = __builtin_elementwise_fma((f32x2_t){wb1.z, wb1.w}, (f32x2_t){RL(14), RL(15)}, a1);
#undef RL
    const float s0 = a0.x + a0.y, s1 = a1.x + a1.y;
    sch[(4 * jo + hb) * 4096 + 32 * kto + r] = (_Float16)s0; sch[(4 * jo + hb + 2) * 4096 + 32 * kto + r] = (_Float16)s1;
#pragma unroll
    for (int g = 0; g < 4; ++g) { __builtin_amdgcn_sched_group_barrier(0x008, 1, 0); __builtin_amdgcn_sched_group_barrier(0x002, 8, 0); }
    return c;
}
__device__ __forceinline__ void dsa_item16(Frame& F, int b, int t0, int stop) {
    unsigned ones_ = ~0u; asm volatile("" : "+v"(ones_));
    const int lane = (int)__builtin_amdgcn_mbcnt_hi(ones_, __builtin_amdgcn_mbcnt_lo(ones_, 0u)), wave = F.wave;
    const int L = ((t0 >> 6) + 1) << 6;
    LAS _Float16* sch = (LAS _Float16*)(F.lds + RING_OFF);
    if (L > 256) {
        const int r = lane & 31, hb = lane >> 5;
        const int head = (r & 3) + 4 * ((r >> 3) & 1), qsub = ((r >> 2) & 1) + 2 * ((r >> 4) & 1);
        bf16x8 qa[4][4];
        LAS float* wl = (LAS float*)(F.lds + HIST_OFF) + wave * 512;
        { const f32x2_t w2 = *(const GAS f32x2_t*)(F_WIQ + (size_t)(b * SEQ + t0) * 8 + 2 * lane); *(LAS f32x2_t*)(wl + 2 * lane) = w2; }
#pragma unroll
        for (int j = 0; j < 4; ++j) {
            const bf16* qp = F_PROJ + (size_t)(b * SEQ + t0 + 4 * j + qsub) * PROJ_LD + 512 + head * 64 + 8 * hb;
#pragma unroll
            for (int ks = 0; ks < 4; ++ks) qa[j][ks] = *(const GAS bf16x8*)(qp + 16 * ks);
            { float xr[8]; unpk8(qa[j][0], xr); rope_frag(xr, hb == 0, 32, lane, F_ROPE + (size_t)(t0 + 4 * j + qsub) * 16); qa[j][0] = pk8(xr); }
        }
        LDS_WAIT(); asm volatile("" ::: "memory");
        const int ntile = L >> 5;
        const bf16* kbase = F_KI + (size_t)(b * SEQ + r) * 64 + 8 * hb;
        const int nmy = (ntile - wave + 7) >> 3;
#define IDX_CL(i_) (wave + 8 * ((i_) < nmy ? (i_) : nmy - 1))
#define IDX_STAGE(cn_, jn_, kbn_, co_, jo_, kto_) do { cn_ = idx_chain_valu(qa[jn_], kbn_, co_, W[jo_], sch, jo_, kto_, r, hb); } while (0)
        if (nmy > 0) {
            bf16x8 kbA[4], kbB[4];
            idx_load(kbA, kbase, wave);
            IdxW W[4];
#pragma unroll
            for (int j = 0; j < 4; ++j) { W[j].a0 = *(const LAS f32x4*)(wl + (4 * j + hb) * 8); W[j].a1 = *(const LAS f32x4*)(wl + (4 * j + hb) * 8 + 4); W[j].b0 = *(const LAS f32x4*)(wl + (4 * j + hb + 2) * 8); W[j].b1 = *(const LAS f32x4*)(wl + (4 * j + hb + 2) * 8 + 4); }
            f32x16 c0 = idx_chain(qa[0], kbA), c1;
            int i = 0;
#pragma unroll 1
            for (;;) {
                const int ktA = wave + 8 * i, ktB = ktA + 8;
                idx_load(kbB, kbase, IDX_CL(i + 1));
                IDX_STAGE(c1, 1, kbA, c0, 0, ktA); IDX_STAGE(c0, 2, kbA, c1, 1, ktA); IDX_STAGE(c1, 3, kbA, c0, 2, ktA); IDX_STAGE(c0, 0, kbB, c1, 3, ktA);
                if (i + 1 >= nmy) break;
                idx_load(kbA, kbase, IDX_CL(i + 2));
                IDX_STAGE(c1, 1, kbB, c0, 0, ktB); IDX_STAGE(c0, 2, kbB, c1, 1, ktB); IDX_STAGE(c1, 3, kbB, c0, 2, ktB); IDX_STAGE(c0, 0, kbA, c1, 3, ktB);
                i += 2;
                if (i >= nmy) break;
            }
        }
#undef IDX_CL
#undef IDX_STAGE
    }
    __syncthreads();
    if (stop == 1) { __syncthreads(); return; }
    LAS unsigned short* idx0 = (LAS unsigned short*)(F.lds + IDX_OFF) + wave * 512;
    LAS unsigned char* vl = (LAS unsigned char*)sch + wave * 8192;
    int nsel = 256;
    const bool early = wave < 4;
#pragma unroll 1
    for (int step = 0; step < 4; ++step) {
        const bool do_sel = early ? ((step & 1) == 0) : (step < 2);
        const int qq = early ? (step >> 1) : (step & 1);
        if (do_sel) {
            int Lq = L; asm volatile("" : "+s"(Lq));
            const LAS unsigned short* rowh = (const LAS unsigned short*)sch + (wave + 8 * qq) * 4096;
            LAS unsigned short* idxl = idx0 + 256 * qq;
            if (Lq <= 256) { nsel = Lq; for (int i = lane; i < 256; i += 64) idxl[i] = (unsigned short)((i < Lq) ? i : 0); }
            else {
                LAS unsigned* hist = (LAS unsigned*)(F.lds + HIST_OFF) + wave * 512;
                bool ok;
                if (Lq <= 1024) ok = select256_h16<16>(rowh, idxl, hist, Lq, lane); else if (Lq <= 2048) ok = select256_h16<32>(rowh, idxl, hist, Lq, lane); else if (Lq <= 3072) ok = select256_h16<48>(rowh, idxl, hist, Lq, lane); else ok = select256_h16<64>(rowh, idxl, hist, Lq, lane);
                if (!ok) select256_b16<64>(rowh, idxl, Lq, lane);
            }
            LDS_WAIT(); asm volatile("" ::: "memory");
        } else if (stop != 2) {
            if (nsel == 256) dsa_attend<true>(F, b, t0 + wave + 8 * qq, 256, idx0 + 256 * qq, vl, lane); else dsa_attend<false>(F, b, t0 + wave + 8 * qq, nsel, idx0 + 256 * qq, vl, lane);
        }
    }
    __syncthreads();
}
__device__ __forceinline__ void p3_attention(Frame& F, int rep) {
    const int stop = (rep == 1 && P3_MODE >= 2) ? P3_MODE - 1 : 0;
    if (!(rep == 1 && P3_MODE >= 2)) { for (int item = blockIdx.x; item < 512; item += F.G) sb_item_mfma(F, item);
    __syncthreads(); }
    if (rep == 1 && P3_MODE == 1) return;
    {
    gu32* qh = F.ctl + CW_QUEUE + 64 * rep;
    if (F.wave == 0 && fresh_lane() == 0) F.MISC[MI_Q] = __hip_atomic_fetch_add(qh, 1u, RLX_AGENT);
    __syncthreads();
    for (int par = 0;; par ^= 1) {
        const int it = (int)F.MISC[MI_Q + par];
        if (it >= 1024) break;
        if (F.wave == 0 && fresh_lane() == 0) F.MISC[MI_Q + (par ^ 1)] = __hip_atomic_fetch_add(qh, 1u, RLX_AGENT);
        const int chunk = 63 - (it >> 4), within = it & 15, b = within >> 2, g4 = within & 3;
        dsa_item16(F, b, chunk * 64 + g4 * 16, stop);
    }
    }
}

__device__ __forceinline__ void p6_router(Frame& F, int rep) {
    const size_t sh4 = rep ? (size_t)(WS_ACT - WS_TOKE) / 4 : 0, sh2 = rep ? (size_t)(WS_Y - WS_XN) / 2 : 0;
    const int lane = F.lane, w4 = F.wave & 3, hbk = F.wave >> 2, lt = F.tid & 255, r32 = lane & 31, hb = lane >> 5;
    LAS float* hs = (LAS float*)(F.lds + hbk * 70912);
    LAS float* red = hs;
    LAS float* lgt = hs + 32 * 516;
    LAS float* rrs = lgt + 32 * 33;
    LAS int* ent = (LAS int*)(rrs + 32);
    const float* H = (F.a->out);
    for (int tile0 = blockIdx.x * 2; tile0 < NTOK / 32; tile0 += 2 * F.G) {
        const int tok0 = (tile0 + hbk) * 32;
        f32x16 acc;
#pragma unroll
        for (int i = 0; i < 16; ++i) acc[i] = 0.f;
        f32x4 st[16];
#pragma unroll
        for (int i = 0; i < 16; ++i) { const int idx = lt + 256 * i; st[i] = *(const GAS f32x4*)(H + (size_t)(tok0 + (idx >> 7)) * DM + 4 * (idx & 127)); }
#pragma unroll 1
        for (int half = 0; half < 2; ++half) {
#pragma unroll
            for (int i = 0; i < 16; ++i) { const int idx = lt + 256 * i; *(LAS f32x4*)(hs + (idx >> 7) * 516 + 4 * (idx & 127)) = st[i]; }
            __syncthreads();
            if (half == 0) {
#pragma unroll
                for (int i = 0; i < 16; ++i) { const int idx = lt + 256 * i; st[i] = *(const GAS f32x4*)(H + (size_t)(tok0 + (idx >> 7)) * DM + 512 + 4 * (idx & 127)); } }
            {
                const int kl = w4 * 128 + 64 * hb;
                const float* wp = F_WRG + (size_t)(512 * half + kl) * 32 + r32;
                const LAS float* ap = hs + r32 * 516 + kl;
#pragma unroll
                for (int c = 0; c < 4; ++c) {
                    f32x4 a4[4]; float b1[16];
#pragma unroll
                    for (int j = 0; j < 4; ++j) a4[j] = *(const LAS f32x4*)(ap + 16 * c + 4 * j);
#pragma unroll
                    for (int j = 0; j < 16; ++j) b1[j] = wp[(size_t)(16 * c + j) * 32];
#pragma unroll
                    for (int j = 0; j < 16; ++j) acc = __builtin_amdgcn_mfma_f32_32x32x2f32(a4[j >> 2][j & 3], b1[j], acc, 0, 0, 0);
                }
            }
            __syncthreads();
        }
#pragma unroll
        for (int i = 0; i < 16; ++i) red[(w4 * 32 + (i & 3) + 8 * (i >> 2) + 4 * hb) * 33 + r32] = acc[i];
        if (lt < 32) { float ssq = 0.f;
#pragma unroll
            for (int i = 0; i < 16; ++i) ssq += F_SSQP[(size_t)(tok0 + lt) * 16 + i];
            rrs[lt] = 1.0f / sqrtf(ssq * (1.f / DM) + RMS_EPS); }
        __syncthreads();
        float sums[4];
#pragma unroll
        for (int q = 0; q < 4; ++q) { const int idx = lt + 256 * q, tk = idx >> 5, e = idx & 31; float sum = 0.f;
#pragma unroll
            for (int w2 = 0; w2 < 4; ++w2) sum += red[(w2 * 32 + tk) * 33 + e];
            sums[q] = sum; }
#pragma unroll
        for (int q = 0; q < 4; ++q) { const int idx = lt + 256 * q; lgt[(idx >> 5) * 33 + (idx & 31)] = sums[q]; }
        __syncthreads();
#pragma unroll
        for (int pass = 0; pass < 4; ++pass) {
            const int tl = 8 * w4 + 2 * pass + hb;
            float v = lgt[tl * 33 + r32] * rrs[tl] + (F.a->in[10])[r32];
            float tv[4]; int te[4];
#pragma unroll
            for (int k = 0; k < 4; ++k) { float bv = v; int be = r32;
#pragma unroll
                for (int o = 1; o < 32; o <<= 1) { const float ov = __shfl_xor(bv, o); const int oe = __shfl_xor(be, o); if (ov > bv || (ov == bv && oe < be)) { bv = ov; be = oe; } }
                tv[k] = bv; te[k] = be; if (r32 == be) v = -INFINITY; }
            float gk[4], gs = 0.f;
#pragma unroll
            for (int k = 0; k < 4; ++k) { gk[k] = __expf(tv[k] - tv[0]); gs += gk[k]; }
            const float ginv = 1.0f / gs;
            if (r32 < 4) { const int m = (tok0 + tl) * 4 + r32; const int ee = r32 == 0 ? te[0] : (r32 == 1 ? te[1] : (r32 == 2 ? te[2] : te[3])); const float gg = r32 == 0 ? gk[0] : (r32 == 1 ? gk[1] : (r32 == 2 ? gk[2] : gk[3]));
                (F_TOKE + sh4)[m] = ee; (F_TOKG + sh4)[m] = gg * ginv; ent[tl * 4 + r32] = ee; }
        }
        __syncthreads();
        if (w4 == 0) {
            const int e0 = ent[lane], e1 = ent[lane + 64];
            int mycnt = 0, r0 = 0, r1 = 0;
            for (int j = 0; j < 32; ++j) { const unsigned long long m0 = __ballot(e0 == j), m1 = __ballot(e1 == j); const int c0 = __popcll(m0);
                if (e0 == j) r0 = (int)__builtin_amdgcn_mbcnt_hi((unsigned)(m0 >> 32), __builtin_amdgcn_mbcnt_lo((unsigned)m0, 0u));
                if (e1 == j) r1 = c0 + (int)__builtin_amdgcn_mbcnt_hi((unsigned)(m1 >> 32), __builtin_amdgcn_mbcnt_lo((unsigned)m1, 0u));
                if (lane == j) mycnt = c0 + __popcll(m1); }
            int mybase = 0; if (lane < 32 && mycnt > 0) mybase = (int)__hip_atomic_fetch_add(F.ctl + CW_CNT + 64 * rep + lane, (unsigned)mycnt, RLX_AGENT);
            const int p0 = __shfl(mybase, e0) + r0, p1 = __shfl(mybase, e1) + r1;
            const int m0i = tok0 * 4 + lane, m1i = tok0 * 4 + lane + 64;
            (F_TOKP + sh4)[m0i] = p0; (F_LIST + sh4)[(size_t)e0 * NTOK + p0] = m0i;
            (F_TOKP + sh4)[m1i] = p1; (F_LIST + sh4)[(size_t)e1 * NTOK + p1] = m1i;
        }
#pragma unroll 2
        for (int i = 0; i < 8; ++i) { const int tl = w4 * 8 + i; const float rr = rrs[tl];
            const GAS f32x4* hr = (const GAS f32x4*)(H + (size_t)(tok0 + tl) * DM) + lane; const GAS f32x4* gr = (const GAS f32x4*)(F.a->in[8]) + lane;
            GAS int* o4 = (GAS int*)((unsigned char*)F_XN + sh2 + (size_t)(tok0 + tl) * DM) + lane;
#pragma unroll
            for (int j = 0; j < 4; ++j) { const f32x4 v = hr[64 * j], g = gr[64 * j]; int pk = __builtin_amdgcn_cvt_pk_fp8_f32(v.x * rr * g.x, v.y * rr * g.y, 0, false); pk = __builtin_amdgcn_cvt_pk_fp8_f32(v.z * rr * g.z, v.w * rr * g.w, pk, true); o4[64 * j] = pk; } }
        __syncthreads();
    }
}
__device__ __forceinline__ void compute_ts(Frame& F) {
    if (F.tid < 32) F.MISC[MI_CNT + F.tid] = __hip_atomic_load(F.ctl + CW_CNT + F.tid, RLX_AGENT);
    __syncthreads();
    if (F.tid == 0) { unsigned run = 0; for (int e = 0; e < 32; ++e) { F.MISC[MI_TS + e] = run; run += (F.MISC[MI_CNT + e] + 255u) >> 8; } F.MISC[MI_TS + 32] = run; }
    __syncthreads();
}
__device__ __forceinline__ void p7_gather(Frame& F) {
    const int gw = blockIdx.x * NWAVES + F.wave, NGW = F.G * NWAVES; const int T = (int)F.MISC[MI_TS + 32];
    for (int r = gw; r < T * 256; r += NGW) {
        const int rt = r >> 8; int e = 0; while (e < 31 && (int)F.MISC[MI_TS + e + 1] <= rt) ++e;
        const int local = r - 256 * (int)F.MISC[MI_TS + e]; const bool valid = local < (int)F.MISC[MI_CNT + e];
        v4u a = {0u, 0u, 0u, 0u};
        if (valid) { const int tok = F_LIST[(size_t)e * NTOK + local] >> 2; a = ((const GAS v4u*)((unsigned char*)F_XN + (size_t)tok * DM))[F.lane]; }
        ((GAS v4u*)((unsigned char*)F_XG + (size_t)r * DM))[F.lane] = a;
    }
}
__device__ __forceinline__ void p10_combine(Frame& F, int rep) {
    const int gw = blockIdx.x * NWAVES + F.wave, NGW = F.G * NWAVES;
    for (int tok = gw; tok < NTOK; tok += NGW) {
        float g[4]; const unsigned char* yr[4];
#pragma unroll
        for (int k = 0; k < 4; ++k) { const int m = tok * 4 + k; const int e = F_TOKE[m]; g[k] = F_TOKG[m]; yr[k] = (const unsigned char*)F_Y + (size_t)(256 * (int)F.MISC[MI_TS + e] + F_TOKP[m]) * DM; }
        GAS f32x4* hr = (GAS f32x4*)((F.a->out) + (size_t)tok * DM) + F.lane;
#pragma unroll
        for (int j = 0; j < 4; ++j) { f32x4 v = hr[64 * j];
#pragma unroll
            for (int k = 0; k < 4; ++k) { const int y = *((const GAS int*)yr[k] + 64 * j + F.lane); const f32x2_t lo = __builtin_amdgcn_cvt_pk_f32_fp8(y, false), hi = __builtin_amdgcn_cvt_pk_f32_fp8(y, true);
                v.x += g[k] * lo.x; v.y += g[k] * lo.y; v.z += g[k] * hi.x; v.w += g[k] * hi.y; }
            if (rep) ((GAS f32x4*)(WSP(float, WS_XG) + (size_t)tok * DM) + F.lane)[64 * j] = v; else hr[64 * j] = v; }
    }
}

__global__ void __launch_bounds__(NWAVES * 64, 2) mk_fwd(Args args) {
    extern __shared__ __attribute__((aligned(16))) unsigned char lds[];
    Frame F;
    F.lds = (LAS unsigned char*)lds;
    F.MISC = (volatile LAS unsigned*)(F.lds + MISC_OFF);
    F.tid = threadIdx.x; F.lane = F.tid & 63; F.wave = __builtin_amdgcn_readfirstlane(F.tid >> 6);
    F.G = gridDim.x;
    F.a = &args;
    F.ctl = (gu32*)(args.ws + WS_CTL);
    for (int u = F.tid; u < (LDS_BYTES - LDSCTL_OFF) / 4; u += NWAVES * 64) ((LAS unsigned*)(F.lds + LDSCTL_OFF))[u] = 0u;
    __syncthreads();
    XcdBarrier bar; bar.bar = (unsigned*)(F.ctl + CW_BAR); bar.x = 0; bar.st = nullptr;
    if (N_LAUNCHES == 1) bar = xcd_barrier_post((unsigned*)(F.ctl + CW_BAR), F.MISC + MI_BAR);
    const int lo = args.ph_lo, hi = args.ph_hi;
#ifdef PHASE_ONLY
#define IN(k) ((k) == PHASE_ONLY && lo <= (k) && (k) < hi)
#else
#define IN(k) (lo <= (k) && (k) < hi)
#endif
#ifndef REPEAT_PHASE
#define REPEAT_PHASE -1
#endif
#define REFRESH() do { F.lane = fresh_lane(); F.tid = F.lane + 64 * F.wave; } while (0)
#ifndef P1_MODE
#define P1_MODE 0
#endif
#ifndef DOUBLE_BAR
#define DOUBLE_BAR 0
#endif
#define SEAM(k) do { if (IN(k) && IN((k) + 1)) { xcd_barrier(bar, F.wave == 0 && fresh_lane() == 0); if (DOUBLE_BAR) xcd_barrier(bar, F.wave == 0 && fresh_lane() == 0); } } while (0)
    const bool split = (F.G & 31) == 0 && F.G >= 64;
    const int NCV = split ? F.G / 4 : 0;
    if (IN(0)) { REFRESH(); p0_prologue(F, split ? MOE_P1_ITEMS : 0); __syncthreads(); } SEAM(0);
    if (IN(1)) { REFRESH(); pg8::Gemm g{F_XN, F_WI, NTOK, NPROJ_PAD, DM}; pg8::StaticOrder S; S.init(NTOK, NPROJ_PAD, F.G, (int)blockIdx.x);
        if (split) { const int slot = (int)blockIdx.x >> 3, xcd = (int)blockIdx.x & 7;
            if ((slot & 3) == 3) { const int cc = (slot >> 2) * 8 + xcd; if (!(P1_MODE == 1 && args.rep)) p1_convert(F, cc, NCV, MOE_P1_ITEMS); __syncthreads(); S.G = NCV; S.c = S.nwg - NCV + cc; }
            else { S.G = F.G - NCV; S.c = (slot - (slot >> 2)) * 8 + xcd; S.lim = S.nwg - NCV; } }
        if (P1_MODE == 2 && args.rep) S.lim = 0;
        pg8::EpiProj E{F_PROJ, F_SMALLF}; pg8::gemm_phase<pg8::EpiProj, pg8::StaticOrder, true, true>(F.lds + RING_OFF, g, S, E, F.wave); } SEAM(1);
    if (IN(2)) { REFRESH(); p2_prep(F, args.rep); } SEAM(2);
    if (IN(3)) { REFRESH(); p3_attention(F, args.rep); } SEAM(3);
    if (IN(4)) { REFRESH(); pg8::StaticOrder S; S.init(NTOK, DM, F.G, (int)blockIdx.x);
        { pg8::Gemm g{F_OA, F_WPA, NTOK, DM, 512}; pg8::EpiGate<true> E{F_PROJ, 2560, F_MERGED}; pg8::gemm_phase<pg8::EpiGate<true>, pg8::StaticOrder, true, true>(F.lds + RING_OFF, g, S, E, F.wave); }
        { pg8::Gemm g{F_OB, F_WPB, NTOK, DM, 512}; pg8::EpiGate<false> E{F_PROJ, 3584, F_MERGED}; pg8::gemm_phase<pg8::EpiGate<false>, pg8::StaticOrder, true, true>(F.lds + RING_OFF, g, S, E, F.wave); } } SEAM(4);
    if (IN(5)) { REFRESH(); pg8::Gemm g{F_MERGED, F_WO, NTOK, DM, DM}; pg8::StaticOrder S; S.init(NTOK, DM, F.G, (int)blockIdx.x);
        pg8::EpiOut E{(F.a->in[0]), (F.a->out), F_SSQP}; pg8::gemm_phase<pg8::EpiOut, pg8::StaticOrder, true, true>(F.lds + RING_OFF, g, S, E, F.wave); } SEAM(5);
    if (IN(6)) { REFRESH(); p6_router(F, args.rep); } SEAM(6);
    REFRESH();
    if (hi > 7) compute_ts(F);
    if (IN(8)) { REFRESH(); pg8::Gemm g{F_XN, F_WGU, 0, 2048, DM / 2}; pg8::MoeOrder S; S.init((const volatile LAS int*)(F.MISC + MI_TS), (const volatile LAS int*)(F.MISC + MI_CNT), F_LIST, 8, F.G, (int)blockIdx.x);
        pg8::EpiAct E{(F.a->in[12]), (unsigned char*)F_ACT}; pg8::gemm_phase<pg8::EpiAct, pg8::MoeOrder, true, true, true, true>(F.lds + RING_OFF, g, S, E, F.wave);
        __syncthreads(); REFRESH(); p8_convert_wd(F, args.rep); } SEAM(8);
    if (IN(9)) { REFRESH(); pg8::Gemm g{F_ACT, F_WD, 0, DM, DM / 2}; pg8::MoeOrder S; S.init((const volatile LAS int*)(F.MISC + MI_TS), (const volatile LAS int*)(F.MISC + MI_CNT), F_LIST, 4, F.G, (int)blockIdx.x);
        pg8::EpiDown E{(F.a->in[14]), (unsigned char*)F_Y}; pg8::gemm_phase<pg8::EpiDown, pg8::MoeOrder, true, true, true>(F.lds + RING_OFF, g, S, E, F.wave); } SEAM(9);
    if (IN(10)) { REFRESH(); p10_combine(F, args.rep);
        if (N_LAUNCHES == 1) {
            const unsigned bad = __hip_atomic_load((gu32*)((unsigned*)(F.ctl + CW_BAR) + XB_TMO), RLX_AGENT);
            if (bad) { const float q = __builtin_nanf(""); for (size_t i = (size_t)blockIdx.x * 512 + F.tid; i < (size_t)NTOK * DM; i += (size_t)F.G * 512) (F.a->out)[i] = q; } } }
#undef IN
#undef SEAM
}

extern "C" void kernel_launch(void* const* d_in, const int* in_sizes, int n_in, void* d_out, int out_size, void* d_ws, size_t ws_size, hipStream_t stream) {
    static int grid = 0;
    if (grid == 0) {
        if (n_in != 15 || in_sizes[0] != NTOK * DM || out_size != NTOK * DM || ws_size < WS_END) { fprintf(stderr, "kernel_launch: unexpected shapes / workspace (n_in %d, in0 %d, out %d, ws %zu); nothing launched\n", n_in, n_in > 0 ? in_sizes[0] : -1, out_size, ws_size); grid = -1; return; }
        int dev = 0, cus = 0, per_cu = 0;
        if (hipGetDevice(&dev) != hipSuccess || hipDeviceGetAttribute(&cus, hipDeviceAttributeMultiprocessorCount, dev) != hipSuccess) { fprintf(stderr, "kernel_launch: device query failed\n"); grid = -1; return; }
        if (hipFuncSetAttribute((const void*)mk_fwd, hipFuncAttributeMaxDynamicSharedMemorySize, LDS_BYTES) != hipSuccess) { fprintf(stderr, "kernel_launch: hipFuncSetAttribute failed\n"); grid = -1; return; }
        if (hipOccupancyMaxActiveBlocksPerMultiprocessor(&per_cu, (const void*)mk_fwd, NWAVES * 64, LDS_BYTES) != hipSuccess || per_cu < 1) { fprintf(stderr, "kernel_launch: occupancy query says %d workgroups per CU; nothing launched\n", per_cu); (void)hipGetLastError(); grid = -1; return; }
        grid = cus;
    }
    if (grid < 0) return;
    if (hipMemsetAsync((char*)d_ws + WS_CTL, 0, CTL_ZERO_BYTES, stream) != hipSuccess) { fprintf(stderr, "kernel_launch: hipMemsetAsync failed\n"); return; }
    Args a{};
    for (int i = 0; i < 15; ++i) a.in[i] = (const float*)d_in[i];
    a.out = (float*)d_out; a.ws = (unsigned char*)d_ws;
    for (int li = 0; li < N_LAUNCHES; ++li) {
        a.ph_lo = (N_LAUNCHES == 1) ? 0 : li; a.ph_hi = (N_LAUNCHES == 1) ? N_PHASES : li + 1;
        for (int rep = 0; rep < ((N_LAUNCHES != 1 && li == REPEAT_PHASE) ? 2 : 1); ++rep) {
            a.rep = rep;
            hipLaunchKernelGGL(mk_fwd, dim3(grid), dim3(NWAVES * 64), LDS_BYTES, stream, a);
            const hipError_t le = hipPeekAtLastError();
            if (le != hipSuccess) { fprintf(stderr, "kernel_launch: launch %d failed: %s\n", li, hipGetErrorName(le)); return; }
        }
    }
}
```

```cpp
#include <hip/hip_runtime.h>
#include <cstdio>
#include <cstdint>
namespace pg8 {
#define PG8_LAS __attribute__((address_space(3)))
typedef unsigned short bf16_t;
typedef short bf16x8 __attribute__((ext_vector_type(8)));
typedef float f32x4 __attribute__((ext_vector_type(4)));
typedef unsigned u32x4 __attribute__((ext_vector_type(4)));
constexpr int BM = 256, BK = 64, HALF = 128, HTB = HALF * BK * 2  , STAGE_BYTES = 8 * HTB, NXCD = 8, WGM = 8;

__host__ __device__ __forceinline__ int lds_byte(int r, int c) { const int st = (r >> 4) * 2 + (c >> 5), rr = r & 15, cc = c & 31, ob = rr * 64 + cc * 2; return st * 1024 + (ob ^ (((ob >> 9) & 1) << 5)); }
__host__ __device__ __forceinline__ void stage_rc(int b, int& R, int& C) { const int st = b / 1024, sb = b % 1024, swz = sb ^ (((sb >> 9) & 1) << 5); R = (st >> 1) * 16 + swz / 64; C = (st & 1) * 32 + (swz % 64) / 2; }
__host__ __device__ __forceinline__ int perm32(int rho) { const int n = rho >> 4, i = rho & 15; return 8 * (i >> 2) + 4 * n + (i & 3); }

struct Unit { int pm, pn, pb, e; };
struct Gemm { const bf16_t* A; const bf16_t* Bt; int M, N, K; };

struct StaticOrder {
    int nM, nN, nwg, G, c, lim;
    __host__ __device__ void init(int M, int N, int G_, int c_) { nM = M / BM; nN = N / BM; nwg = nM * nN; G = G_; c = c_; lim = nwg; }
    __host__ __device__ bool next(int i, Unit& u) const {
        const long L = (long)i * G + c; if (L >= lim) return false;
        int wgid = (int)L; { const int q = nwg / NXCD, r = nwg % NXCD, xcd = wgid % NXCD, off = wgid / NXCD; wgid = (xcd < r ? xcd * (q + 1) : r * (q + 1) + (xcd - r) * q) + off; }
        const int nig = WGM * nN, gid = wgid / nig, fm = gid * WGM, gsz = (nM - fm) < WGM ? (nM - fm) : WGM;
        u.pm = fm + ((wgid % nig) % gsz); u.pn = (wgid % nig) / gsz; u.pb = u.pn; u.e = 0; return true;
    }
    __device__ __forceinline__ void a_ready(const Unit&) const {}
    __device__ __forceinline__ void done(const Unit&) const {}
    __device__ __forceinline__ int tok(const Unit&, int) const { return 0; }
};


__device__ __forceinline__ unsigned cvt_pk_bf16(float lo, float hi) { unsigned r; asm volatile("v_cvt_pk_bf16_f32 %0, %1, %2" : "=v"(r) : "v"(lo), "v"(hi)); return r; }
__device__ __forceinline__ float bf_lo(unsigned w) { return __uint_as_float(w << 16); }
__device__ __forceinline__ float bf_hi(unsigned w) { return __uint_as_float(w & 0xffff0000u); }
__device__ __forceinline__ float sigmoidf_(float x) { return 1.0f / (1.0f + __expf(-x)); }
__device__ __forceinline__ u32x4 pack8(const f32x4& v0, const f32x4& v1) { u32x4 w; w.x = cvt_pk_bf16(v0[0], v0[1]); w.y = cvt_pk_bf16(v0[2], v0[3]); w.z = cvt_pk_bf16(v1[0], v1[1]); w.w = cvt_pk_bf16(v1[2], v1[3]); return w; }
__device__ __forceinline__ void unpack8(const u32x4& w, f32x4& v0, f32x4& v1) { v0 = (f32x4){bf_lo(w.x), bf_hi(w.x), bf_lo(w.y), bf_hi(w.y)}; v1 = (f32x4){bf_lo(w.z), bf_hi(w.z), bf_lo(w.w), bf_hi(w.w)}; }

struct EpiProj {
    static constexpr bool PERM = true, AFTER_DRAIN = false;
    bf16_t* PROJ; float* SMALLF;
    __device__ __forceinline__ void operator()(const f32x4 (&acc)[2][2][4][2], const Unit& u, int wr, int wc, int fr, int fq) const {
        const int row0 = u.pm * BM + wr * 64 + fr, cl = wc * 32 + 8 * fq;
        if (u.pn < 18) {
            const int mode = (u.pn >= 10) ? 2 : ((u.pn == 4 || u.pn == 5) ? 1 : 0);
#pragma unroll
            for (int ai = 0; ai < 2; ++ai)
#pragma unroll
                for (int m = 0; m < 4; ++m) { bf16_t* rowp = PROJ + (size_t)(row0 + ai * HALF + m * 16) * 4608 + u.pn * BM + cl;
#pragma unroll
                    for (int bj = 0; bj < 2; ++bj) { f32x4 v0 = acc[ai][bj][m][0], v1 = acc[ai][bj][m][1];
                        if (mode == 1) { v0 = v0 * 0.125f; v1 = v1 * 0.125f; }
                        else if (mode == 2) {
#pragma unroll
                            for (int j = 0; j < 4; ++j) { v0[j] = sigmoidf_(v0[j]); v1[j] = sigmoidf_(v1[j]); } }
                        *(u32x4*)(rowp + bj * HALF) = pack8(v0, v1); } }
        } else {
#pragma unroll
            for (int ai = 0; ai < 2; ++ai)
#pragma unroll
                for (int m = 0; m < 4; ++m) { float* rowp = SMALLF + (size_t)(row0 + ai * HALF + m * 16) * 256 + cl;
#pragma unroll
                    for (int bj = 0; bj < 2; ++bj) { *(f32x4*)(rowp + bj * HALF) = acc[ai][bj][m][0]; *(f32x4*)(rowp + bj * HALF + 4) = acc[ai][bj][m][1]; } }
        }
    }
};
template <bool FIRST> struct EpiGate {
    static constexpr bool PERM = true, AFTER_DRAIN = false;
    const bf16_t* PROJ; int goff; bf16_t* MERGED;
    __device__ __forceinline__ void operator()(const f32x4 (&acc)[2][2][4][2], const Unit& u, int wr, int wc, int fr, int fq) const {
        const int row0 = u.pm * BM + wr * 64 + fr, col0 = u.pn * BM + wc * 32 + 8 * fq;
#pragma unroll
        for (int ai = 0; ai < 2; ++ai)
#pragma unroll
            for (int m = 0; m < 4; ++m) { const size_t row = (size_t)(row0 + ai * HALF + m * 16);
#pragma unroll
                for (int bj = 0; bj < 2; ++bj) { const int col = col0 + bj * HALF;
                    const u32x4 gw = *(const u32x4*)(PROJ + row * 4608 + goff + col); f32x4 g0, g1; unpack8(gw, g0, g1);
                    f32x4 v0 = acc[ai][bj][m][0] * g0, v1 = acc[ai][bj][m][1] * g1;
                    bf16_t* mp = MERGED + row * 1024 + col;
                    if (!FIRST) { const u32x4 pw = *(const u32x4*)mp; f32x4 p0, p1; unpack8(pw, p0, p1); v0 = v0 + p0; v1 = v1 + p1; }
                    *(u32x4*)mp = pack8(v0, v1); } }
    }
};
struct EpiOut {
    static constexpr bool PERM = true, AFTER_DRAIN = false;
    const float* X; float* OUT; float* SSQP;
    __device__ __forceinline__ void operator()(const f32x4 (&acc)[2][2][4][2], const Unit& u, int wr, int wc, int fr, int fq) const {
        const int row0 = u.pm * BM + wr * 64 + fr, col0 = u.pn * BM + wc * 32 + 8 * fq;
#pragma unroll
        for (int ai = 0; ai < 2; ++ai)
#pragma unroll
            for (int m = 0; m < 4; ++m) { const size_t row = (size_t)(row0 + ai * HALF + m * 16); float s = 0.f;
#pragma unroll
                for (int bj = 0; bj < 2; ++bj) { const size_t off = row * 1024 + col0 + bj * HALF;
                    const f32x4 x0 = *(const f32x4*)(X + off), x1 = *(const f32x4*)(X + off + 4);
                    const f32x4 h0 = x0 + acc[ai][bj][m][0], h1 = x1 + acc[ai][bj][m][1];
                    *(f32x4*)(OUT + off) = h0; *(f32x4*)(OUT + off + 4) = h1;
                    s += (h0[0] * h0[0] + h0[1] * h0[1]) + (h0[2] * h0[2] + h0[3] * h0[3]) + (h1[0] * h1[0] + h1[1] * h1[1]) + (h1[2] * h1[2] + h1[3] * h1[3]); }
                s += __shfl_xor(s, 16); s += __shfl_xor(s, 32);
                if (fq == 0) SSQP[row * 16 + u.pn * 4 + wc] = s; }
    }
};
struct EpiAct {
    static constexpr bool PERM = true, AFTER_DRAIN = false;
    const float* BGU; unsigned char* ACT;
    __device__ __forceinline__ void operator()(const f32x4 (&acc)[2][2][4][2], const Unit& u, int wr, int wc, int fr, int fq) const {
        const int row0 = u.pm * BM + wr * 64 + fr, j0 = u.pn * HALF + wc * 32 + 8 * fq;
        const float* bg = BGU + (size_t)u.e * 2048 + j0;
        const f32x4 bg0 = *(const f32x4*)bg, bg1 = *(const f32x4*)(bg + 4), bu0 = *(const f32x4*)(bg + 1024), bu1 = *(const f32x4*)(bg + 1028);
#pragma unroll
        for (int ai = 0; ai < 2; ++ai)
#pragma unroll
            for (int m = 0; m < 4; ++m) { f32x4 o[2];
#pragma unroll
                for (int n = 0; n < 2; ++n) { const f32x4 g = acc[ai][0][m][n] + (n ? bg1 : bg0), up = acc[ai][1][m][n] + (n ? bu1 : bu0);
#pragma unroll
                    for (int j = 0; j < 4; ++j) { const float gc = fminf(g[j], 7.0f), uc = fminf(fmaxf(up[j], -7.0f), 7.0f); o[n][j] = (uc + 1.0f) * gc * sigmoidf_(1.702f * gc); } }
                int p0 = __builtin_amdgcn_cvt_pk_fp8_f32(o[0][0], o[0][1], 0, false); p0 = __builtin_amdgcn_cvt_pk_fp8_f32(o[0][2], o[0][3], p0, true);
                int p1 = __builtin_amdgcn_cvt_pk_fp8_f32(o[1][0], o[1][1], 0, false); p1 = __builtin_amdgcn_cvt_pk_fp8_f32(o[1][2], o[1][3], p1, true);
                typedef int i32x2 __attribute__((ext_vector_type(2)));
                *(i32x2*)(ACT + (size_t)(row0 + ai * HALF + m * 16) * 1024 + j0) = (i32x2){p0, p1}; }
    }
};
struct EpiDown {
    static constexpr bool PERM = true, AFTER_DRAIN = false;
    const float* BD; unsigned char* Y;
    __device__ __forceinline__ void operator()(const f32x4 (&acc)[2][2][4][2], const Unit& u, int wr, int wc, int fr, int fq) const {
        const int row0 = u.pm * BM + wr * 64 + fr, col0 = u.pn * BM + wc * 32 + 8 * fq;
        f32x4 bv[2][2];
#pragma unroll
        for (int bj = 0; bj < 2; ++bj)
#pragma unroll
            for (int n = 0; n < 2; ++n) bv[bj][n] = *(const f32x4*)(BD + (size_t)u.e * 1024 + col0 + bj * HALF + 4 * n);
#pragma unroll
        for (int ai = 0; ai < 2; ++ai)
#pragma unroll
            for (int m = 0; m < 4; ++m) { unsigned char* rowp = Y + (size_t)(row0 + ai * HALF + m * 16) * 1024 + col0;
#pragma unroll
                for (int bj = 0; bj < 2; ++bj) { const f32x4 v0 = acc[ai][bj][m][0] + bv[bj][0], v1 = acc[ai][bj][m][1] + bv[bj][1];
                    int p0 = __builtin_amdgcn_cvt_pk_fp8_f32(v0[0], v0[1], 0, false); p0 = __builtin_amdgcn_cvt_pk_fp8_f32(v0[2], v0[3], p0, true);
                    int p1 = __builtin_amdgcn_cvt_pk_fp8_f32(v1[0], v1[1], 0, false); p1 = __builtin_amdgcn_cvt_pk_fp8_f32(v1[2], v1[3], p1, true);
                    typedef int i32x2 __attribute__((ext_vector_type(2)));
                    *(i32x2*)(rowp + bj * HALF) = (i32x2){p0, p1}; } }
    }
};
struct MoeOrder {
    const volatile PG8_LAS int* ts; const volatile PG8_LAS int* cnt; const int* LIST; int T, nN, nwg, G, c;
    __device__ void init(const volatile PG8_LAS int* ts_, const volatile PG8_LAS int* cnt_, const int* LIST_, int nN_, int G_, int c_) { ts = ts_; cnt = cnt_; LIST = LIST_; T = ts_[32]; nN = nN_; nwg = T * nN_; G = G_; c = c_; }
    __device__ __forceinline__ int tok(const Unit& u, int r) const { const int pos = 256 * (u.pm - ts[u.e]) + r; return pos < cnt[u.e] ? (LIST[(size_t)u.e * 16384 + pos] >> 2) : 0; }
    __device__ bool next(int i, Unit& u) const {
        const long L = (long)i * G + c; if (L >= nwg) return false;
        int wgid = (int)L; { const int q = nwg / NXCD, r = nwg % NXCD, xcd = wgid % NXCD, off = wgid / NXCD; wgid = (xcd < r ? xcd * (q + 1) : r * (q + 1) + (xcd - r) * q) + off; }
        const int nig = WGM * nN, gid = wgid / nig, fm = gid * WGM, gsz = (T - fm) < WGM ? (T - fm) : WGM;
        u.pm = fm + ((wgid % nig) % gsz); u.pn = (wgid % nig) / gsz;
        int e = 0; while (e < 31 && ts[e + 1] <= u.pm) ++e;
        u.e = e; u.pb = e * nN + u.pn; return true;
    }
    __device__ __forceinline__ void a_ready(const Unit&) const {}
    __device__ __forceinline__ void done(const Unit&) const {}
};

typedef int v4i_t __attribute__((ext_vector_type(4))); typedef int v8i_t __attribute__((ext_vector_type(8)));
__device__ __forceinline__ v8i_t cat8(bf16x8 a, bf16x8 b) { const v4i_t x = __builtin_bit_cast(v4i_t, a), y = __builtin_bit_cast(v4i_t, b); return __builtin_shufflevector(x, y, 0, 1, 2, 3, 4, 5, 6, 7); }
__device__ __forceinline__ void mfma_f8(f32x4& acc, const v8i_t& wfrag, const v8i_t& afrag) {
    asm volatile("s_nop 1\n\tv_mfma_scale_f32_16x16x128_f8f6f4 %0, %1, %2, %0, %3, %4 op_sel_hi:[0,0,0]" : "+v"(acc) : "v"(wfrag), "v"(afrag), "v"(0x7a7a7a7a), "v"(0x7f7f7f7f));
}
template <class Epi, class Sched, bool ALIGN_EPI = false, bool SP2 = false, bool FP8 = false, bool GATHER = false>
__device__ __forceinline__ void gemm_phase(PG8_LAS unsigned char* lds, const Gemm g, const Sched& S, const Epi& E, const int wave_id) {
    unsigned ones_ = ~0u; asm volatile("" : "+v"(ones_));
    const int wid = wave_id, tid = (int)__builtin_amdgcn_mbcnt_hi(ones_, __builtin_amdgcn_mbcnt_lo(ones_, 0u)) + 64 * wave_id, lane = tid & 63, wr = wid >> 2, wc = wid & 3, fr = lane & 15, fq = lane >> 4;
    const int K = g.K, nt = K / BK;
    unsigned voffA[2], voffB[2]; int stR[2], stC[2];
#pragma unroll
    for (int i = 0; i < 2; ++i) { int R, C; stage_rc(tid * 16 + i * 8192, R, C); const int Rb = Epi::PERM ? ((R & ~31) + perm32(R & 31)) : R;
        voffA[i] = (unsigned)(R * K + C) * 2u; voffB[i] = (unsigned)(Rb * K + C) * 2u; stR[i] = R; stC[i] = C; }
    const size_t kstep = (size_t)(BK * 2);
    const size_t hstep = (size_t)HALF * K * 2;
    const size_t tstep = 2 * hstep;
    const unsigned ldsw = (unsigned)wid * 1024u;
    const int aoff = lds_byte(wr * 64 + fr, fq * 8), boff = lds_byte(wc * 32 + fr, fq * 8);
#define PG8_SA(b, h) (((b) * 2 + (h)) * HTB)
#define PG8_SB(b, h) ((4 + (b) * 2 + (h)) * HTB)
#define PG8_STAGE(bufoff, gbase, voff) do { _Pragma("unroll") for (int _i = 0; _i < 2; ++_i) \
        __builtin_amdgcn_global_load_lds((const unsigned*)((const char*)(gbase) + (voff)[_i]), (PG8_LAS unsigned*)(lds + (bufoff) + ldsw + _i * 8192), 16, 0, 0); } while (0)
#define PG8_LDA(dst, b, h) do { _Pragma("unroll") for (int m = 0; m < 4; ++m) { _Pragma("unroll") for (int k = 0; k < 2; ++k) dst[m][k] = *(const PG8_LAS bf16x8*)(lds + PG8_SA(b, h) + aoff + m * 2048 + k * 1024); if constexpr (FP8) dst##8[m] = cat8(dst[m][0], dst[m][1]); } } while (0)
#define PG8_LDB(dst, b, h) do { _Pragma("unroll") for (int n = 0; n < 2; ++n) { _Pragma("unroll") for (int k = 0; k < 2; ++k) dst[n][k] = *(const PG8_LAS bf16x8*)(lds + PG8_SB(b, h) + boff + n * 2048 + k * 1024); if constexpr (FP8) dst##8[n] = cat8(dst[n][0], dst[n][1]); } } while (0)
#define PG8_MMA(ai, bj, At, Bt) do { __builtin_amdgcn_s_setprio(1); _Pragma("unroll") for (int m = 0; m < 4; ++m) _Pragma("unroll") for (int n = 0; n < 2; ++n) { \
        if constexpr (FP8) { mfma_f8(acc[ai][bj][m][n], Bt##8[n], At##8[m]); } \
        else { _Pragma("unroll") for (int k = 0; k < 2; ++k) acc[ai][bj][m][n] = __builtin_amdgcn_mfma_f32_16x16x32_bf16(Bt[n][k], At[m][k], acc[ai][bj][m][n], 0, 0, 0); } } \
        __builtin_amdgcn_s_setprio(0); } while (0)
#define PG8_WAIT_V(n) asm volatile("s_waitcnt vmcnt(" #n ")" ::: "memory")
#define PG8_WAIT_L(n) asm volatile("s_waitcnt lgkmcnt(" #n ")" ::: "memory")
#define PG8_BAR __builtin_amdgcn_s_barrier()
#define PG8_SCHED __builtin_amdgcn_sched_barrier(0)
    Unit cur, nxt; int ui = 0;
    if (!S.next(0, cur)) return;
    f32x4 acc[2][2][4][2];
#pragma unroll
    for (int a = 0; a < 2; ++a)
#pragma unroll
        for (int b = 0; b < 2; ++b)
#pragma unroll
            for (int m = 0; m < 4; ++m)
#pragma unroll
                for (int n = 0; n < 2; ++n) acc[a][b][m][n] = (f32x4){0.f, 0.f, 0.f, 0.f};
    bf16x8 At[4][2], B0[2][2], B1[2][2]; v8i_t At8[4], B08[2], B18[2];
    const char* cA = GATHER ? (const char*)g.A : (const char*)g.A + (size_t)cur.pm * tstep; const char* cB = (const char*)g.Bt + (size_t)cur.pb * tstep;
    unsigned vC[2][2], vN[2][2];
#define PG8_GROWS(V, u_) do { _Pragma("unroll") for (int h_ = 0; h_ < 2; ++h_) _Pragma("unroll") for (int i_ = 0; i_ < 2; ++i_) V[h_][i_] = (unsigned)S.tok(u_, 128 * h_ + stR[i_]) * (unsigned)(K * 2) + (unsigned)stC[i_] * 2u; } while (0)
    if constexpr (GATHER) { PG8_GROWS(vC, cur); }
    else {
#pragma unroll
        for (int h_ = 0; h_ < 2; ++h_)
#pragma unroll
            for (int i_ = 0; i_ < 2; ++i_) vC[h_][i_] = voffA[i_] + (unsigned)(h_ * hstep); }
#pragma unroll
    for (int h_ = 0; h_ < 2; ++h_)
#pragma unroll
        for (int i_ = 0; i_ < 2; ++i_) vN[h_][i_] = vC[h_][i_];
    S.a_ready(cur);
    if constexpr (SP2) {
        PG8_STAGE(PG8_SB(0, 0), cB, voffB); PG8_STAGE(PG8_SB(0, 1), cB + hstep, voffB); PG8_STAGE(PG8_SA(0, 0), cA, vC[0]); PG8_STAGE(PG8_SA(0, 1), cA, vC[1]);
        if (wr == 1) PG8_BAR;
        PG8_WAIT_V(2); PG8_BAR;
        PG8_STAGE(PG8_SB(1, 0), cB + kstep, voffB); PG8_STAGE(PG8_SA(1, 0), cA + kstep, vC[0]); PG8_STAGE(PG8_SB(1, 1), cB + hstep + kstep, voffB);
        PG8_WAIT_V(6); PG8_BAR;
    } else {
        PG8_STAGE(PG8_SB(0, 0), cB, voffB); PG8_STAGE(PG8_SA(0, 0), cA, vC[0]); PG8_STAGE(PG8_SB(0, 1), cB + hstep, voffB); PG8_STAGE(PG8_SA(0, 1), cA, vC[1]);
        if (wr == 1) PG8_BAR;
        PG8_WAIT_V(4); PG8_BAR;
        PG8_STAGE(PG8_SB(1, 0), cB + kstep, voffB); PG8_STAGE(PG8_SA(1, 0), cA + kstep, vC[0]); PG8_STAGE(PG8_SB(1, 1), cB + hstep + kstep, voffB);
        PG8_WAIT_V(6); PG8_BAR;
    }
    for (;;) {
        const bool has_next = S.next(ui + 1, nxt);
        if constexpr (GATHER) { if (has_next) { PG8_GROWS(vN, nxt); } }
        const char* nA = has_next ? (GATHER ? (const char*)g.A : (const char*)g.A + (size_t)nxt.pm * tstep) : cA; const char* nB = has_next ? (const char*)g.Bt + (size_t)nxt.pb * tstep : cB;
        for (int t = 0; t < nt; t += 2) {
            const bool last = (t == nt - 2);
            const char* a1 = cA + (size_t)(t + 1) * kstep;
            const char* a2 = last ? nA : cA + (size_t)(t + 2) * kstep; const char* b2 = last ? nB : cB + (size_t)(t + 2) * kstep;
            const char* a3 = a2 + kstep; const char* b3 = b2 + kstep;
            unsigned vS[2][2];
#pragma unroll
            for (int h_ = 0; h_ < 2; ++h_)
#pragma unroll
                for (int i_ = 0; i_ < 2; ++i_) vS[h_][i_] = (GATHER && last) ? vN[h_][i_] : vC[h_][i_];
            if (last && has_next) S.a_ready(nxt);
            if constexpr (SP2) {
            PG8_LDB(B0, 0, 0); PG8_LDB(B1, 0, 1); PG8_SCHED; PG8_LDA(At, 0, 0); PG8_STAGE(PG8_SA(1, 1), a1, vC[1]);
            PG8_WAIT_V(8); PG8_WAIT_L(0); PG8_BAR; PG8_MMA(0, 0, At, B0); PG8_MMA(0, 1, At, B1); PG8_BAR; PG8_SCHED;
            PG8_LDA(At, 0, 1); PG8_STAGE(PG8_SB(0, 0), b2, voffB); PG8_STAGE(PG8_SB(0, 1), b2 + hstep, voffB); PG8_STAGE(PG8_SA(0, 0), a2, vS[0]);
            PG8_WAIT_V(8); PG8_WAIT_L(0); PG8_BAR; PG8_MMA(1, 0, At, B0); PG8_MMA(1, 1, At, B1); PG8_BAR; PG8_SCHED;
            PG8_LDB(B0, 1, 0); PG8_LDB(B1, 1, 1); PG8_SCHED; PG8_LDA(At, 1, 0); PG8_STAGE(PG8_SA(0, 1), a2, vS[1]);
            PG8_WAIT_V(8); PG8_WAIT_L(0); PG8_BAR; PG8_MMA(0, 0, At, B0); PG8_MMA(0, 1, At, B1); PG8_BAR; PG8_SCHED;
            PG8_LDA(At, 1, 1); PG8_STAGE(PG8_SB(1, 0), b3, voffB); PG8_STAGE(PG8_SB(1, 1), b3 + hstep, voffB); PG8_STAGE(PG8_SA(1, 0), a3, vS[0]);
            PG8_WAIT_V(8); PG8_WAIT_L(0); PG8_BAR; PG8_MMA(1, 0, At, B0); PG8_MMA(1, 1, At, B1); PG8_BAR; PG8_SCHED;
            } else {
            PG8_LDB(B0, 0, 0); PG8_SCHED; PG8_LDA(At, 0, 0); PG8_STAGE(PG8_SA(1, 1), a1, vC[1]);
            PG8_WAIT_L(8); PG8_BAR; PG8_WAIT_L(0); PG8_MMA(0, 0, At, B0); PG8_BAR; PG8_SCHED;
            PG8_LDB(B1, 0, 1); PG8_STAGE(PG8_SB(0, 0), b2, voffB);
            PG8_BAR; PG8_WAIT_L(0); PG8_MMA(0, 1, At, B1); PG8_BAR;
            PG8_LDA(At, 0, 1); PG8_STAGE(PG8_SA(0, 0), a2, vS[0]);
            PG8_BAR; PG8_WAIT_L(0); PG8_MMA(1, 0, At, B0); PG8_BAR; PG8_SCHED;
            PG8_STAGE(PG8_SB(0, 1), b2 + hstep, voffB);
            PG8_WAIT_V(6); PG8_BAR; PG8_MMA(1, 1, At, B1); PG8_BAR;
            PG8_LDB(B0, 1, 0); PG8_SCHED; PG8_LDA(At, 1, 0); PG8_STAGE(PG8_SA(0, 1), a2, vS[1]);
            PG8_WAIT_L(8); PG8_BAR; PG8_WAIT_L(0); PG8_MMA(0, 0, At, B0); PG8_BAR; PG8_SCHED;
            PG8_LDB(B1, 1, 1); PG8_STAGE(PG8_SB(1, 0), b3, voffB);
            PG8_BAR; PG8_WAIT_L(0); PG8_MMA(0, 1, At, B1); PG8_BAR;
            PG8_LDA(At, 1, 1); PG8_STAGE(PG8_SA(1, 0), a3, vS[0]);
            PG8_BAR; PG8_WAIT_L(0); PG8_MMA(1, 0, At, B0); PG8_BAR; PG8_SCHED;
            PG8_STAGE(PG8_SB(1, 1), b3 + hstep, voffB);
            PG8_WAIT_V(6); PG8_BAR; PG8_MMA(1, 1, At, B1); PG8_BAR;
            }
        }
        if constexpr (FP8) asm volatile("s_nop 15\n\ts_nop 15" ::: "memory");
        if constexpr (ALIGN_EPI) { if (wr == 0) PG8_BAR; }
        if constexpr (!Epi::AFTER_DRAIN) { E(acc, cur, wr, wc, fr, fq); S.done(cur); }
        if (!has_next) break;
#pragma unroll
        for (int a = 0; a < 2; ++a)
#pragma unroll
            for (int b = 0; b < 2; ++b)
#pragma unroll
                for (int m = 0; m < 4; ++m)
#pragma unroll
                    for (int n = 0; n < 2; ++n) acc[a][b][m][n] = (f32x4){0.f, 0.f, 0.f, 0.f};
        cur = nxt; cA = nA; cB = nB; ++ui;
        if constexpr (GATHER) {
#pragma unroll
            for (int h_ = 0; h_ < 2; ++h_)
#pragma unroll
                for (int i_ = 0; i_ < 2; ++i_) vC[h_][i_] = vN[h_][i_]; }
        if constexpr (ALIGN_EPI) { if (wr == 1) PG8_BAR; }
    }
    PG8_WAIT_V(0);
    if constexpr (!ALIGN_EPI) { if (wr == 0) PG8_BAR; }
    PG8_BAR;
    if constexpr (Epi::AFTER_DRAIN) { E.fused(acc, cur, wr, wc, fr, fq, lds, wid, lane); S.done(cur); }
#undef PG8_GROWS
#undef PG8_SA
#undef PG8_SB
#undef PG8_STAGE
#undef PG8_LDA
#undef PG8_LDB
#undef PG8_MMA
#undef PG8_WAIT_V
#undef PG8_WAIT_L
#undef PG8_BAR
#undef PG8_SCHED
}
}

constexpr int NWAVES = 8;
#ifndef MK_N_LAUNCHES
#define MK_N_LAUNCHES 1
#endif
constexpr int N_PHASES = 11;
constexpr int N_LAUNCHES = MK_N_LAUNCHES;

constexpr int NB = 4, SEQ = 4096, DM = 1024, NTOK = NB * SEQ;
constexpr int NPROJ = 4808, NPROJ_PAD = 4864, PROJ_LD = 4608;
constexpr int NEXP = 32, MAXTILES = 288;
constexpr float RMS_EPS = 1e-6f;

constexpr size_t MiB = 1u << 20;
constexpr size_t WS_CTL = 0, CTL_ZERO_BYTES = 1 * MiB;
constexpr size_t WS_WI = 2 * MiB, WS_WPA = 12 * MiB, WS_WPB = 13 * MiB, WS_WO = 14 * MiB, WS_WGU = 16 * MiB, WS_WD = 144 * MiB;
constexpr size_t WS_XN = 208 * MiB, WS_PROJ = 240 * MiB, WS_SMALLF = 384 * MiB, WS_KA = 400 * MiB, WS_VA = 402 * MiB, WS_KI = 404 * MiB, WS_WIQ = 406 * MiB;
constexpr size_t WS_OA = 408 * MiB, WS_OB = 424 * MiB, WS_MERGED = 440 * MiB, WS_SSQP = 472 * MiB;
constexpr size_t WS_TOKE = 473 * MiB, WS_TOKG = WS_TOKE + 256 * 1024, WS_TOKP = WS_TOKG + 256 * 1024, WS_LIST = 474 * MiB;
constexpr size_t WS_WRG = 478 * MiB;
constexpr size_t WS_ROPE = 479 * MiB;
constexpr size_t WS_XG = 480 * MiB, WS_ACT = 624 * MiB, WS_Y = 768 * MiB, WS_END = 912 * MiB;
constexpr int CW_TMO = 0, CW_CODE = 1;
constexpr int CW_BAR = 4096;
constexpr int CW_CNT = 8192;
constexpr int CW_QUEUE = 8448;
constexpr int CW_WDQ = 8576;
constexpr int RING_OFF = 0, RING_BYTES = 131072;
constexpr int IDX_OFF = 131072;
constexpr int HIST_OFF = 139264;
constexpr int LDSCTL_OFF = 155648, MISC_OFF = LDSCTL_OFF + 320;
constexpr int LDS_BYTES = 159744;
constexpr int MI_BAR = 8, MI_TS = 16  , MI_CNT = 64  , MI_Q = 100, MI_STAMP = 104  ;

#define GAS __attribute__((address_space(1)))
#define LAS __attribute__((address_space(3)))
typedef unsigned short bf16;
typedef unsigned v4u __attribute__((ext_vector_type(4)));
typedef float f32x4 __attribute__((ext_vector_type(4)));
typedef short bf16x8 __attribute__((ext_vector_type(8)));
typedef GAS unsigned gu32;
typedef GAS unsigned long long gu64;
#define RLX_AGENT __ATOMIC_RELAXED, __HIP_MEMORY_SCOPE_AGENT
#define LDS_WAIT() asm volatile("s_waitcnt lgkmcnt(0)" ::: "memory")
#define VM_WAIT() asm volatile("s_waitcnt vmcnt(0)" ::: "memory")
__device__ __forceinline__ unsigned long long rt() { return __builtin_amdgcn_s_memrealtime(); }
__device__ __forceinline__ unsigned f2bf(float f) { unsigned u = __builtin_bit_cast(unsigned, f); return (u + 0x7fffu + ((u >> 16) & 1u)) >> 16; }
__device__ __forceinline__ unsigned pk2(float lo, float hi) { return f2bf(lo) | (f2bf(hi) << 16); }

#define XB_TMO      128
#define XB_XCNT(j)  (256  + 64 * (j))
#define XB_XSUB(j)  (1280 + 64 * (j))
#define XB_XGEN(j)  (2304 + 64 * (j))
#define XB_TOP      3328
#define XB_TOPGEN   3392
#define XCD_BAR_WORDS 3456
#define XB_SPIN_CAP (1u << 18)

__device__ __forceinline__ unsigned xb_ld(unsigned* p)              { return __hip_atomic_load(p, __ATOMIC_RELAXED, __HIP_MEMORY_SCOPE_AGENT); }
__device__ __forceinline__ unsigned xb_add(unsigned* p, unsigned v) { return __hip_atomic_fetch_add(p, v, __ATOMIC_RELAXED, __HIP_MEMORY_SCOPE_AGENT); }
__device__ __forceinline__ unsigned xb_xcc_id() { return (unsigned)__builtin_amdgcn_s_getreg((3 << 11) | 20) & 0xFu; }
#define XB_SPIN(cond, bar) do { unsigned _sp = 0; while (cond) { __builtin_amdgcn_s_sleep(1); \
    if ((++_sp & 255u) == 0u) { if (xb_ld(&(bar)[XB_TMO])) break; if (_sp > XB_SPIN_CAP) { atomicAdd(&(bar)[XB_TMO], 1u); break; } } } } while (0)

struct XcdBarrier {
    unsigned* bar; unsigned x;
    volatile LAS unsigned* st;
};

__device__ __forceinline__ XcdBarrier xcd_barrier_post(unsigned* bar, volatile LAS unsigned* st) {
    XcdBarrier b; b.bar = bar; b.x = xb_xcc_id(); b.st = st;
    if (threadIdx.x == 0) (void)xb_add(&bar[XB_XCNT(b.x)], 1u);
    return b;
}
__device__ __forceinline__ void xcd_barrier_complete(unsigned* bar, unsigned x, unsigned& nloc, unsigned& nx) {
    const unsigned G = gridDim.x * gridDim.y * gridDim.z;
    unsigned sum, cnt, mine, sp = 0u;
    for (;;) {
        sum = 0u; cnt = 0u; mine = 0u;
#pragma unroll
        for (unsigned j = 0; j < 16; ++j) { const unsigned c = xb_ld(&bar[XB_XCNT(j)]); sum += c; cnt += (c > 0u) ? 1u : 0u; mine = (j == x) ? c : mine; }
        if (sum == G) break;
        __builtin_amdgcn_s_sleep(1);
        if ((++sp & 255u) == 0u) { if (xb_ld(&bar[XB_TMO])) break; if (sp > XB_SPIN_CAP) { atomicAdd(&bar[XB_TMO], 1u); break; } }
    }
    nloc = mine > 0u ? mine : 1u; nx = cnt > 0u ? cnt : 1u;
}

__device__ __forceinline__ void xcd_barrier(const XcdBarrier& b, const bool lead  ) {
    asm volatile("s_waitcnt vmcnt(0)" ::: "memory");
    __syncthreads();
    if (lead) {
        unsigned* bar = b.bar;
        __builtin_amdgcn_s_waitcnt(0);
        unsigned nloc = b.st[0], nx = b.st[1];
        if (nloc == 0u) { xcd_barrier_complete(bar, b.x, nloc, nx); b.st[0] = nloc; b.st[1] = nx; }
        const unsigned old = xb_add(&bar[XB_XSUB(b.x)], 1u);
        const unsigned gen = old / nloc;
        if (old + 1u == (gen + 1u) * nloc) {
            __builtin_amdgcn_fence(__ATOMIC_RELEASE, "agent");
            asm volatile("s_waitcnt vmcnt(0)" ::: "memory");
            const unsigned og = xb_add(&bar[XB_TOP], 1u);
            const unsigned tg = og / nx;
            if (og + 1u == (tg + 1u) * nx) xb_add(&bar[XB_TOPGEN], 1u);
            else XB_SPIN(xb_ld(&bar[XB_TOPGEN]) == tg, bar);
            __builtin_amdgcn_fence(__ATOMIC_ACQUIRE, "agent");
            xb_add(&bar[XB_XGEN(b.x)], 1u);
            asm volatile("s_waitcnt vmcnt(0)" ::: "memory");
        } else {
            XB_SPIN(xb_ld(&bar[XB_XGEN(b.x)]) == gen, bar);
            __builtin_amdgcn_fence(__ATOMIC_ACQUIRE, "agent");
            asm volatile("s_waitcnt vmcnt(0)" ::: "memory");
        }
    }
    __syncthreads();
}


__device__ __forceinline__ float bf2f(unsigned short b) { return __uint_as_float((unsigned)b << 16); }
__device__ __forceinline__ float bflo(unsigned w) { return __uint_as_float(w << 16); }
__device__ __forceinline__ float bfhi(unsigned w) { return __uint_as_float(w & 0xffff0000u); }

struct Args { const float* in[15]; float* out; unsigned char* ws; int ph_lo, ph_hi, rep, pad; };
struct Frame {
    const Args* a;
    LAS unsigned char* lds;
    volatile LAS unsigned* MISC;
    gu32* ctl;
    int tid, lane, wave;
    int G;
};
#define WSP(T, off) ((T*)((F.a->ws) + (off)))
#define F_WI WSP(bf16, WS_WI)
#define F_WPA WSP(bf16, WS_WPA)
#define F_WPB WSP(bf16, WS_WPB)
#define F_WO WSP(bf16, WS_WO)
#define F_WGU WSP(bf16, WS_WGU)
#define F_WD WSP(bf16, WS_WD)
#define F_XN WSP(bf16, WS_XN)
#define F_PROJ WSP(bf16, WS_PROJ)
#define F_KA WSP(bf16, WS_KA)
#define F_VA WSP(bf16, WS_VA)
#define F_KI WSP(bf16, WS_KI)
#define F_OA WSP(bf16, WS_OA)
#define F_OB WSP(bf16, WS_OB)
#define F_MERGED WSP(bf16, WS_MERGED)
#define F_XG WSP(bf16, WS_XG)
#define F_ACT WSP(bf16, WS_ACT)
#define F_Y WSP(bf16, WS_Y)
#define F_SMALLF WSP(float, WS_SMALLF)
#define F_WIQ WSP(float, WS_WIQ)
#define F_SSQP WSP(float, WS_SSQP)
#define F_TOKG WSP(float, WS_TOKG)
#define F_TOKE WSP(int, WS_TOKE)
#define F_TOKP WSP(int, WS_TOKP)
#define F_LIST WSP(int, WS_LIST)
#define F_WRG WSP(float, WS_WRG)
#define F_ROPE WSP(float, WS_ROPE)

__device__ __forceinline__ int fresh_lane() { unsigned ones_ = ~0u; asm volatile("" : "+v"(ones_)); return (int)__builtin_amdgcn_mbcnt_hi(ones_, __builtin_amdgcn_mbcnt_lo(ones_, 0u)); }
__device__ __forceinline__ float wave_sum(float v) {
#pragma unroll
    for (int o = 1; o < 64; o <<= 1) v += __shfl_xor(v, o);
    return v;
}
__device__ __forceinline__ float wave_max(float v) {
#pragma unroll
    for (int o = 1; o < 64; o <<= 1) v = fmaxf(v, __shfl_xor(v, o));
    return v;
}

__device__ __forceinline__ int wi_rowmap(int n) {
    if (n < 512) return n;
    if (n < 576) return 4608 + (n - 512);
    if (n < 640) return 4672 + (n - 576);
    if (n < 1152) return 512 + (n - 640);
    if (n < 1216) return 4736 + (n - 1152);
    if (n < 1224) return 4800 + (n - 1216);
    if (n < 1736) return 1024 + (n - 1224);
    if (n < 2248) return 1536 + (n - 1736);
    if (n < 2760) return 2048 + (n - 2248);
    if (n < 3784) return 2560 + (n - 2760);
    return 3584 + (n - 3784);
}
template <int MAP> __device__ __forceinline__ void transpose_item(const float* W, int K, int N, bf16* WT, int row_base, LAS float* scr, int item, int lane) {
    const int nblk = (N + 31) / 32, kb = item / nblk, nb = item % nblk, k0 = 64 * kb, n0 = 32 * nb;
    const int nsrc = n0 + (lane & 31); const bool ok = nsrc < N; const int ncl = ok ? nsrc : 0;
#pragma unroll 8
    for (int i = 0; i < 32; ++i) { const int kk = 2 * i + (lane >> 5); const float v = W[(size_t)(k0 + kk) * N + ncl]; scr[kk * 33 + (lane & 31)] = v; }
    LDS_WAIT(); asm volatile("" ::: "memory");
    const int c = lane & 7;
#pragma unroll
    for (int j = 0; j < 4; ++j) { const int nl = (lane >> 3) + 8 * j, n = n0 + nl; const LAS float* s = scr + (8 * c) * 33 + nl;
        if (n < N) { int dr;
            if (MAP == 0) dr = n; else if (MAP == 1) dr = wi_rowmap(n); else { const int jj = n & 1023; dr = 256 * (jj >> 7) + 128 * (n >> 10) + (jj & 127); }
            v4u o; o.x = pk2(s[0 * 33], s[1 * 33]); o.y = pk2(s[2 * 33], s[3 * 33]); o.z = pk2(s[4 * 33], s[5 * 33]); o.w = pk2(s[6 * 33], s[7 * 33]);
            *(GAS v4u*)(WT + (size_t)(row_base + dr) * K + k0 + 8 * c) = o; } }
    LDS_WAIT(); asm volatile("" ::: "memory");
}
template <int MAP> __device__ __forceinline__ void transpose_item_f8(const float* W, int K, int N, unsigned char* WT, int row_base, LAS float* scr, int item, int lane, float scale) {
    const int nblk = (N + 31) / 32, kb = item / nblk, nb = item % nblk, k0 = 64 * kb, n0 = 32 * nb;
    const int nsrc = n0 + (lane & 31); const bool ok = nsrc < N; const int ncl = ok ? nsrc : 0;
#pragma unroll 8
    for (int i = 0; i < 32; ++i) { const int kk = 2 * i + (lane >> 5); const float v = W[(size_t)(k0 + kk) * N + ncl]; scr[kk * 33 + (lane & 31)] = v; }
    LDS_WAIT(); asm volatile("" ::: "memory");
    const int c = lane & 7;
#pragma unroll
    for (int j = 0; j < 4; ++j) { const int nl = (lane >> 3) + 8 * j, n = n0 + nl; const LAS float* s = scr + (8 * c) * 33 + nl;
        if (n < N) { int dr;
            if (MAP == 0) dr = n; else { const int jj = n & 1023; dr = 256 * (jj >> 7) + 128 * (n >> 10) + (jj & 127); }
            int lo = __builtin_amdgcn_cvt_pk_fp8_f32(s[0 * 33] * scale, s[1 * 33] * scale, 0, false); lo = __builtin_amdgcn_cvt_pk_fp8_f32(s[2 * 33] * scale, s[3 * 33] * scale, lo, true);
            int hi = __builtin_amdgcn_cvt_pk_fp8_f32(s[4 * 33] * scale, s[5 * 33] * scale, 0, false); hi = __builtin_amdgcn_cvt_pk_fp8_f32(s[6 * 33] * scale, s[7 * 33] * scale, hi, true);
            typedef int i32x2 __attribute__((ext_vector_type(2)));
            *(GAS i32x2*)(WT + (size_t)(row_base + dr) * K + k0 + 8 * c) = (i32x2){lo, hi}; } }
    LDS_WAIT(); asm volatile("" ::: "memory");
}
template <int MAP> __device__ __forceinline__ void convert_item_f8(const float* W, int K, int N, unsigned char* WT, int row_base, LAS unsigned char* tile, int item, int lane, float scale) {
    const int nblk = N / 64, kb = item / nblk, nb = item % nblk, k0 = 128 * kb, n0 = 64 * nb, ng = lane & 15, ko = lane >> 4;
    const float* src = W + (size_t)(k0 + 8 * ko) * N + n0 + 4 * ng;
    typedef int i32x2 __attribute__((ext_vector_type(2)));
#pragma unroll
    for (int q = 0; q < 4; ++q) {
        f32x4 v[8];
#pragma unroll
        for (int k = 0; k < 8; ++k) v[k] = *(const GAS f32x4*)(src + (size_t)(32 * q + k) * N);
#pragma unroll
        for (int j = 0; j < 4; ++j) {
            int lo = __builtin_amdgcn_cvt_pk_fp8_f32(v[0][j] * scale, v[1][j] * scale, 0, false); lo = __builtin_amdgcn_cvt_pk_fp8_f32(v[2][j] * scale, v[3][j] * scale, lo, true);
            int hi = __builtin_amdgcn_cvt_pk_fp8_f32(v[4][j] * scale, v[5][j] * scale, 0, false); hi = __builtin_amdgcn_cvt_pk_fp8_f32(v[6][j] * scale, v[7][j] * scale, hi, true);
            *(LAS i32x2*)(tile + (4 * ng + j) * 144 + 32 * q + 8 * ko) = (i32x2){lo, hi}; }
    }
    LDS_WAIT(); asm volatile("" ::: "memory");
#pragma unroll
    for (int i = 0; i < 8; ++i) { const int rl = (lane >> 3) + 8 * i, n = n0 + rl; int dr; if (MAP == 0) dr = n; else { const int jj = n & 1023; dr = 256 * (jj >> 7) + 128 * (n >> 10) + (jj & 127); }
        const v4u w = *(const LAS v4u*)(tile + rl * 144 + 16 * (lane & 7));
        *(GAS v4u*)(WT + (size_t)(row_base + dr) * K + k0 + 16 * (lane & 7)) = w; }
    LDS_WAIT(); asm volatile("" ::: "memory");
}
template <int MAP> __device__ __forceinline__ void convert_stream_f8(const float* Wall, int N, int items_per_e, unsigned char* WT, LAS unsigned char* tile, int first, int stride, int end, int lane, float scale) {
    if (first >= end) return;
    const int ng = lane & 15, ko = lane >> 4, nblk = N / 64;
    typedef int i32x2 __attribute__((ext_vector_type(2)));
    f32x4 v[4][8];
    { const int e = first / items_per_e, item = first % items_per_e, kb = item / nblk, nb = item % nblk;
      const float* src = Wall + (size_t)e * 1024 * N + (size_t)(128 * kb + 8 * ko) * N + 64 * nb + 4 * ng;
#pragma unroll
      for (int q = 0; q < 4; ++q)
#pragma unroll
          for (int k = 0; k < 8; ++k) v[q][k] = __builtin_nontemporal_load((const GAS f32x4*)(src + (size_t)(32 * q + k) * N)); }
#pragma unroll 1
    for (int r = first; r < end; r += stride) {
        const int rn = r + stride; const bool hn = rn < end; const int rr = hn ? rn : r;
        const int en = rr / items_per_e, itn = rr % items_per_e;
        const float* nsrc = Wall + (size_t)en * 1024 * N + (size_t)(128 * (itn / nblk) + 8 * ko) * N + 64 * (itn % nblk) + 4 * ng;
#pragma unroll
        for (int q = 0; q < 4; ++q) {
#pragma unroll
            for (int j = 0; j < 4; ++j) {
                int lo = __builtin_amdgcn_cvt_pk_fp8_f32(v[q][0][j] * scale, v[q][1][j] * scale, 0, false); lo = __builtin_amdgcn_cvt_pk_fp8_f32(v[q][2][j] * scale, v[q][3][j] * scale, lo, true);
                int hi = __builtin_amdgcn_cvt_pk_fp8_f32(v[q][4][j] * scale, v[q][5][j] * scale, 0, false); hi = __builtin_amdgcn_cvt_pk_fp8_f32(v[q][6][j] * scale, v[q][7][j] * scale, hi, true);
                *(LAS i32x2*)(tile + (4 * ng + j) * 144 + 32 * q + 8 * ko) = (i32x2){lo, hi}; }
            if (hn) {
#pragma unroll
                for (int k = 0; k < 8; ++k) v[q][k] = __builtin_nontemporal_load((const GAS f32x4*)(nsrc + (size_t)(32 * q + k) * N)); }
        }
        LDS_WAIT(); asm volatile("" ::: "memory");
        const int e = r / items_per_e, item = r % items_per_e, k0 = 128 * (item / nblk), n0 = 64 * (item % nblk);
#pragma unroll
        for (int i = 0; i < 8; ++i) { const int rl = (lane >> 3) + 8 * i, n = n0 + rl; int dr; if (MAP == 0) dr = n; else { const int jj = n & 1023; dr = 256 * (jj >> 7) + 128 * (n >> 10) + (jj & 127); }
            const v4u w = *(const LAS v4u*)(tile + rl * 144 + 16 * (lane & 7));
            *(GAS v4u*)(WT + (size_t)(e * N + dr) * 1024 + k0 + 16 * (lane & 7)) = w; }
        LDS_WAIT(); asm volatile("" ::: "memory");
    }
}
constexpr int I_GU = 8 * 32, I_D = 8 * 16, NMOE_ITEMS = NEXP * (I_GU + I_D);
#ifndef MOE_P1_ITEMS
#define MOE_P1_ITEMS (NEXP * I_GU)
#endif
__device__ __forceinline__ void moe_item(Frame& F, int r, LAS float* scr) {
    if (r < NEXP * I_GU) { const int e = r / I_GU; convert_item_f8<2>((F.a->in[11]) + (size_t)e * 1024 * 2048, 1024, 2048, (unsigned char*)F_WGU, e * 2048, (LAS unsigned char*)scr, r % I_GU, F.lane, 32.0f); return; }
    r -= NEXP * I_GU;
    { const int e = r / I_D; convert_item_f8<0>((F.a->in[13]) + (size_t)e * 1024 * 1024, 1024, 1024, (unsigned char*)F_WD, e * 1024, (LAS unsigned char*)scr, r % I_D, F.lane, 32.0f); }
}
__device__ __forceinline__ void p1_convert(Frame& F, int cc, int NC, int moe_hi) {
    LAS unsigned char* scr = (LAS unsigned char*)(F.lds + RING_OFF + F.wave * 16384);
    const int w = cc * NWAVES + F.wave, nw = NC * NWAVES;
    const int hi_gu = moe_hi < NEXP * I_GU ? moe_hi : NEXP * I_GU, hi_d = moe_hi - NEXP * I_GU;
    convert_stream_f8<2>((F.a->in[11]), 2048, I_GU, (unsigned char*)F_WGU, scr, w, nw, hi_gu, F.lane, 32.0f);
    convert_stream_f8<0>((F.a->in[13]), 1024, I_D, (unsigned char*)F_WD, scr, w, nw, hi_d, F.lane, 32.0f);
}
__device__ __forceinline__ void p8_convert_wd(Frame& F, int rep) {
    LAS float* scr = (LAS float*)(F.lds + RING_OFF + F.wave * 16384);
    gu32* q = F.ctl + CW_WDQ + 64 * rep;
    unsigned nxt = 0u; if (F.lane == 0) nxt = __hip_atomic_fetch_add(q, 1u, RLX_AGENT);
    nxt = (unsigned)__builtin_amdgcn_readfirstlane((int)nxt);
    while (nxt < (unsigned)(NEXP * I_D)) {
        const int cur = (int)nxt;
        unsigned t = 0u; if (F.lane == 0) t = __hip_atomic_fetch_add(q, 1u, RLX_AGENT);
        moe_item(F, NEXP * I_GU + cur, scr);
        nxt = (unsigned)__builtin_amdgcn_readfirstlane((int)t);
    }
}
__device__ __forceinline__ void p0_prologue(Frame& F, int moe_lo) {
    LAS float* scr = (LAS float*)(F.lds + RING_OFF + F.wave * 16384);
    const int gw = blockIdx.x * NWAVES + F.wave, NGW = F.G * NWAVES;
    constexpr int I_WI = 16 * 151, I_PA = 8 * 32, I_WO = 16 * 32;
    constexpr int NITEMS = I_WI + 2 * I_PA + I_WO + NMOE_ITEMS;
    for (int it = moe_lo + gw; it < NITEMS; it += NGW) {
        int r = it;
        if (r < NMOE_ITEMS) { if (r < NEXP * I_GU) moe_item(F, r, scr); continue; } r -= NMOE_ITEMS;
        if (r < I_WI) { transpose_item<1>((F.a->in[2]), 1024, NPROJ, F_WI, 0, scr, r, F.lane); continue; } r -= I_WI;
        if (r < I_PA) { transpose_item<0>((F.a->in[5]), 512, 1024, F_WPA, 0, scr, r, F.lane); continue; } r -= I_PA;
        if (r < I_PA) { transpose_item<0>((F.a->in[6]), 512, 1024, F_WPB, 0, scr, r, F.lane); continue; } r -= I_PA;
        transpose_item<0>((F.a->in[7]), 1024, 1024, F_WO, 0, scr, r, F.lane);
    }
    { const int gt = blockIdx.x * (NWAVES * 64) + F.tid; if (gt < 7168) { v4u z = {0u, 0u, 0u, 0u}; *((GAS v4u*)(F_WI + (size_t)NPROJ * 1024) + gt) = z; } }
    { const int gt = blockIdx.x * (NWAVES * 64) + F.tid; if (gt < 1024 * 32) F_WRG[gt] = (F.a->in[8])[gt >> 5] * (F.a->in[9])[gt]; }
    { const int gt = blockIdx.x * (NWAVES * 64) + F.tid; if (gt < SEQ * 8) { const int i = gt & 7; const float inv = exp2f(-(float)i * 0.125f * 18.931568569324174f); float sn, cs; sincosf((float)(gt >> 3) * inv, &sn, &cs); F_ROPE[2 * gt] = cs; F_ROPE[2 * gt + 1] = sn; } }
    for (int m = gw; m < NTOK; m += NGW) {
        const GAS f32x4* xr = (const GAS f32x4*)((F.a->in[0]) + (size_t)m * DM) + F.lane; const GAS f32x4* gr = (const GAS f32x4*)(F.a->in[1]) + F.lane;
        f32x4 v[4]; float s = 0.f;
#pragma unroll
        for (int j = 0; j < 4; ++j) { v[j] = xr[64 * j]; s += (v[j].x * v[j].x + v[j].y * v[j].y) + (v[j].z * v[j].z + v[j].w * v[j].w); }
        const float rr = 1.0f / sqrtf(wave_sum(s) * (1.f / DM) + RMS_EPS);
        GAS unsigned long long* o8 = (GAS unsigned long long*)(F_XN + (size_t)m * DM) + F.lane;
#pragma unroll
        for (int j = 0; j < 4; ++j) { const f32x4 g = gr[64 * j]; o8[64 * j] = (unsigned long long)pk2(v[j].x * rr * g.x, v[j].y * rr * g.y) | ((unsigned long long)pk2(v[j].z * rr * g.z, v[j].w * rr * g.w) << 32); }
    }
}

__device__ __forceinline__ void rope16(float (&v)[16], const float* tab  ) {
#pragma unroll
    for (int i = 0; i < 8; ++i) { const float cs = tab[2 * i], sn = tab[2 * i + 1]; const float a = v[i], b2 = v[i + 8]; v[i] = a * cs - b2 * sn; v[i + 8] = b2 * cs + a * sn; }
}
__device__ __forceinline__ void p2_prep(Frame& F, int rep) {
    const size_t shift = rep ? (size_t)(WS_Y - WS_PROJ) / 2 : 0;
    const int gt = blockIdx.x * (NWAVES * 64) + F.tid, NGT = F.G * NWAVES * 64;
    for (int w = gt; w < NTOK * 8; w += NGT) {
        const int tk = w >> 3, h = w & 7; bf16* p = F_PROJ + (size_t)tk * PROJ_LD + h * 64; const float* g = (F.a->in[3]);
        v4u u[8]; float ss = 0.f;
#pragma unroll
        for (int c = 0; c < 8; ++c) { u[c] = *((const GAS v4u*)p + c); const float a0 = bflo(u[c].x), a1 = bfhi(u[c].x), a2 = bflo(u[c].y), a3 = bfhi(u[c].y), a4 = bflo(u[c].z), a5 = bfhi(u[c].z), a6 = bflo(u[c].w), a7 = bfhi(u[c].w);
            ss += (a0 * a0 + a1 * a1) + (a2 * a2 + a3 * a3) + (a4 * a4 + a5 * a5) + (a6 * a6 + a7 * a7); }
        const float rr = 1.0f / sqrtf(ss * (1.f / 64.f) + RMS_EPS);
        float r16[16];
#pragma unroll
        for (int c = 0; c < 2; ++c) { r16[8 * c] = bflo(u[c].x) * rr * g[8 * c]; r16[8 * c + 1] = bfhi(u[c].x) * rr * g[8 * c + 1]; r16[8 * c + 2] = bflo(u[c].y) * rr * g[8 * c + 2]; r16[8 * c + 3] = bfhi(u[c].y) * rr * g[8 * c + 3];
            r16[8 * c + 4] = bflo(u[c].z) * rr * g[8 * c + 4]; r16[8 * c + 5] = bfhi(u[c].z) * rr * g[8 * c + 5]; r16[8 * c + 6] = bflo(u[c].w) * rr * g[8 * c + 6]; r16[8 * c + 7] = bfhi(u[c].w) * rr * g[8 * c + 7]; }
        rope16(r16, F_ROPE + (size_t)(tk & (SEQ - 1)) * 16);
        const float sc = 0.125f;
#pragma unroll
        for (int c = 0; c < 8; ++c) { v4u o;
            if (c < 2) { o.x = pk2(r16[8 * c] * sc, r16[8 * c + 1] * sc); o.y = pk2(r16[8 * c + 2] * sc, r16[8 * c + 3] * sc); o.z = pk2(r16[8 * c + 4] * sc, r16[8 * c + 5] * sc); o.w = pk2(r16[8 * c + 6] * sc, r16[8 * c + 7] * sc); }
            else { const float q = rr * sc; o.x = pk2(bflo(u[c].x) * q * g[8 * c], bfhi(u[c].x) * q * g[8 * c + 1]); o.y = pk2(bflo(u[c].y) * q * g[8 * c + 2], bfhi(u[c].y) * q * g[8 * c + 3]);
                o.z = pk2(bflo(u[c].z) * q * g[8 * c + 4], bfhi(u[c].z) * q * g[8 * c + 5]); o.w = pk2(bflo(u[c].w) * q * g[8 * c + 6], bfhi(u[c].w) * q * g[8 * c + 7]); }
            *((GAS v4u*)(p + shift) + c) = o; }
    }
    for (int w = gt; w < NTOK * 4; w += NGT) {
        const int tk = w >> 2, j = w & 3;
        if (j == 3) {
#pragma unroll
            for (int h = 0; h < 8; ++h) (F_WIQ + (rep ? (size_t)(WS_ACT - WS_WIQ) / 4 + 4 * MiB : 0))[(size_t)tk * 8 + h] = F_SMALLF[(size_t)tk * 256 + 192 + h] * 0.044194173824159216f;
            continue;
        }
        const float* p = F_SMALLF + (size_t)tk * 256 + (j == 0 ? 0 : (j == 1 ? 128 : 64));
        bf16* dst = (j == 0 ? F_KA : (j == 1 ? F_KI : F_VA)) + (size_t)tk * 64 + (rep ? (size_t)(WS_ACT - WS_KA) / 2 : 0);
        float v[64];
#pragma unroll
        for (int c = 0; c < 16; ++c) { const f32x4 u = *((const GAS f32x4*)p + c); v[4 * c] = u.x; v[4 * c + 1] = u.y; v[4 * c + 2] = u.z; v[4 * c + 3] = u.w; }
        if (j == 0) { const float* g = (F.a->in[4]); float ss = 0.f;
#pragma unroll
            for (int d = 0; d < 64; ++d) ss += v[d] * v[d];
            const float rr = 1.0f / sqrtf(ss * (1.f / 64.f) + RMS_EPS);
#pragma unroll
            for (int d = 0; d < 64; ++d) v[d] = v[d] * rr * g[d]; }
        if (j < 2) { float r16[16];
#pragma unroll
            for (int d = 0; d < 16; ++d) r16[d] = v[d];
            rope16(r16, F_ROPE + (size_t)(tk & (SEQ - 1)) * 16);
#pragma unroll
            for (int d = 0; d < 16; ++d) v[d] = r16[d]; }
#pragma unroll
        for (int c = 0; c < 8; ++c) { v4u o; o.x = pk2(v[8 * c], v[8 * c + 1]); o.y = pk2(v[8 * c + 2], v[8 * c + 3]); o.z = pk2(v[8 * c + 4], v[8 * c + 5]); o.w = pk2(v[8 * c + 6], v[8 * c + 7]); *((GAS v4u*)dst + c) = o; }
    }
}

typedef float f32x16 __attribute__((ext_vector_type(16)));
__device__ __forceinline__ void sb_item(Frame& F, int item) {
    const int bh = item >> 3, tb = item & 7, b = bh >> 3, h = bh & 7, t = tb * 512 + F.tid;
    const bf16* base = F_PROJ + (size_t)(b * SEQ) * PROJ_LD + h * 64;
    float o[64]; v4u qw[8];
    { const GAS v4u* qp = (const GAS v4u*)(base + (size_t)t * PROJ_LD + 1024);
#pragma unroll
      for (int c = 0; c < 8; ++c) qw[c] = qp[c]; }
#pragma unroll
    for (int d = 0; d < 64; ++d) o[d] = 0.f;
    float R = 0.f; int s = t - 1;
    for (;;) {
        const bool active = (s >= 0) && (R <= 104.0f);
        if (!__any(active)) break;
        if (active) {
            const GAS v4u* kp = (const GAS v4u*)(base + (size_t)s * PROJ_LD + 1536);
            const GAS v4u* vp = (const GAS v4u*)(base + (size_t)s * PROJ_LD + 2048);
            float z = 0.f;
#pragma unroll
            for (int c = 0; c < 8; ++c) { const v4u u = kp[c];
                const v4u qq = qw[c]; z += bflo(qq.x) * bflo(u.x) + bfhi(qq.x) * bfhi(u.x) + bflo(qq.y) * bflo(u.y) + bfhi(qq.y) * bfhi(u.y) + bflo(qq.z) * bflo(u.z) + bfhi(qq.z) * bfhi(u.z) + bflo(qq.w) * bflo(u.w) + bfhi(qq.w) * bfhi(u.w); }
            const float sp = fmaxf(z, 0.f) + log1pf(__expf(-fabsf(z)));
            R += sp;
            const float a = __expf(z - R);
#pragma unroll
            for (int c = 0; c < 8; ++c) { const v4u u = vp[c];
                o[8 * c] += a * bflo(u.x); o[8 * c + 1] += a * bfhi(u.x); o[8 * c + 2] += a * bflo(u.y); o[8 * c + 3] += a * bfhi(u.y); o[8 * c + 4] += a * bflo(u.z); o[8 * c + 5] += a * bfhi(u.z); o[8 * c + 6] += a * bflo(u.w); o[8 * c + 7] += a * bfhi(u.w); }
        }
        --s;
    }
    GAS v4u* op = (GAS v4u*)(F_OB + (size_t)(b * SEQ + t) * 512 + h * 64);
#pragma unroll
    for (int c = 0; c < 8; ++c) { v4u w; w.x = pk2(o[8 * c], o[8 * c + 1]); w.y = pk2(o[8 * c + 2], o[8 * c + 3]); w.z = pk2(o[8 * c + 4], o[8 * c + 5]); w.w = pk2(o[8 * c + 6], o[8 * c + 7]); op[c] = w; }
}

typedef float f32x2_t __attribute__((ext_vector_type(2))); typedef __bf16 bf16x2_t __attribute__((ext_vector_type(2)));
__device__ __forceinline__ float relu_i(float x) { const int i = __builtin_bit_cast(int, x); return __builtin_bit_cast(float, i > 0 ? i : 0); }
typedef short v4i16_t __attribute__((ext_vector_type(4)));
__device__ __forceinline__ unsigned cvtpk_s(float lo, float hi) { f32x2_t v = {lo, hi}; bf16x2_t b = __builtin_convertvector(v, bf16x2_t); return __builtin_bit_cast(unsigned, b); }
__device__ __forceinline__ v4i16_t vtr(LAS unsigned char* p) { return __builtin_amdgcn_ds_read_tr16_b64_v4i16((LAS v4i16_t*)p); }
__device__ __forceinline__ void sb_item_mfma(Frame& F, int item) {
    const int lane = F.lane, wave = F.wave, r32 = lane & 31, hb = lane >> 5;
    const int bh = item >> 4, qb = item & 15, b = bh >> 3, h = bh & 7, qt = qb * 8 + wave, t0 = qt * 32;
    const bf16* base = F_PROJ + (size_t)(b * SEQ) * PROJ_LD + h * 64;
    LAS unsigned char* vl = F.lds + RING_OFF + wave * 16384;
    bf16x8 qf[4];
#pragma unroll
    for (int ks = 0; ks < 4; ++ks) qf[ks] = *(const GAS bf16x8*)(base + (size_t)(t0 + r32) * PROJ_LD + 1024 + 16 * ks + 8 * hb);
    f32x16 o0, o1;
#pragma unroll
    for (int i = 0; i < 16; ++i) { o0[i] = 0.f; o1[i] = 0.f; }
    float R = 0.f;
    const int tg = (lane >> 4) & 1, tq = (lane & 15) >> 2, tp = lane & 3;
    LAS unsigned char* trb = vl + (4 * hb + tq) * 192 + (16 * tg + 4 * tp) * 2;
    for (int kt = qt; kt >= 0; --kt) {
        const bf16* kp = base + (size_t)(32 * kt + r32) * PROJ_LD + 1536 + 8 * hb;
        bf16x8 kf[4];
#pragma unroll
        for (int ks = 0; ks < 4; ++ks) kf[ks] = *(const GAS bf16x8*)(kp + 16 * ks);
        v4u vv[4];
#pragma unroll
        for (int i = 0; i < 4; ++i) vv[i] = *(const GAS v4u*)(base + (size_t)(32 * kt + (lane >> 3) + 8 * i) * PROJ_LD + 2048 + 8 * (lane & 7));
        f32x16 c;
#pragma unroll
        for (int i = 0; i < 16; ++i) c[i] = 0.f;
#pragma unroll
        for (int ks = 0; ks < 4; ++ks) c = __builtin_amdgcn_mfma_f32_32x32x16_bf16(kf[ks], qf[ks], c, 0, 0, 0);
#pragma unroll
        for (int i = 0; i < 4; ++i) *(LAS v4u*)(vl + ((lane >> 3) + 8 * i) * 192 + 16 * (lane & 7)) = vv[i];
        const bool diag = (kt == qt);
        float sp[16];
#pragma unroll
        for (int i = 0; i < 16; ++i) { const int kk = (i & 3) + 8 * (i >> 2) + 4 * hb; const bool msk = diag && (kk >= r32); const float z = c[i];
            const float v = fmaxf(z, 0.f) + 0.6931471805599453f * __builtin_amdgcn_logf(1.0f + __builtin_amdgcn_exp2f(-fabsf(z) * 1.4426950408889634f));
            sp[i] = msk ? 0.f : v; }
        float gs[4], pg[4];
#pragma unroll
        for (int k4 = 0; k4 < 4; ++k4) { gs[k4] = (sp[4 * k4] + sp[4 * k4 + 1]) + (sp[4 * k4 + 2] + sp[4 * k4 + 3]); pg[k4] = __shfl_xor(gs[k4], 32); }
        float off[4];
        { const float so2 = gs[3], so1 = so2 + gs[2], so0 = so1 + gs[1]; const float po2 = pg[3], po1 = po2 + pg[2], po0 = po1 + pg[1];
          off[3] = 0.f; off[2] = so2 + po2; off[1] = so1 + po1; off[0] = so0 + po0;
          if (hb == 0) { off[3] += pg[3]; off[2] += pg[2]; off[1] += pg[1]; off[0] += pg[0]; }
          const float total = (so0 + gs[0]) + (po0 + pg[0]);
#pragma unroll
          for (int k4 = 0; k4 < 4; ++k4) { float run = R + off[k4];
#pragma unroll
              for (int w = 3; w >= 0; --w) { const int i = 4 * k4 + w; const int kk = w + 8 * k4 + 4 * hb; const bool msk = diag && (kk >= r32);
                  run += sp[i]; const float a = __builtin_amdgcn_exp2f((c[i] - run) * 1.4426950408889634f); c[i] = msk ? 0.f : a; } }
          R += total; }
        bf16x8 pa[2];
#pragma unroll
        for (int s2 = 0; s2 < 2; ++s2) { v4u w4; w4.x = cvtpk_s(c[8 * s2], c[8 * s2 + 1]); w4.y = cvtpk_s(c[8 * s2 + 2], c[8 * s2 + 3]); w4.z = cvtpk_s(c[8 * s2 + 4], c[8 * s2 + 5]); w4.w = cvtpk_s(c[8 * s2 + 6], c[8 * s2 + 7]); pa[s2] = __builtin_bit_cast(bf16x8, w4); }
        LDS_WAIT(); asm volatile("" ::: "memory");
#pragma unroll
        for (int s2 = 0; s2 < 2; ++s2) {
#pragma unroll
            for (int db = 0; db < 2; ++db) {
                const v4i16_t lo = vtr(trb + (16 * s2) * 192 + db * 64), hi2 = vtr(trb + (16 * s2 + 8) * 192 + db * 64);
                const bf16x8 vf = (bf16x8){lo[0], lo[1], lo[2], lo[3], hi2[0], hi2[1], hi2[2], hi2[3]};
                if (db == 0) o0 = __builtin_amdgcn_mfma_f32_32x32x16_bf16(pa[s2], vf, o0, 0, 0, 0); else o1 = __builtin_amdgcn_mfma_f32_32x32x16_bf16(pa[s2], vf, o1, 0, 0, 0);
            } }
        LDS_WAIT(); asm volatile("" ::: "memory");
        if (__all(R > 104.0f)) break;
    }
    bf16* op = F_OB + (size_t)(b * SEQ + t0) * 512 + h * 64 + r32;
#pragma unroll
    for (int i = 0; i < 16; ++i) { const int qr = (i & 3) + 8 * (i >> 2) + 4 * hb; op[(size_t)qr * 512] = (bf16)f2bf(o0[i]); op[(size_t)qr * 512 + 32] = (bf16)f2bf(o1[i]); }
}

template <int NV> __device__ __forceinline__ bool select256_hist(const LAS unsigned* rowu, LAS int* idxl, LAS unsigned* hist  , int L, int lane) {
    unsigned kv[NV]; unsigned kmin = 0xffffffffu, kmax = 0u;
    const LAS unsigned* rp = rowu + lane; asm volatile("" : "+v"(rp));
#pragma unroll
    for (int j = 0; j < NV; ++j) { unsigned u = 0u;
        if (64 * j < L) { u = rp[64 * j]; u = (u & 0x80000000u) ? ~u : (u | 0x80000000u); kmin = u < kmin ? u : kmin; kmax = u > kmax ? u : kmax; }
        kv[j] = u; }
#pragma unroll
    for (int o = 1; o < 64; o <<= 1) { const unsigned a = (unsigned)__shfl_xor((int)kmin, o), c2 = (unsigned)__shfl_xor((int)kmax, o); kmin = a < kmin ? a : kmin; kmax = c2 > kmax ? c2 : kmax; }
    const float fmin = __uint_as_float((kmin & 0x80000000u) ? (kmin ^ 0x80000000u) : ~kmin), fmax = __uint_as_float((kmax & 0x80000000u) ? (kmax ^ 0x80000000u) : ~kmax);
    const float rng = fmax - fmin, scale = rng > 0.f ? 1023.5f / rng : 0.f;
#define SEL_BIN(kk) ({ const unsigned k_ = (kk); const float f_ = __uint_as_float((k_ & 0x80000000u) ? (k_ ^ 0x80000000u) : ~k_); int b_ = (int)((f_ - fmin) * scale); b_ = b_ > 1023 ? 1023 : b_; b_; })
#pragma unroll
    for (int i = 0; i < 2; ++i) *(LAS v4u*)(hist + 4 * (lane + 64 * i)) = (v4u){0u, 0u, 0u, 0u};
    LDS_WAIT(); asm volatile("" ::: "memory");
#pragma unroll
    for (int j = 0; j < NV; ++j) if (64 * j < L) { const int b = SEL_BIN(kv[j]); __hip_atomic_fetch_add(hist + (b >> 1), 1u << (16 * (b & 1)), __ATOMIC_RELAXED, __HIP_MEMORY_SCOPE_WORKGROUP); }
    LDS_WAIT(); asm volatile("" ::: "memory");
    int hb[16];
    { const v4u w0 = *(const LAS v4u*)(hist + 8 * lane), w1 = *(const LAS v4u*)(hist + 8 * lane + 4);
      hb[0] = w0.x & 0xffff; hb[1] = w0.x >> 16; hb[2] = w0.y & 0xffff; hb[3] = w0.y >> 16; hb[4] = w0.z & 0xffff; hb[5] = w0.z >> 16; hb[6] = w0.w & 0xffff; hb[7] = w0.w >> 16;
      hb[8] = w1.x & 0xffff; hb[9] = w1.x >> 16; hb[10] = w1.y & 0xffff; hb[11] = w1.y >> 16; hb[12] = w1.z & 0xffff; hb[13] = w1.z >> 16; hb[14] = w1.w & 0xffff; hb[15] = w1.w >> 16; }
    int S = 0;
#pragma unroll
    for (int i = 0; i < 16; ++i) S += hb[i];
    int incl = S;
#pragma unroll
    for (int o = 1; o < 64; o <<= 1) { const int v = __shfl_down(incl, o); if (lane + o < 64) incl += v; }
    const int T = incl - S;
    int bstar = -1, cA = 0, nb = 0;
    { int run = T; bool found = false;
#pragma unroll
      for (int i = 15; i >= 0; --i) { const bool here = !found && (T < 256) && (T + S >= 256) && (run + hb[i] >= 256); if (here) { bstar = 16 * lane + i; cA = run; nb = hb[i]; found = true; } run += hb[i]; } }
    { const unsigned long long mown = __ballot(bstar >= 0); const int src = (int)__ffsll((long long)mown) - 1; bstar = __shfl(bstar, src); cA = __shfl(cA, src); nb = __shfl(nb, src); }
    if (nb > 512) return false;
    const int need = 256 - cA;
    LDS_WAIT(); asm volatile("" ::: "memory");
    LAS int* cand = (LAS int*)hist;
    int base = 0, cbase = 0;
#pragma unroll
    for (int j = 0; j < NV; ++j) {
        const int b = (64 * j < L) ? SEL_BIN(kv[j]) : -1;
        const bool gt = b > bstar, eq = b == bstar;
        const unsigned long long mg = __ballot(gt), me = __ballot(eq);
        const int pg = base + (int)__builtin_amdgcn_mbcnt_hi((unsigned)(mg >> 32), __builtin_amdgcn_mbcnt_lo((unsigned)mg, 0u));
        const int pe = cbase + (int)__builtin_amdgcn_mbcnt_hi((unsigned)(me >> 32), __builtin_amdgcn_mbcnt_lo((unsigned)me, 0u));
        if (gt && pg < 256) idxl[pg] = 64 * j + lane;
        if (eq && pe < 512) cand[pe] = 64 * j + lane;
        base += __popcll(mg); cbase += __popcll(me);
    }
#undef SEL_BIN
    LDS_WAIT(); asm volatile("" ::: "memory");
    for (int i = lane; i < nb; i += 64) {
        const int ci = cand[i]; unsigned ki = rowu[ci]; ki = (ki & 0x80000000u) ? ~ki : (ki | 0x80000000u);
        int rank = 0;
        for (int j = 0; j < nb; ++j) { const int cj = cand[j]; unsigned kj = rowu[cj]; kj = (kj & 0x80000000u) ? ~kj : (kj | 0x80000000u); rank += (kj > ki || (kj == ki && cj < ci)) ? 1 : 0; }
        if (rank < need) idxl[cA + rank] = ci;
    }
    return true;
}
template <int NV> __device__ __forceinline__ void select256(const LAS unsigned* rowu, LAS int* idxl, int L, int lane) {
    unsigned kv[NV]; unsigned kmin = 0xffffffffu, kmax = 0u;
    const LAS unsigned* rp = rowu + lane; asm volatile("" : "+v"(rp));
#pragma unroll
    for (int j = 0; j < NV; ++j) { unsigned u = 0u;
        if (64 * j < L) { u = rp[64 * j]; u = (u & 0x80000000u) ? ~u : (u | 0x80000000u); kmin = u < kmin ? u : kmin; kmax = u > kmax ? u : kmax; }
        kv[j] = u; }
#pragma unroll
    for (int o = 1; o < 64; o <<= 1) { const unsigned a = (unsigned)__shfl_xor((int)kmin, o), c2 = (unsigned)__shfl_xor((int)kmax, o); kmin = a < kmin ? a : kmin; kmax = c2 > kmax ? c2 : kmax; }
    unsigned lo = kmin, hi = kmax + 1u; int chi = 0;
    while (hi - lo > 1u) {
        const unsigned mid = lo + ((hi - lo) >> 1);
        int c = 0;
#pragma unroll
        for (int j = 0; j < NV; j += 8) {
            unsigned long long mk[8];
#pragma unroll
            for (int q = 0; q < 8; ++q) mk[q] = __ballot(kv[j + q] >= mid);
            asm volatile("" : "+s"(mk[0]), "+s"(mk[1]), "+s"(mk[2]), "+s"(mk[3]), "+s"(mk[4]), "+s"(mk[5]), "+s"(mk[6]), "+s"(mk[7]));
#pragma unroll
            for (int q = 0; q < 8; ++q) c += __popcll(mk[q]);
        }
        if (c >= 256) { lo = mid; if (c == 256) { hi = mid; chi = 256; break; } } else { hi = mid; chi = c; }
    }
    const int need = 256 - chi; int base = 0, tdone = 0;
#pragma unroll
    for (int j = 0; j < NV; ++j) {
        const unsigned u = kv[j];
        const bool gt = u >= hi, eq = (u == lo) && !gt;
        const unsigned long long meq = __ballot(eq);
        const int eqrank = tdone + (int)__builtin_amdgcn_mbcnt_hi((unsigned)(meq >> 32), __builtin_amdgcn_mbcnt_lo((unsigned)meq, 0u));
        const bool sel = gt || (eq && eqrank < need);
        const unsigned long long msel = __ballot(sel);
        const int pos = base + (int)__builtin_amdgcn_mbcnt_hi((unsigned)(msel >> 32), __builtin_amdgcn_mbcnt_lo((unsigned)msel, 0u));
        if (sel && pos < 256) idxl[pos] = 64 * j + lane;
        base += __popcll(msel); tdone += __popcll(meq);
    }
}
#ifndef P3_MODE
#define P3_MODE 0
#endif
__device__ __forceinline__ void dsa_item(Frame& F, int b, int t0, int stop) {
    const int lane = F.lane, wave = F.wave;
    const int L = ((t0 >> 6) + 1) << 6;
    LAS float* sc = (LAS float*)(F.lds + RING_OFF);
    if (L > 256) {
        const int r = lane & 31, hb = lane >> 5;
        const int head = (r & 3) + 4 * ((r >> 3) & 1), qsub = ((r >> 2) & 1) + 2 * ((r >> 4) & 1);
        bf16x8 qa[2][4]; float wq[2][2][8];
#pragma unroll
        for (int j = 0; j < 2; ++j) {
            const bf16* qp = F_PROJ + (size_t)(b * SEQ + t0 + 4 * j + qsub) * PROJ_LD + 512 + head * 64 + 8 * hb;
#pragma unroll
            for (int ks = 0; ks < 4; ++ks) qa[j][ks] = *(const GAS bf16x8*)(qp + 16 * ks);
#pragma unroll
            for (int x2 = 0; x2 < 2; ++x2)
#pragma unroll
                for (int hh = 0; hh < 8; ++hh) wq[j][x2][hh] = F_WIQ[(size_t)(b * SEQ + t0 + 4 * j + hb + 2 * x2) * 8 + hh];
        }
        const int ntile = L >> 5;
        const bf16* kbase = F_KI + (size_t)(b * SEQ + r) * 64 + 8 * hb;
#define IDX_LOAD(dst, kt_) do { const bf16* kp_ = kbase + (size_t)(32 * (kt_)) * 64; _Pragma("unroll") for (int ks = 0; ks < 4; ++ks) dst[ks] = *(const GAS bf16x8*)(kp_ + 16 * ks); } while (0)
#define IDX_TILE(src, kt_) do { _Pragma("unroll") for (int j = 0; j < 2; ++j) { f32x16 c; _Pragma("unroll") for (int i = 0; i < 16; ++i) c[i] = 0.f; \
            _Pragma("unroll") for (int ks = 0; ks < 4; ++ks) c = __builtin_amdgcn_mfma_f32_32x32x16_bf16(qa[j][ks], src[ks], c, 0, 0, 0); \
            float s0 = 0.f, s1 = 0.f; _Pragma("unroll") for (int i = 0; i < 8; ++i) { s0 += wq[j][0][i] * fmaxf(c[i], 0.f); s1 += wq[j][1][i] * fmaxf(c[8 + i], 0.f); } \
            sc[(4 * j + hb) * 4096 + 32 * (kt_) + r] = s0; sc[(4 * j + hb + 2) * 4096 + 32 * (kt_) + r] = s1; } } while (0)
        for (int kt = wave; kt < ntile; kt += 32) {
            bf16x8 k4[4][4];
#pragma unroll
            for (int u = 0; u < 4; ++u) { const int ku = kt + 8 * u; IDX_LOAD(k4[u], ku < ntile ? ku : ntile - 1); }
#pragma unroll
            for (int u = 0; u < 4; ++u) { const int ku = kt + 8 * u; if (ku < ntile) IDX_TILE(k4[u], ku); }
        }
#undef IDX_LOAD
#undef IDX_TILE
    }
    __syncthreads();
    if (stop == 1) { __syncthreads(); return; }
    LAS float* row = sc + wave * 4096; LAS unsigned* rowu = (LAS unsigned*)row;
    LAS int* idxl = (LAS int*)(F.lds + IDX_OFF) + wave * 256;
    int nsel;
    if (L <= 256) { nsel = L; for (int i = lane; i < 256; i += 64) idxl[i] = (i < L) ? i : 0; }
    else {
        LAS unsigned* hist = (LAS unsigned*)(F.lds + HIST_OFF) + wave * 512;
        bool ok;
        if (L <= 1024) ok = select256_hist<16>(rowu, idxl, hist, L, lane); else if (L <= 2048) ok = select256_hist<32>(rowu, idxl, hist, L, lane); else if (L <= 3072) ok = select256_hist<48>(rowu, idxl, hist, L, lane); else ok = select256_hist<64>(rowu, idxl, hist, L, lane);
        if (!ok) select256<64>(rowu, idxl, L, lane);
        nsel = 256;
    }
    LDS_WAIT(); asm volatile("" ::: "memory");
    if (stop == 2) { __syncthreads(); return; }
    const int t = t0 + wave;
    {
        const int c16 = lane & 15, q4 = lane >> 4, tq = c16 >> 2, tp = c16 & 3;
        bf16x8 qf[2];
        { const bf16* qp = F_PROJ + (size_t)(b * SEQ + t) * PROJ_LD + (c16 & 7) * 64 + 8 * q4;
          qf[0] = *(const GAS bf16x8*)qp; qf[1] = *(const GAS bf16x8*)(qp + 32);
          if (c16 >= 8) { qf[0] = (bf16x8){0, 0, 0, 0, 0, 0, 0, 0}; qf[1] = qf[0]; } }
        f32x4 lg[16];
        const bf16* kbase = F_KA + (size_t)(b * SEQ) * 64 + 8 * q4;
#pragma unroll
        for (int g = 0; g < 16; ++g) {
            const int p = 16 * g + c16; const int key = (p < nsel) ? idxl[p] : 0;
            const bf16* kp = kbase + (size_t)key * 64;
            const bf16x8 k0 = *(const GAS bf16x8*)kp, k1 = *(const GAS bf16x8*)(kp + 32);
            f32x4 c = {0.f, 0.f, 0.f, 0.f};
            c = __builtin_amdgcn_mfma_f32_16x16x32_bf16(k0, qf[0], c, 0, 0, 0);
            c = __builtin_amdgcn_mfma_f32_16x16x32_bf16(k1, qf[1], c, 0, 0, 0);
#pragma unroll
            for (int r = 0; r < 4; ++r) if (16 * g + 4 * q4 + r >= nsel) c[r] = -INFINITY;
            lg[g] = c;
        }
        v4u vA[8], vB[8];
#pragma unroll
        for (int i = 0; i < 8; ++i) { const int p_ = (lane >> 3) + 8 * i; const int key_ = (p_ < nsel) ? idxl[p_] : 0; vA[i] = *(const GAS v4u*)(F_VA + (size_t)(b * SEQ + key_) * 64 + 8 * (lane & 7)); }
        float m = -INFINITY;
#pragma unroll
        for (int g = 0; g < 16; ++g) m = fmaxf(m, fmaxf(fmaxf(lg[g][0], lg[g][1]), fmaxf(lg[g][2], lg[g][3])));
        m = fmaxf(m, __shfl_xor(m, 16)); m = fmaxf(m, __shfl_xor(m, 32));
        float ssum = 0.f;
#pragma unroll
        for (int g = 0; g < 16; ++g)
#pragma unroll
            for (int r = 0; r < 4; ++r) { const float e = __builtin_amdgcn_exp2f((lg[g][r] - m) * 1.4426950408889634f); lg[g][r] = e; ssum += e; }
        ssum += __shfl_xor(ssum, 16); ssum += __shfl_xor(ssum, 32);
        const float inv = 1.0f / ssum;
        LAS unsigned char* vl = (LAS unsigned char*)row;
        f32x4 o[4];
#pragma unroll
        for (int db = 0; db < 4; ++db) o[db] = (f32x4){0.f, 0.f, 0.f, 0.f};
#define V_LOAD(dst, ch_) do { _Pragma("unroll") for (int i = 0; i < 8; ++i) { const int p_ = 64 * (ch_) + (lane >> 3) + 8 * i; const int key_ = (p_ < nsel) ? idxl[p_] : 0; \
            dst[i] = *(const GAS v4u*)(F_VA + (size_t)(b * SEQ + key_) * 64 + 8 * (lane & 7)); } } while (0)
#define V_STEP(cur, nxt, ch_, HAS_NEXT) do { \
            _Pragma("unroll") for (int i = 0; i < 8; ++i) *(LAS v4u*)(vl + ((lane >> 3) + 8 * i) * 160 + 16 * (lane & 7)) = cur[i]; \
            LDS_WAIT(); asm volatile("" ::: "memory"); \
            if (HAS_NEXT) V_LOAD(nxt, (ch_) + 1); \
            _Pragma("unroll") for (int ss = 0; ss < 2; ++ss) { const int s2 = 2 * (ch_) + ss; \
                v4u w4; w4.x = cvtpk_s(lg[2 * s2][0] * inv, lg[2 * s2][1] * inv); w4.y = cvtpk_s(lg[2 * s2][2] * inv, lg[2 * s2][3] * inv); \
                w4.z = cvtpk_s(lg[2 * s2 + 1][0] * inv, lg[2 * s2 + 1][1] * inv); w4.w = cvtpk_s(lg[2 * s2 + 1][2] * inv, lg[2 * s2 + 1][3] * inv); \
                const bf16x8 pa = __builtin_bit_cast(bf16x8, w4); \
                _Pragma("unroll") for (int db = 0; db < 4; ++db) { \
                    const v4i16_t lo = vtr(vl + (32 * ss + 4 * q4 + tq) * 160 + (16 * db + 4 * tp) * 2), hi2 = vtr(vl + (32 * ss + 16 + 4 * q4 + tq) * 160 + (16 * db + 4 * tp) * 2); \
                    const bf16x8 vf = (bf16x8){lo[0], lo[1], lo[2], lo[3], hi2[0], hi2[1], hi2[2], hi2[3]}; \
                    o[db] = __builtin_amdgcn_mfma_f32_16x16x32_bf16(pa, vf, o[db], 0, 0, 0); } } \
            LDS_WAIT(); asm volatile("" ::: "memory"); } while (0)
        V_STEP(vA, vB, 0, true); V_STEP(vB, vA, 1, true); V_STEP(vA, vB, 2, true); V_STEP(vB, vA, 3, false);
#undef V_LOAD
#undef V_STEP
        if (q4 < 2) { bf16* op = F_OA + (size_t)(b * SEQ + t) * 512 + (4 * q4) * 64 + c16;
#pragma unroll
            for (int db = 0; db < 4; ++db)
#pragma unroll
                for (int r = 0; r < 4; ++r) op[r * 64 + 16 * db] = (bf16)f2bf(o[db][r]); }
    }
    __syncthreads();
}
__device__ __forceinline__ int shx_i(int v, int o, int lane) { return __builtin_amdgcn_ds_bpermute((lane ^ o) << 2, v); }
__device__ __forceinline__ float shx_f(float v, int o, int lane) { return __int_as_float(__builtin_amdgcn_ds_bpermute((lane ^ o) << 2, __float_as_int(v))); }
__device__ __forceinline__ int shl_i(int v, int src) { return __builtin_amdgcn_ds_bpermute(src << 2, v); }
__device__ __forceinline__ unsigned h2key(unsigned u) { return (u & 0x8000u) ? (~u & 0xffffu) : (u | 0x8000u); }
__device__ __forceinline__ float key2val(unsigned k) { const unsigned u = (k & 0x8000u) ? (k ^ 0x8000u) : (~k & 0xffffu); return (float)__builtin_bit_cast(_Float16, (unsigned short)u); }
template <int NV> __device__ __forceinline__ void select256_b16(const LAS unsigned short* rowh, LAS unsigned short* idxl, int L, int lane) {
    unsigned kv[NV]; unsigned kmin = 0xffffffffu, kmax = 0u;
    const LAS unsigned short* rp = rowh + lane; asm volatile("" : "+v"(rp));
#pragma unroll
    for (int j = 0; j < NV; ++j) { unsigned u = 0u; if (j < NV - 16 || 64 * j < L) { u = h2key(rp[64 * j]); kmin = u < kmin ? u : kmin; kmax = u > kmax ? u : kmax; } kv[j] = u; }
#pragma unroll
    for (int o = 1; o < 64; o <<= 1) { const unsigned a = (unsigned)shx_i((int)kmin, o, lane), c2 = (unsigned)shx_i((int)kmax, o, lane); kmin = a < kmin ? a : kmin; kmax = c2 > kmax ? c2 : kmax; }
    unsigned lo = kmin, hi = kmax + 1u; int chi = 0;
    while (hi - lo > 1u) {
        const unsigned mid = lo + ((hi - lo) >> 1);
        int c = 0;
#pragma unroll
        for (int j = 0; j < NV; ++j) c += __popcll(__ballot(kv[j] >= mid));
        if (c >= 256) { lo = mid; if (c == 256) { hi = mid; chi = 256; break; } } else { hi = mid; chi = c; }
    }
    const int need = 256 - chi; int base = 0, tdone = 0;
#pragma unroll
    for (int j = 0; j < NV; ++j) {
        const unsigned u = kv[j];
        const bool gt = u >= hi, eq = (u == lo) && !gt;
        const unsigned long long meq = __ballot(eq);
        const int eqrank = tdone + (int)__builtin_amdgcn_mbcnt_hi((unsigned)(meq >> 32), __builtin_amdgcn_mbcnt_lo((unsigned)meq, 0u));
        const bool sel = gt || (eq && eqrank < need);
        const unsigned long long msel = __ballot(sel);
        const int pos = base + (int)__builtin_amdgcn_mbcnt_hi((unsigned)(msel >> 32), __builtin_amdgcn_mbcnt_lo((unsigned)msel, 0u));
        if (sel && pos < 256) idxl[pos] = (unsigned short)(64 * j + lane);
        base += __popcll(msel); tdone += __popcll(meq);
    }
}
template <int NV> __device__ __forceinline__ bool select256_h16(const LAS unsigned short* rowh, LAS unsigned short* idxl, LAS unsigned* hist  , int L, int lane) {
    float kv[NV]; float fmin = INFINITY, fmax = -INFINITY;
    const LAS _Float16* rp = (const LAS _Float16*)rowh + lane; asm volatile("" : "+v"(rp));
#pragma unroll
    for (int j = 0; j < NV; ++j) { float f = -INFINITY; if (j < NV - 16 || 64 * j < L) { f = (float)rp[64 * j]; fmin = fminf(fmin, f); fmax = fmaxf(fmax, f); } kv[j] = f; }
#pragma unroll
    for (int o = 1; o < 64; o <<= 1) { fmin = fminf(fmin, shx_f(fmin, o, lane)); fmax = fmaxf(fmax, shx_f(fmax, o, lane)); }
    const float rng = fmax - fmin, scale = rng > 0.f ? 511.5f / rng : 0.f;
#pragma unroll
    for (int i = 0; i < 2; ++i) *(LAS v4u*)(hist + 4 * (lane + 64 * i)) = (v4u){0u, 0u, 0u, 0u};
    LDS_WAIT(); asm volatile("" ::: "memory");
    int kb[NV];
#pragma unroll
    for (int j = 0; j < NV; ++j) { int bq = -1;
        if (j < NV - 16 || 64 * j < L) { bq = (int)((kv[j] - fmin) * scale); bq = bq > 511 ? 511 : bq; __hip_atomic_fetch_add(hist + bq, 1u, __ATOMIC_RELAXED, __HIP_MEMORY_SCOPE_WORKGROUP); }
        kb[j] = bq; }
    LDS_WAIT(); asm volatile("" ::: "memory");
    int hb[8];
    { const v4u w0 = *(const LAS v4u*)(hist + 8 * lane), w1 = *(const LAS v4u*)(hist + 8 * lane + 4);
      hb[0] = (int)w0.x; hb[1] = (int)w0.y; hb[2] = (int)w0.z; hb[3] = (int)w0.w; hb[4] = (int)w1.x; hb[5] = (int)w1.y; hb[6] = (int)w1.z; hb[7] = (int)w1.w; }
    int S = 0;
#pragma unroll
    for (int i = 0; i < 8; ++i) S += hb[i];
    int incl = S;
#pragma unroll
    for (int o = 1; o < 64; o <<= 1) { const int v = shl_i(incl, (lane + o) & 63); if (lane + o < 64) incl += v; }
    const int T = incl - S;
    int bstar = -1, cA = 0, nb = 0;
    { int run = T; bool found = false;
#pragma unroll
      for (int i = 7; i >= 0; --i) { const bool here = !found && (T < 256) && (T + S >= 256) && (run + hb[i] >= 256); if (here) { bstar = 8 * lane + i; cA = run; nb = hb[i]; found = true; } run += hb[i]; } }
    { const unsigned long long mown = __ballot(bstar >= 0); const int src = (int)__ffsll((long long)mown) - 1; bstar = shl_i(bstar, src); cA = shl_i(cA, src); nb = shl_i(nb, src); }
    if (nb > 512) return false;
    const int need = 256 - cA;
    LDS_WAIT(); asm volatile("" ::: "memory");
    LAS int* cand = (LAS int*)hist;
    int base = 0, cbase = 0;
#pragma unroll
    for (int j = 0; j < NV; ++j) {
        const bool gt = kb[j] > bstar, eq = kb[j] == bstar;
        const unsigned long long mg = __ballot(gt), me = __ballot(eq);
        const int pg = base + (int)__builtin_amdgcn_mbcnt_hi((unsigned)(mg >> 32), __builtin_amdgcn_mbcnt_lo((unsigned)mg, 0u));
        const int pe = cbase + (int)__builtin_amdgcn_mbcnt_hi((unsigned)(me >> 32), __builtin_amdgcn_mbcnt_lo((unsigned)me, 0u));
        if (gt && pg < 256) idxl[pg] = (unsigned short)(64 * j + lane);
        if (eq && pe < 512) cand[pe] = 64 * j + lane;
        base += __popcll(mg); cbase += __popcll(me);
    }
    LDS_WAIT(); asm volatile("" ::: "memory");
    for (int i = lane; i < nb; i += 64) {
        const int ci = cand[i]; const unsigned ki = h2key(rowh[ci]);
        int rank = 0;
        for (int j = 0; j < nb; ++j) { const int cj = cand[j]; const unsigned kj = h2key(rowh[cj]); rank += (kj > ki || (kj == ki && cj < ci)) ? 1 : 0; }
        if (rank < need) idxl[cA + rank] = (unsigned short)ci;
    }
    return true;
}
__device__ __forceinline__ void unpk8(const bf16x8& v, float (&x)[8]) { const v4u u = __builtin_bit_cast(v4u, v); x[0] = bflo(u.x); x[1] = bfhi(u.x); x[2] = bflo(u.y); x[3] = bfhi(u.y); x[4] = bflo(u.z); x[5] = bfhi(u.z); x[6] = bflo(u.w); x[7] = bfhi(u.w); }
__device__ __forceinline__ bf16x8 pk8(const float (&x)[8]) { v4u u; u.x = cvtpk_s(x[0], x[1]); u.y = cvtpk_s(x[2], x[3]); u.z = cvtpk_s(x[4], x[5]); u.w = cvtpk_s(x[6], x[7]); return __builtin_bit_cast(bf16x8, u); }
__device__ __forceinline__ void rope_frag(float (&x)[8], bool lowhalf, int pmask, int lane, const float* tab) {
#pragma unroll
    for (int i = 0; i < 8; ++i) { const float o = shx_f(x[i], pmask, lane); const float cs = tab[2 * i], sn = tab[2 * i + 1]; x[i] = lowhalf ? x[i] * cs - o * sn : x[i] * cs + o * sn; }
}
template <bool FULL> __device__ __forceinline__ void dsa_attend(Frame& F, int b, int t, int nsel_, const LAS unsigned short* idxl, LAS unsigned char* vl, int lane) {
    int nsel = FULL ? 256 : nsel_; if (!FULL) asm volatile("" : "+v"(nsel));
    const int c16 = lane & 15, q4 = lane >> 4, tq = c16 >> 2, tp = c16 & 3;
    bf16x8 qf[2];
    { const bf16* qp = F_PROJ + (size_t)(b * SEQ + t) * PROJ_LD + (c16 & 7) * 64 + 8 * q4;
      qf[0] = *(const GAS bf16x8*)qp; qf[1] = *(const GAS bf16x8*)(qp + 32);
      if (c16 >= 8) { qf[0] = (bf16x8){0, 0, 0, 0, 0, 0, 0, 0}; qf[1] = qf[0]; } }
    f32x4 lg[16];
    const bf16* kbase = F_KA + (size_t)(b * SEQ) * 64 + 8 * q4;
#pragma unroll
    for (int g = 0; g < 16; ++g) {
        const int p = 16 * g + c16; const int key = (FULL || p < nsel) ? (int)idxl[p] : 0;
        const bf16* kp = kbase + (size_t)key * 64;
        const bf16x8 k0 = *(const GAS bf16x8*)kp, k1 = *(const GAS bf16x8*)(kp + 32);
        f32x4 c = {0.f, 0.f, 0.f, 0.f};
        c = __builtin_amdgcn_mfma_f32_16x16x32_bf16(k0, qf[0], c, 0, 0, 0);
        c = __builtin_amdgcn_mfma_f32_16x16x32_bf16(k1, qf[1], c, 0, 0, 0);
        if (!FULL) {
#pragma unroll
            for (int r = 0; r < 4; ++r) if (16 * g + 4 * q4 + r >= nsel) c[r] = -INFINITY; }
        lg[g] = c;
    }
    v4u vA[8];
#define V_LOAD(dst, ch_) do { _Pragma("unroll") for (int i = 0; i < 8; ++i) { const int p_ = 64 * (ch_) + (lane >> 3) + 8 * i; const int key_ = (FULL || p_ < nsel) ? (int)idxl[p_] : 0; \
        dst[i] = *(const GAS v4u*)(F_VA + (size_t)(b * SEQ + key_) * 64 + 8 * (lane & 7)); } } while (0)
    V_LOAD(vA, 0);
    float m = -INFINITY;
#pragma unroll
    for (int g = 0; g < 16; ++g) m = fmaxf(m, fmaxf(fmaxf(lg[g][0], lg[g][1]), fmaxf(lg[g][2], lg[g][3])));
    m = fmaxf(m, shx_f(m, 16, lane)); m = fmaxf(m, shx_f(m, 32, lane));
    float ssum = 0.f;
#pragma unroll
    for (int g = 0; g < 16; ++g)
#pragma unroll
        for (int r = 0; r < 4; ++r) { const float e = __builtin_amdgcn_exp2f((lg[g][r] - m) * 1.4426950408889634f); lg[g][r] = e; ssum += e; }
    ssum += shx_f(ssum, 16, lane); ssum += shx_f(ssum, 32, lane);
    const float inv = 1.0f / ssum;
    f32x4 o[4];
#pragma unroll
    for (int db = 0; db < 4; ++db) o[db] = (f32x4){0.f, 0.f, 0.f, 0.f};
#define VSWZ(row_, chunk_) ((row_) * 128 + ((((chunk_)) ^ (2 * (((row_) >> 1) & 3))) * 16))
#define V_STEP(cur, nxt, ch_, HAS_NEXT) do { \
        _Pragma("unroll") for (int i = 0; i < 8; ++i) { const int row_ = (lane >> 3) + 8 * i; *(LAS v4u*)(vl + VSWZ(row_, lane & 7)) = cur[i]; } \
        LDS_WAIT(); asm volatile("" ::: "memory"); \
        if (HAS_NEXT) V_LOAD(nxt, (ch_) + 1); \
        _Pragma("unroll") for (int ss = 0; ss < 2; ++ss) { const int s2 = 2 * (ch_) + ss; \
            v4u w4; w4.x = cvtpk_s(lg[2 * s2][0] * inv, lg[2 * s2][1] * inv); w4.y = cvtpk_s(lg[2 * s2][2] * inv, lg[2 * s2][3] * inv); \
            w4.z = cvtpk_s(lg[2 * s2 + 1][0] * inv, lg[2 * s2 + 1][1] * inv); w4.w = cvtpk_s(lg[2 * s2 + 1][2] * inv, lg[2 * s2 + 1][3] * inv); \
            const bf16x8 pa = __builtin_bit_cast(bf16x8, w4); \
            _Pragma("unroll") for (int db = 0; db < 4; ++db) { const int r0_ = 32 * ss + 4 * q4 + tq, r1_ = r0_ + 16; \
                const v4i16_t lo = vtr(vl + VSWZ(r0_, 2 * db + (tp >> 1)) + 8 * (tp & 1)), hi2 = vtr(vl + VSWZ(r1_, 2 * db + (tp >> 1)) + 8 * (tp & 1)); \
                const bf16x8 vf = (bf16x8){lo[0], lo[1], lo[2], lo[3], hi2[0], hi2[1], hi2[2], hi2[3]}; \
                o[db] = __builtin_amdgcn_mfma_f32_16x16x32_bf16(pa, vf, o[db], 0, 0, 0); } } \
        LDS_WAIT(); asm volatile("" ::: "memory"); } while (0)
    V_STEP(vA, vA, 0, true); V_STEP(vA, vA, 1, true); V_STEP(vA, vA, 2, true); V_STEP(vA, vA, 3, false);
#undef V_LOAD
#undef V_STEP
#undef VSWZ
    if (q4 < 2) { bf16* op = F_OA + (size_t)(b * SEQ + t) * 512 + (4 * q4) * 64 + c16;
#pragma unroll
        for (int db = 0; db < 4; ++db)
#pragma unroll
            for (int r = 0; r < 4; ++r) op[r * 64 + 16 * db] = (bf16)f2bf(o[db][r]); }
}
__device__ __forceinline__ void idx_load(bf16x8 (&kb)[4], const bf16* kbase, int kt) {
    const bf16* kp = kbase + (size_t)(32 * kt) * 64;
#pragma unroll
    for (int ks = 0; ks < 4; ++ks) kb[ks] = *(const GAS bf16x8*)(kp + 16 * ks);
}
__device__ __forceinline__ f32x16 idx_chain(const bf16x8 (&q)[4], const bf16x8 (&kb)[4]) {
    f32x16 c;
#pragma unroll
    for (int i = 0; i < 16; ++i) c[i] = 0.f;
#pragma unroll
    for (int ks = 0; ks < 4; ++ks) c = __builtin_amdgcn_mfma_f32_32x32x16_bf16(q[ks], kb[ks], c, 0, 0, 0);
    return c;
}
struct IdxW { f32x4 a0, a1, b0, b1; };
__device__ __forceinline__ f32x16 idx_chain_valu(const bf16x8 (&q)[4], const bf16x8 (&kb)[4], const f32x16& co, const IdxW& w, LAS _Float16* sch, int jo, int kto, int r, int hb) {
    const f32x4 wa0 = w.a0, wa1 = w.a1, wb0 = w.b0, wb1 = w.b1;
    f32x16 c;
#pragma unroll
    for (int i = 0; i < 16; ++i) c[i] = 0.f;
#pragma unroll
    for (int ks = 0; ks < 4; ++ks) c = __builtin_amdgcn_mfma_f32_32x32x16_bf16(q[ks], kb[ks], c, 0, 0, 0);
#define RL(i_) relu_i(co[i_])
    f32x2_t a0 = (f32x2_t){wa0.x, wa0.y} * (f32x2_t){RL(0), RL(1)};
    a0 = __builtin_elementwise_fma((f32x2_t){wa0.z, wa0.w}, (f32x2_t){RL(2), RL(3)}, a0); a0 = __builtin_elementwise_fma((f32x2_t){wa1.x, wa1.y}, (f32x2_t){RL(4), RL(5)}, a0); a0 = __builtin_elementwise_fma((f32x2_t){wa1.z, wa1.w}, (f32x2_t){RL(6), RL(7)}, a0);
    f32x2_t a1 = (f32x2_t){wb0.x, wb0.y} * (f32x2_t){RL(8), RL(9)};
    a1 = __builtin_elementwise_fma((f32x2_t){wb0.z, wb0.w}, (f32x2_t){RL(10), RL(11)}, a1); a1 = __builtin_elementwise_fma((f32x2_t){wb1.x, wb1.y}, (f32x2_t){RL(12), RL(13)}, a1); a1 = __builtin_elementwise_fma((f32x2_t){wb1.z, wb1.w}, (f32x2_t){RL(14), RL(15)}, a1);
#undef RL
    const float s0 = a0.x + a0.y, s1 = a1.x + a1.y;
    sch[(4 * jo + hb) * 4096 + 32 * kto + r] = (_Float16)s0; sch[(4 * jo + hb + 2) * 4096 + 32 * kto + r] = (_Float16)s1;
#pragma unroll
    for (int g = 0; g < 4; ++g) { __builtin_amdgcn_sched_group_barrier(0x008, 1, 0); __builtin_amdgcn_sched_group_barrier(0x002, 8, 0); }
    return c;
}
__device__ __forceinline__ void dsa_item16(Frame& F, int b, int t0, int stop) {
    unsigned ones_ = ~0u; asm volatile("" : "+v"(ones_));
    const int lane = (int)__builtin_amdgcn_mbcnt_hi(ones_, __builtin_amdgcn_mbcnt_lo(ones_, 0u)), wave = F.wave;
    const int L = ((t0 >> 6) + 1) << 6;
    LAS _Float16* sch = (LAS _Float16*)(F.lds + RING_OFF);
    if (L > 256) {
        const int r = lane & 31, hb = lane >> 5;
        const int head = (r & 3) + 4 * ((r >> 3) & 1), qsub = ((r >> 2) & 1) + 2 * ((r >> 4) & 1);
        bf16x8 qa[4][4];
        LAS float* wl = (LAS float*)(F.lds + HIST_OFF) + wave * 512;
        { const f32x2_t w2 = *(const GAS f32x2_t*)(F_WIQ + (size_t)(b * SEQ + t0) * 8 + 2 * lane); *(LAS f32x2_t*)(wl + 2 * lane) = w2; }
#pragma unroll
        for (int j = 0; j < 4; ++j) {
            const bf16* qp = F_PROJ + (size_t)(b * SEQ + t0 + 4 * j + qsub) * PROJ_LD + 512 + head * 64 + 8 * hb;
#pragma unroll
            for (int ks = 0; ks < 4; ++ks) qa[j][ks] = *(const GAS bf16x8*)(qp + 16 * ks);
            { float xr[8]; unpk8(qa[j][0], xr); rope_frag(xr, hb == 0, 32, lane, F_ROPE + (size_t)(t0 + 4 * j + qsub) * 16); qa[j][0] = pk8(xr); }
        }
        LDS_WAIT(); asm volatile("" ::: "memory");
        const int ntile = L >> 5;
        const bf16* kbase = F_KI + (size_t)(b * SEQ + r) * 64 + 8 * hb;
        const int nmy = (ntile - wave + 7) >> 3;
#define IDX_CL(i_) (wave + 8 * ((i_) < nmy ? (i_) : nmy - 1))
#define IDX_STAGE(cn_, jn_, kbn_, co_, jo_, kto_) do { cn_ = idx_chain_valu(qa[jn_], kbn_, co_, W[jo_], sch, jo_, kto_, r, hb); } while (0)
        if (nmy > 0) {
            bf16x8 kbA[4], kbB[4];
            idx_load(kbA, kbase, wave);
            IdxW W[4];
#pragma unroll
            for (int j = 0; j < 4; ++j) { W[j].a0 = *(const LAS f32x4*)(wl + (4 * j + hb) * 8); W[j].a1 = *(const LAS f32x4*)(wl + (4 * j + hb) * 8 + 4); W[j].b0 = *(const LAS f32x4*)(wl + (4 * j + hb + 2) * 8); W[j].b1 = *(const LAS f32x4*)(wl + (4 * j + hb + 2) * 8 + 4); }
            f32x16 c0 = idx_chain(qa[0], kbA), c1;
            int i = 0;
#pragma unroll 1
            for (;;) {
                const int ktA = wave + 8 * i, ktB = ktA + 8;
                idx_load(kbB, kbase, IDX_CL(i + 1));
                IDX_STAGE(c1, 1, kbA, c0, 0, ktA); IDX_STAGE(c0, 2, kbA, c1, 1, ktA); IDX_STAGE(c1, 3, kbA, c0, 2, ktA); IDX_STAGE(c0, 0, kbB, c1, 3, ktA);
                if (i + 1 >= nmy) break;
                idx_load(kbA, kbase, IDX_CL(i + 2));
                IDX_STAGE(c1, 1, kbB, c0, 0, ktB); IDX_STAGE(c0, 2, kbB, c1, 1, ktB); IDX_STAGE(c1, 3, kbB, c0, 2, ktB); IDX_STAGE(c0, 0, kbA, c1, 3, ktB);
                i += 2;
                if (i >= nmy) break;
            }
        }
#undef IDX_CL
#undef IDX_STAGE
    }
    __syncthreads();
    if (stop == 1) { __syncthreads(); return; }
    LAS unsigned short* idx0 = (LAS unsigned short*)(F.lds + IDX_OFF) + wave * 512;
    LAS unsigned char* vl = (LAS unsigned char*)sch + wave * 8192;
    int nsel = 256;
    const bool early = wave < 4;
#pragma unroll 1
    for (int step = 0; step < 4; ++step) {
        const bool do_sel = early ? ((step & 1) == 0) : (step < 2);
        const int qq = early ? (step >> 1) : (step & 1);
        if (do_sel) {
            int Lq = L; asm volatile("" : "+s"(Lq));
            const LAS unsigned short* rowh = (const LAS unsigned short*)sch + (wave + 8 * qq) * 4096;
            LAS unsigned short* idxl = idx0 + 256 * qq;
            if (Lq <= 256) { nsel = Lq; for (int i = lane; i < 256; i += 64) idxl[i] = (unsigned short)((i < Lq) ? i : 0); }
            else {
                LAS unsigned* hist = (LAS unsigned*)(F.lds + HIST_OFF) + wave * 512;
                bool ok;
                if (Lq <= 1024) ok = select256_h16<16>(rowh, idxl, hist, Lq, lane); else if (Lq <= 2048) ok = select256_h16<32>(rowh, idxl, hist, Lq, lane); else if (Lq <= 3072) ok = select256_h16<48>(rowh, idxl, hist, Lq, lane); else ok = select256_h16<64>(rowh, idxl, hist, Lq, lane);
                if (!ok) select256_b16<64>(rowh, idxl, Lq, lane);
            }
            LDS_WAIT(); asm volatile("" ::: "memory");
        } else if (stop != 2) {
            if (nsel == 256) dsa_attend<true>(F, b, t0 + wave + 8 * qq, 256, idx0 + 256 * qq, vl, lane); else dsa_attend<false>(F, b, t0 + wave + 8 * qq, nsel, idx0 + 256 * qq, vl, lane);
        }
    }
    __syncthreads();
}
__device__ __forceinline__ void p3_attention(Frame& F, int rep) {
    const int stop = (rep == 1 && P3_MODE >= 2) ? P3_MODE - 1 : 0;
    if (!(rep == 1 && P3_MODE >= 2)) { for (int item = blockIdx.x; item < 512; item += F.G) sb_item_mfma(F, item);
    __syncthreads(); }
    if (rep == 1 && P3_MODE == 1) return;
    {
    gu32* qh = F.ctl + CW_QUEUE + 64 * rep;
    if (F.wave == 0 && fresh_lane() == 0) F.MISC[MI_Q] = __hip_atomic_fetch_add(qh, 1u, RLX_AGENT);
    __syncthreads();
    for (int par = 0;; par ^= 1) {
        const int it = (int)F.MISC[MI_Q + par];
        if (it >= 1024) break;
        if (F.wave == 0 && fresh_lane() == 0) F.MISC[MI_Q + (par ^ 1)] = __hip_atomic_fetch_add(qh, 1u, RLX_AGENT);
        const int chunk = 63 - (it >> 4), within = it & 15, b = within >> 2, g4 = within & 3;
        dsa_item16(F, b, chunk * 64 + g4 * 16, stop);
    }
    }
}

__device__ __forceinline__ void p6_router(Frame& F, int rep) {
    const size_t sh4 = rep ? (size_t)(WS_ACT - WS_TOKE) / 4 : 0, sh2 = rep ? (size_t)(WS_Y - WS_XN) / 2 : 0;
    const int lane = F.lane, w4 = F.wave & 3, hbk = F.wave >> 2, lt = F.tid & 255, r32 = lane & 31, hb = lane >> 5;
    LAS float* hs = (LAS float*)(F.lds + hbk * 70912);
    LAS float* red = hs;
    LAS float* lgt = hs + 32 * 516;
    LAS float* rrs = lgt + 32 * 33;
    LAS int* ent = (LAS int*)(rrs + 32);
    const float* H = (F.a->out);
    for (int tile0 = blockIdx.x * 2; tile0 < NTOK / 32; tile0 += 2 * F.G) {
        const int tok0 = (tile0 + hbk) * 32;
        f32x16 acc;
#pragma unroll
        for (int i = 0; i < 16; ++i) acc[i] = 0.f;
        f32x4 st[16];
#pragma unroll
        for (int i = 0; i < 16; ++i) { const int idx = lt + 256 * i; st[i] = *(const GAS f32x4*)(H + (size_t)(tok0 + (idx >> 7)) * DM + 4 * (idx & 127)); }
        if (lt < 32) { float ssq = 0.f;
#pragma unroll
            for (int i = 0; i < 16; ++i) ssq += F_SSQP[(size_t)(tok0 + lt) * 16 + i];
            rrs[lt] = 1.0f / sqrtf(ssq * (1.f / DM) + RMS_EPS); }
#pragma unroll 1
        for (int half = 0; half < 2; ++half) {
#pragma unroll
            for (int i = 0; i < 16; ++i) { const int idx = lt + 256 * i; *(LAS f32x4*)(hs + (idx >> 7) * 516 + 4 * (idx & 127)) = st[i]; }
            __syncthreads();
            {
                const f32x4 g4 = *((const GAS f32x4*)(F.a->in[8]) + 128 * half + (lt & 127));
#pragma unroll
                for (int i = 0; i < 16; ++i) { const int idx = lt + 256 * i, tl = idx >> 7; const float rr = rrs[tl]; const f32x4 v = st[i];
                    int pk = __builtin_amdgcn_cvt_pk_fp8_f32(v.x * rr * g4.x, v.y * rr * g4.y, 0, false); pk = __builtin_amdgcn_cvt_pk_fp8_f32(v.z * rr * g4.z, v.w * rr * g4.w, pk, true);
                    *((GAS int*)((unsigned char*)F_XN + sh2 + (size_t)(tok0 + tl) * DM + 512 * half) + (idx & 127)) = pk; }
            }
            if (half == 0) {
#pragma unroll
                for (int i = 0; i < 16; ++i) { const int idx = lt + 256 * i; st[i] = *(const GAS f32x4*)(H + (size_t)(tok0 + (idx >> 7)) * DM + 512 + 4 * (idx & 127)); } }
            {
                const int kl = w4 * 128 + 64 * hb;
                const float* wp = F_WRG + (size_t)(512 * half + kl) * 32 + r32;
                const LAS float* ap = hs + r32 * 516 + kl;
#pragma unroll
                for (int c = 0; c < 4; ++c) {
                    f32x4 a4[4]; float b1[16];
#pragma unroll
                    for (int j = 0; j < 4; ++j) a4[j] = *(const LAS f32x4*)(ap + 16 * c + 4 * j);
#pragma unroll
                    for (int j = 0; j < 16; ++j) b1[j] = wp[(size_t)(16 * c + j) * 32];
#pragma unroll
                    for (int j = 0; j < 16; ++j) acc = __builtin_amdgcn_mfma_f32_32x32x2f32(a4[j >> 2][j & 3], b1[j], acc, 0, 0, 0);
                }
            }
            __syncthreads();
        }
#pragma unroll
        for (int i = 0; i < 16; ++i) red[(w4 * 32 + (i & 3) + 8 * (i >> 2) + 4 * hb) * 33 + r32] = acc[i];
        __syncthreads();
        float sums[4];
#pragma unroll
        for (int q = 0; q < 4; ++q) { const int idx = lt + 256 * q, tk = idx >> 5, e = idx & 31; float sum = 0.f;
#pragma unroll
            for (int w2 = 0; w2 < 4; ++w2) sum += red[(w2 * 32 + tk) * 33 + e];
            sums[q] = sum; }
#pragma unroll
        for (int q = 0; q < 4; ++q) { const int idx = lt + 256 * q; lgt[(idx >> 5) * 33 + (idx & 31)] = sums[q]; }
        __syncthreads();
#pragma unroll
        for (int pass = 0; pass < 4; ++pass) {
            const int tl = 8 * w4 + 2 * pass + hb;
            float v = lgt[tl * 33 + r32] * rrs[tl] + (F.a->in[10])[r32];
            float tv[4]; int te[4];
#pragma unroll
            for (int k = 0; k < 4; ++k) { float bv = v; int be = r32;
#pragma unroll
                for (int o = 1; o < 32; o <<= 1) { const float ov = __shfl_xor(bv, o); const int oe = __shfl_xor(be, o); if (ov > bv || (ov == bv && oe < be)) { bv = ov; be = oe; } }
                tv[k] = bv; te[k] = be; if (r32 == be) v = -INFINITY; }
            float gk[4], gs = 0.f;
#pragma unroll
            for (int k = 0; k < 4; ++k) { gk[k] = __expf(tv[k] - tv[0]); gs += gk[k]; }
            const float ginv = 1.0f / gs;
            if (r32 < 4) { const int m = (tok0 + tl) * 4 + r32; const int ee = r32 == 0 ? te[0] : (r32 == 1 ? te[1] : (r32 == 2 ? te[2] : te[3])); const float gg = r32 == 0 ? gk[0] : (r32 == 1 ? gk[1] : (r32 == 2 ? gk[2] : gk[3]));
                (F_TOKE + sh4)[m] = ee; (F_TOKG + sh4)[m] = gg * ginv; ent[tl * 4 + r32] = ee; }
        }
        __syncthreads();
        if (w4 == 0) {
            const int e0 = ent[lane], e1 = ent[lane + 64];
            int mycnt = 0, r0 = 0, r1 = 0;
            for (int j = 0; j < 32; ++j) { const unsigned long long m0 = __ballot(e0 == j), m1 = __ballot(e1 == j); const int c0 = __popcll(m0);
                if (e0 == j) r0 = (int)__builtin_amdgcn_mbcnt_hi((unsigned)(m0 >> 32), __builtin_amdgcn_mbcnt_lo((unsigned)m0, 0u));
                if (e1 == j) r1 = c0 + (int)__builtin_amdgcn_mbcnt_hi((unsigned)(m1 >> 32), __builtin_amdgcn_mbcnt_lo((unsigned)m1, 0u));
                if (lane == j) mycnt = c0 + __popcll(m1); }
            int mybase = 0; if (lane < 32 && mycnt > 0) mybase = (int)__hip_atomic_fetch_add(F.ctl + CW_CNT + 64 * rep + lane, (unsigned)mycnt, RLX_AGENT);
            const int p0 = __shfl(mybase, e0) + r0, p1 = __shfl(mybase, e1) + r1;
            const int m0i = tok0 * 4 + lane, m1i = tok0 * 4 + lane + 64;
            (F_TOKP + sh4)[m0i] = p0; (F_LIST + sh4)[(size_t)e0 * NTOK + p0] = m0i;
            (F_TOKP + sh4)[m1i] = p1; (F_LIST + sh4)[(size_t)e1 * NTOK + p1] = m1i;
        }
        __syncthreads();
    }
}
__device__ __forceinline__ void compute_ts(Frame& F) {
    if (F.tid < 32) F.MISC[MI_CNT + F.tid] = __hip_atomic_load(F.ctl + CW_CNT + F.tid, RLX_AGENT);
    __syncthreads();
    if (F.tid == 0) { unsigned run = 0; for (int e = 0; e < 32; ++e) { F.MISC[MI_TS + e] = run; run += (F.MISC[MI_CNT + e] + 255u) >> 8; } F.MISC[MI_TS + 32] = run; }
    __syncthreads();
}
__device__ __forceinline__ void p7_gather(Frame& F) {
    const int gw = blockIdx.x * NWAVES + F.wave, NGW = F.G * NWAVES; const int T = (int)F.MISC[MI_TS + 32];
    for (int r = gw; r < T * 256; r += NGW) {
        const int rt = r >> 8; int e = 0; while (e < 31 && (int)F.MISC[MI_TS + e + 1] <= rt) ++e;
        const int local = r - 256 * (int)F.MISC[MI_TS + e]; const bool valid = local < (int)F.MISC[MI_CNT + e];
        v4u a = {0u, 0u, 0u, 0u};
        if (valid) { const int tok = F_LIST[(size_t)e * NTOK + local] >> 2; a = ((const GAS v4u*)((unsigned char*)F_XN + (size_t)tok * DM))[F.lane]; }
        ((GAS v4u*)((unsigned char*)F_XG + (size_t)r * DM))[F.lane] = a;
    }
}
__device__ __forceinline__ void p10_combine(Frame& F, int rep) {
    const int gw = blockIdx.x * NWAVES + F.wave, NGW = F.G * NWAVES;
    for (int tok = gw; tok < NTOK; tok += NGW) {
        float g[4]; const unsigned char* yr[4];
#pragma unroll
        for (int k = 0; k < 4; ++k) { const int m = tok * 4 + k; const int e = F_TOKE[m]; g[k] = F_TOKG[m]; yr[k] = (const unsigned char*)F_Y + (size_t)(256 * (int)F.MISC[MI_TS + e] + F_TOKP[m]) * DM; }
        GAS f32x4* hr = (GAS f32x4*)((F.a->out) + (size_t)tok * DM) + F.lane;
#pragma unroll
        for (int j = 0; j < 4; ++j) { f32x4 v = hr[64 * j];
#pragma unroll
            for (int k = 0; k < 4; ++k) { const int y = *((const GAS int*)yr[k] + 64 * j + F.lane); const f32x2_t lo = __builtin_amdgcn_cvt_pk_f32_fp8(y, false), hi = __builtin_amdgcn_cvt_pk_f32_fp8(y, true);
                v.x += g[k] * lo.x; v.y += g[k] * lo.y; v.z += g[k] * hi.x; v.w += g[k] * hi.y; }
            if (rep) ((GAS f32x4*)(WSP(float, WS_XG) + (size_t)tok * DM) + F.lane)[64 * j] = v; else hr[64 * j] = v; }
    }
}

__global__ void __launch_bounds__(NWAVES * 64, 2) mk_fwd(Args args) {
    extern __shared__ __attribute__((aligned(16))) unsigned char lds[];
    Frame F;
    F.lds = (LAS unsigned char*)lds;
    F.MISC = (volatile LAS unsigned*)(F.lds + MISC_OFF);
    F.tid = threadIdx.x; F.lane = F.tid & 63; F.wave = __builtin_amdgcn_readfirstlane(F.tid >> 6);
    F.G = gridDim.x;
    F.a = &args;
    F.ctl = (gu32*)(args.ws + WS_CTL);
    for (int u = F.tid; u < (LDS_BYTES - LDSCTL_OFF) / 4; u += NWAVES * 64) ((LAS unsigned*)(F.lds + LDSCTL_OFF))[u] = 0u;
    __syncthreads();
    XcdBarrier bar; bar.bar = (unsigned*)(F.ctl + CW_BAR); bar.x = 0; bar.st = nullptr;
    if (N_LAUNCHES == 1) bar = xcd_barrier_post((unsigned*)(F.ctl + CW_BAR), F.MISC + MI_BAR);
    const int lo = args.ph_lo, hi = args.ph_hi;
#ifdef PHASE_ONLY
#define IN(k) ((k) == PHASE_ONLY && lo <= (k) && (k) < hi)
#else
#define IN(k) (lo <= (k) && (k) < hi)
#endif
#ifndef REPEAT_PHASE
#define REPEAT_PHASE -1
#endif
#define REFRESH() do { F.lane = fresh_lane(); F.tid = F.lane + 64 * F.wave; } while (0)
#ifndef P1_MODE
#define P1_MODE 0
#endif
#ifndef DOUBLE_BAR
#define DOUBLE_BAR 0
#endif
#define SEAM(k) do { if (IN(k) && IN((k) + 1)) { xcd_barrier(bar, F.wave == 0 && fresh_lane() == 0); if (DOUBLE_BAR) xcd_barrier(bar, F.wave == 0 && fresh_lane() == 0); } } while (0)
    const bool split = (F.G & 31) == 0 && F.G >= 64;
    const int NCV = split ? F.G / 4 : 0;
    if (IN(0)) { REFRESH(); p0_prologue(F, split ? MOE_P1_ITEMS : 0); __syncthreads(); } SEAM(0);
    if (IN(1)) { REFRESH(); pg8::Gemm g{F_XN, F_WI, NTOK, NPROJ_PAD, DM}; pg8::StaticOrder S; S.init(NTOK, NPROJ_PAD, F.G, (int)blockIdx.x);
        if (split) { const int slot = (int)blockIdx.x >> 3, xcd = (int)blockIdx.x & 7;
            if ((slot & 3) == 3) { const int cc = (slot >> 2) * 8 + xcd; if (!(P1_MODE == 1 && args.rep)) p1_convert(F, cc, NCV, MOE_P1_ITEMS); __syncthreads(); S.G = NCV; S.c = S.nwg - NCV + cc; }
            else { S.G = F.G - NCV; S.c = (slot - (slot >> 2)) * 8 + xcd; S.lim = S.nwg - NCV; } }
        if (P1_MODE == 2 && args.rep) S.lim = 0;
        pg8::EpiProj E{F_PROJ, F_SMALLF}; pg8::gemm_phase<pg8::EpiProj, pg8::StaticOrder, true, true>(F.lds + RING_OFF, g, S, E, F.wave); } SEAM(1);
    if (IN(2)) { REFRESH(); p2_prep(F, args.rep); } SEAM(2);
    if (IN(3)) { REFRESH(); p3_attention(F, args.rep); } SEAM(3);
    if (IN(4)) { REFRESH(); pg8::StaticOrder S; S.init(NTOK, DM, F.G, (int)blockIdx.x);
        { pg8::Gemm g{F_OA, F_WPA, NTOK, DM, 512}; pg8::EpiGate<true> E{F_PROJ, 2560, F_MERGED}; pg8::gemm_phase<pg8::EpiGate<true>, pg8::StaticOrder, true, true>(F.lds + RING_OFF, g, S, E, F.wave); }
        { pg8::Gemm g{F_OB, F_WPB, NTOK, DM, 512}; pg8::EpiGate<false> E{F_PROJ, 3584, F_MERGED}; pg8::gemm_phase<pg8::EpiGate<false>, pg8::StaticOrder, true, true>(F.lds + RING_OFF, g, S, E, F.wave); } } SEAM(4);
    if (IN(5)) { REFRESH(); pg8::Gemm g{F_MERGED, F_WO, NTOK, DM, DM}; pg8::StaticOrder S; S.init(NTOK, DM, F.G, (int)blockIdx.x);
        pg8::EpiOut E{(F.a->in[0]), (F.a->out), F_SSQP}; pg8::gemm_phase<pg8::EpiOut, pg8::StaticOrder, true, true>(F.lds + RING_OFF, g, S, E, F.wave); } SEAM(5);
    if (IN(6)) { REFRESH(); p6_router(F, args.rep); } SEAM(6);
    REFRESH();
    if (hi > 7) compute_ts(F);
    if (IN(8)) { REFRESH(); pg8::Gemm g{F_XN, F_WGU, 0, 2048, DM / 2}; pg8::MoeOrder S; S.init((const volatile LAS int*)(F.MISC + MI_TS), (const volatile LAS int*)(F.MISC + MI_CNT), F_LIST, 8, F.G, (int)blockIdx.x);
        pg8::EpiAct E{(F.a->in[12]), (unsigned char*)F_ACT}; pg8::gemm_phase<pg8::EpiAct, pg8::MoeOrder, true, true, true, true>(F.lds + RING_OFF, g, S, E, F.wave);
        __syncthreads(); REFRESH(); p8_convert_wd(F, args.rep); } SEAM(8);
    if (IN(9)) { REFRESH(); pg8::Gemm g{F_ACT, F_WD, 0, DM, DM / 2}; pg8::MoeOrder S; S.init((const volatile LAS int*)(F.MISC + MI_TS), (const volatile LAS int*)(F.MISC + MI_CNT), F_LIST, 4, F.G, (int)blockIdx.x);
        pg8::EpiDown E{(F.a->in[14]), (unsigned char*)F_Y}; pg8::gemm_phase<pg8::EpiDown, pg8::MoeOrder, true, true, true>(F.lds + RING_OFF, g, S, E, F.wave); } SEAM(9);
    if (IN(10)) { REFRESH(); p10_combine(F, args.rep);
        if (N_LAUNCHES == 1) {
            const unsigned bad = __hip_atomic_load((gu32*)((unsigned*)(F.ctl + CW_BAR) + XB_TMO), RLX_AGENT);
            if (bad) { const float q = __builtin_nanf(""); for (size_t i = (size_t)blockIdx.x * 512 + F.tid; i < (size_t)NTOK * DM; i += (size_t)F.G * 512) (F.a->out)[i] = q; } } }
#undef IN
#undef SEAM
}

extern "C" void kernel_launch(void* const* d_in, const int* in_sizes, int n_in, void* d_out, int out_size, void* d_ws, size_t ws_size, hipStream_t stream) {
    static int grid = 0;
    if (grid == 0) {
        if (n_in != 15 || in_sizes[0] != NTOK * DM || out_size != NTOK * DM || ws_size < WS_END) { fprintf(stderr, "kernel_launch: unexpected shapes / workspace (n_in %d, in0 %d, out %d, ws %zu); nothing launched\n", n_in, n_in > 0 ? in_sizes[0] : -1, out_size, ws_size); grid = -1; return; }
        int dev = 0, cus = 0, per_cu = 0;
        if (hipGetDevice(&dev) != hipSuccess || hipDeviceGetAttribute(&cus, hipDeviceAttributeMultiprocessorCount, dev) != hipSuccess) { fprintf(stderr, "kernel_launch: device query failed\n"); grid = -1; return; }
        if (hipFuncSetAttribute((const void*)mk_fwd, hipFuncAttributeMaxDynamicSharedMemorySize, LDS_BYTES) != hipSuccess) { fprintf(stderr, "kernel_launch: hipFuncSetAttribute failed\n"); grid = -1; return; }
        if (hipOccupancyMaxActiveBlocksPerMultiprocessor(&per_cu, (const void*)mk_fwd, NWAVES * 64, LDS_BYTES) != hipSuccess || per_cu < 1) { fprintf(stderr, "kernel_launch: occupancy query says %d workgroups per CU; nothing launched\n", per_cu); (void)hipGetLastError(); grid = -1; return; }
        grid = cus;
    }
    if (grid < 0) return;
    if (hipMemsetAsync((char*)d_ws + WS_CTL, 0, CTL_ZERO_BYTES, stream) != hipSuccess) { fprintf(stderr, "kernel_launch: hipMemsetAsync failed\n"); return; }
    Args a{};
    for (int i = 0; i < 15; ++i) a.in[i] = (const float*)d_in[i];
    a.out = (float*)d_out; a.ws = (unsigned char*)d_ws;
    for (int li = 0; li < N_LAUNCHES; ++li) {
        a.ph_lo = (N_LAUNCHES == 1) ? 0 : li; a.ph_hi = (N_LAUNCHES == 1) ? N_PHASES : li + 1;
        for (int rep = 0; rep < ((N_LAUNCHES != 1 && li == REPEAT_PHASE) ? 2 : 1); ++rep) {
            a.rep = rep;
            hipLaunchKernelGGL(mk_fwd, dim3(grid), dim3(NWAVES * 64), LDS_BYTES, stream, a);
            const hipError_t le = hipPeekAtLastError();
            if (le != hipSuccess) { fprintf(stderr, "kernel_launch: launch %d failed: %s\n", li, hipGetErrorName(le)); return; }
        }
    }
}
```

```cpp
#include <hip/hip_runtime.h>
#include <cstdio>
#include <cstdint>
namespace pg8 {
#define PG8_LAS __attribute__((address_space(3)))
typedef unsigned short bf16_t;
typedef short bf16x8 __attribute__((ext_vector_type(8)));
typedef float f32x4 __attribute__((ext_vector_type(4)));
typedef unsigned u32x4 __attribute__((ext_vector_type(4)));
constexpr int BM = 256, BK = 64, HALF = 128, HTB = HALF * BK * 2  , STAGE_BYTES = 8 * HTB, NXCD = 8, WGM = 8;

__host__ __device__ __forceinline__ int lds_byte(int r, int c) { const int st = (r >> 4) * 2 + (c >> 5), rr = r & 15, cc = c & 31, ob = rr * 64 + cc * 2; return st * 1024 + (ob ^ (((ob >> 9) & 1) << 5)); }
__host__ __device__ __forceinline__ void stage_rc(int b, int& R, int& C) { const int st = b / 1024, sb = b % 1024, swz = sb ^ (((sb >> 9) & 1) << 5); R = (st >> 1) * 16 + swz / 64; C = (st & 1) * 32 + (swz % 64) / 2; }
__host__ __device__ __forceinline__ int perm32(int rho) { const int n = rho >> 4, i = rho & 15; return 8 * (i >> 2) + 4 * n + (i & 3); }

struct Unit { int pm, pn, pb, e; };
struct Gemm { const bf16_t* A; const bf16_t* Bt; int M, N, K; };

struct StaticOrder {
    int nM, nN, nwg, G, c, lim;
    __host__ __device__ void init(int M, int N, int G_, int c_) { nM = M / BM; nN = N / BM; nwg = nM * nN; G = G_; c = c_; lim = nwg; }
    __host__ __device__ bool next(int i, Unit& u) const {
        const long L = (long)i * G + c; if (L >= lim) return false;
        int wgid = (int)L; { const int q = nwg / NXCD, r = nwg % NXCD, xcd = wgid % NXCD, off = wgid / NXCD; wgid = (xcd < r ? xcd * (q + 1) : r * (q + 1) + (xcd - r) * q) + off; }
        const int nig = WGM * nN, gid = wgid / nig, fm = gid * WGM, gsz = (nM - fm) < WGM ? (nM - fm) : WGM;
        u.pm = fm + ((wgid % nig) % gsz); u.pn = (wgid % nig) / gsz; u.pb = u.pn; u.e = 0; return true;
    }
    __device__ __forceinline__ void a_ready(const Unit&) const {}
    __device__ __forceinline__ void done(const Unit&) const {}
    __device__ __forceinline__ int tok(const Unit&, int) const { return 0; }
};


__device__ __forceinline__ unsigned cvt_pk_bf16(float lo, float hi) { unsigned r; asm volatile("v_cvt_pk_bf16_f32 %0, %1, %2" : "=v"(r) : "v"(lo), "v"(hi)); return r; }
__device__ __forceinline__ float bf_lo(unsigned w) { return __uint_as_float(w << 16); }
__device__ __forceinline__ float bf_hi(unsigned w) { return __uint_as_float(w & 0xffff0000u); }
__device__ __forceinline__ float sigmoidf_(float x) { return 1.0f / (1.0f + __expf(-x)); }
__device__ __forceinline__ u32x4 pack8(const f32x4& v0, const f32x4& v1) { u32x4 w; w.x = cvt_pk_bf16(v0[0], v0[1]); w.y = cvt_pk_bf16(v0[2], v0[3]); w.z = cvt_pk_bf16(v1[0], v1[1]); w.w = cvt_pk_bf16(v1[2], v1[3]); return w; }
__device__ __forceinline__ void unpack8(const u32x4& w, f32x4& v0, f32x4& v1) { v0 = (f32x4){bf_lo(w.x), bf_hi(w.x), bf_lo(w.y), bf_hi(w.y)}; v1 = (f32x4){bf_lo(w.z), bf_hi(w.z), bf_lo(w.w), bf_hi(w.w)}; }

struct EpiProj {
    static constexpr bool PERM = true, AFTER_DRAIN = false;
    bf16_t* PROJ; float* SMALLF;
    __device__ __forceinline__ void operator()(const f32x4 (&acc)[2][2][4][2], const Unit& u, int wr, int wc, int fr, int fq) const {
        const int row0 = u.pm * BM + wr * 64 + fr, cl = wc * 32 + 8 * fq;
        if (u.pn < 18) {
            const int mode = (u.pn >= 10) ? 2 : ((u.pn == 4 || u.pn == 5) ? 1 : 0);
#pragma unroll
            for (int ai = 0; ai < 2; ++ai)
#pragma unroll
                for (int m = 0; m < 4; ++m) { bf16_t* rowp = PROJ + (size_t)(row0 + ai * HALF + m * 16) * 4608 + u.pn * BM + cl;
#pragma unroll
                    for (int bj = 0; bj < 2; ++bj) { f32x4 v0 = acc[ai][bj][m][0], v1 = acc[ai][bj][m][1];
                        if (mode == 1) { v0 = v0 * 0.125f; v1 = v1 * 0.125f; }
                        else if (mode == 2) {
#pragma unroll
                            for (int j = 0; j < 4; ++j) { v0[j] = sigmoidf_(v0[j]); v1[j] = sigmoidf_(v1[j]); } }
                        *(u32x4*)(rowp + bj * HALF) = pack8(v0, v1); } }
        } else {
#pragma unroll
            for (int ai = 0; ai < 2; ++ai)
#pragma unroll
                for (int m = 0; m < 4; ++m) { float* rowp = SMALLF + (size_t)(row0 + ai * HALF + m * 16) * 256 + cl;
#pragma unroll
                    for (int bj = 0; bj < 2; ++bj) { *(f32x4*)(rowp + bj * HALF) = acc[ai][bj][m][0]; *(f32x4*)(rowp + bj * HALF + 4) = acc[ai][bj][m][1]; } }
        }
    }
};
template <bool FIRST> struct EpiGate {
    static constexpr bool PERM = true, AFTER_DRAIN = false;
    const bf16_t* PROJ; int goff; bf16_t* MERGED;
    __device__ __forceinline__ void operator()(const f32x4 (&acc)[2][2][4][2], const Unit& u, int wr, int wc, int fr, int fq) const {
        const int row0 = u.pm * BM + wr * 64 + fr, col0 = u.pn * BM + wc * 32 + 8 * fq;
#pragma unroll
        for (int ai = 0; ai < 2; ++ai)
#pragma unroll
            for (int m = 0; m < 4; ++m) { const size_t row = (size_t)(row0 + ai * HALF + m * 16);
#pragma unroll
                for (int bj = 0; bj < 2; ++bj) { const int col = col0 + bj * HALF;
                    const u32x4 gw = *(const u32x4*)(PROJ + row * 4608 + goff + col); f32x4 g0, g1; unpack8(gw, g0, g1);
                    f32x4 v0 = acc[ai][bj][m][0] * g0, v1 = acc[ai][bj][m][1] * g1;
                    bf16_t* mp = MERGED + row * 1024 + col;
                    if (!FIRST) { const u32x4 pw = *(const u32x4*)mp; f32x4 p0, p1; unpack8(pw, p0, p1); v0 = v0 + p0; v1 = v1 + p1; }
                    *(u32x4*)mp = pack8(v0, v1); } }
    }
};
struct EpiOut {
    static constexpr bool PERM = true, AFTER_DRAIN = false;
    const float* X; float* OUT; float* SSQP;
    __device__ __forceinline__ void operator()(const f32x4 (&acc)[2][2][4][2], const Unit& u, int wr, int wc, int fr, int fq) const {
        const int row0 = u.pm * BM + wr * 64 + fr, col0 = u.pn * BM + wc * 32 + 8 * fq;
#pragma unroll
        for (int ai = 0; ai < 2; ++ai)
#pragma unroll
            for (int m = 0; m < 4; ++m) { const size_t row = (size_t)(row0 + ai * HALF + m * 16); float s = 0.f;
#pragma unroll
                for (int bj = 0; bj < 2; ++bj) { const size_t off = row * 1024 + col0 + bj * HALF;
                    const f32x4 x0 = *(const f32x4*)(X + off), x1 = *(const f32x4*)(X + off + 4);
                    const f32x4 h0 = x0 + acc[ai][bj][m][0], h1 = x1 + acc[ai][bj][m][1];
                    *(f32x4*)(OUT + off) = h0; *(f32x4*)(OUT + off + 4) = h1;
                    s += (h0[0] * h0[0] + h0[1] * h0[1]) + (h0[2] * h0[2] + h0[3] * h0[3]) + (h1[0] * h1[0] + h1[1] * h1[1]) + (h1[2] * h1[2] + h1[3] * h1[3]); }
                s += __shfl_xor(s, 16); s += __shfl_xor(s, 32);
                if (fq == 0) SSQP[row * 16 + u.pn * 4 + wc] = s; }
    }
};
struct EpiAct {
    static constexpr bool PERM = true, AFTER_DRAIN = false;
    const float* BGU; unsigned char* ACT;
    __device__ __forceinline__ void operator()(const f32x4 (&acc)[2][2][4][2], const Unit& u, int wr, int wc, int fr, int fq) const {
        const int row0 = u.pm * BM + wr * 64 + fr, j0 = u.pn * HALF + wc * 32 + 8 * fq;
        const float* bg = BGU + (size_t)u.e * 2048 + j0;
        const f32x4 bg0 = *(const f32x4*)bg, bg1 = *(const f32x4*)(bg + 4), bu0 = *(const f32x4*)(bg + 1024), bu1 = *(const f32x4*)(bg + 1028);
#pragma unroll
        for (int ai = 0; ai < 2; ++ai)
#pragma unroll
            for (int m = 0; m < 4; ++m) { f32x4 o[2];
#pragma unroll
                for (int n = 0; n < 2; ++n) { const f32x4 g = acc[ai][0][m][n] + (n ? bg1 : bg0), up = acc[ai][1][m][n] + (n ? bu1 : bu0);
#pragma unroll
                    for (int j = 0; j < 4; ++j) { const float gc = fminf(g[j], 7.0f), uc = fminf(fmaxf(up[j], -7.0f), 7.0f); o[n][j] = (uc + 1.0f) * gc * sigmoidf_(1.702f * gc); } }
                int p0 = __builtin_amdgcn_cvt_pk_fp8_f32(o[0][0], o[0][1], 0, false); p0 = __builtin_amdgcn_cvt_pk_fp8_f32(o[0][2], o[0][3], p0, true);
                int p1 = __builtin_amdgcn_cvt_pk_fp8_f32(o[1][0], o[1][1], 0, false); p1 = __builtin_amdgcn_cvt_pk_fp8_f32(o[1][2], o[1][3], p1, true);
                typedef int i32x2 __attribute__((ext_vector_type(2)));
                *(i32x2*)(ACT + (size_t)(row0 + ai * HALF + m * 16) * 1024 + j0) = (i32x2){p0, p1}; }
    }
};
struct EpiDown {
    static constexpr bool PERM = true, AFTER_DRAIN = false;
    const float* BD; unsigned char* Y;
    __device__ __forceinline__ void operator()(const f32x4 (&acc)[2][2][4][2], const Unit& u, int wr, int wc, int fr, int fq) const {
        const int row0 = u.pm * BM + wr * 64 + fr, col0 = u.pn * BM + wc * 32 + 8 * fq;
        f32x4 bv[2][2];
#pragma unroll
        for (int bj = 0; bj < 2; ++bj)
#pragma unroll
            for (int n = 0; n < 2; ++n) bv[bj][n] = *(const f32x4*)(BD + (size_t)u.e * 1024 + col0 + bj * HALF + 4 * n);
#pragma unroll
        for (int ai = 0; ai < 2; ++ai)
#pragma unroll
            for (int m = 0; m < 4; ++m) { unsigned char* rowp = Y + (size_t)(row0 + ai * HALF + m * 16) * 1024 + col0;
#pragma unroll
                for (int bj = 0; bj < 2; ++bj) { const f32x4 v0 = acc[ai][bj][m][0] + bv[bj][0], v1 = acc[ai][bj][m][1] + bv[bj][1];
                    int p0 = __builtin_amdgcn_cvt_pk_fp8_f32(v0[0], v0[1], 0, false); p0 = __builtin_amdgcn_cvt_pk_fp8_f32(v0[2], v0[3], p0, true);
                    int p1 = __builtin_amdgcn_cvt_pk_fp8_f32(v1[0], v1[1], 0, false); p1 = __builtin_amdgcn_cvt_pk_fp8_f32(v1[2], v1[3], p1, true);
                    typedef int i32x2 __attribute__((ext_vector_type(2)));
                    *(i32x2*)(rowp + bj * HALF) = (i32x2){p0, p1}; } }
    }
};
struct MoeOrder {
    const volatile PG8_LAS int* ts; const volatile PG8_LAS int* cnt; const int* LIST; int T, nN, nwg, G, c;
    __device__ void init(const volatile PG8_LAS int* ts_, const volatile PG8_LAS int* cnt_, const int* LIST_, int nN_, int G_, int c_) { ts = ts_; cnt = cnt_; LIST = LIST_; T = ts_[32]; nN = nN_; nwg = T * nN_; G = G_; c = c_; }
    __device__ __forceinline__ int tok(const Unit& u, int r) const { const int pos = 256 * (u.pm - ts[u.e]) + r; return pos < cnt[u.e] ? (LIST[(size_t)u.e * 16384 + pos] >> 2) : 0; }
    __device__ bool next(int i, Unit& u) const {
        const long L = (long)i * G + c; if (L >= nwg) return false;
        int wgid = (int)L; { const int q = nwg / NXCD, r = nwg % NXCD, xcd = wgid % NXCD, off = wgid / NXCD; wgid = (xcd < r ? xcd * (q + 1) : r * (q + 1) + (xcd - r) * q) + off; }
        const int nig = WGM * nN, gid = wgid / nig, fm = gid * WGM, gsz = (T - fm) < WGM ? (T - fm) : WGM;
        u.pm = fm + ((wgid % nig) % gsz); u.pn = (wgid % nig) / gsz;
        int e = 0; while (e < 31 && ts[e + 1] <= u.pm) ++e;
        u.e = e; u.pb = e * nN + u.pn; return true;
    }
    __device__ __forceinline__ void a_ready(const Unit&) const {}
    __device__ __forceinline__ void done(const Unit&) const {}
};

typedef int v4i_t __attribute__((ext_vector_type(4))); typedef int v8i_t __attribute__((ext_vector_type(8)));
__device__ __forceinline__ v8i_t cat8(bf16x8 a, bf16x8 b) { const v4i_t x = __builtin_bit_cast(v4i_t, a), y = __builtin_bit_cast(v4i_t, b); return __builtin_shufflevector(x, y, 0, 1, 2, 3, 4, 5, 6, 7); }
__device__ __forceinline__ void mfma_f8(f32x4& acc, const v8i_t& wfrag, const v8i_t& afrag) {
    asm volatile("s_nop 1\n\tv_mfma_scale_f32_16x16x128_f8f6f4 %0, %1, %2, %0, %3, %4 op_sel_hi:[0,0,0]" : "+v"(acc) : "v"(wfrag), "v"(afrag), "v"(0x7a7a7a7a), "v"(0x7f7f7f7f));
}
template <class Epi, class Sched, bool ALIGN_EPI = false, bool SP2 = false, bool FP8 = false, bool GATHER = false>
__device__ __forceinline__ void gemm_phase(PG8_LAS unsigned char* lds, const Gemm g, const Sched& S, const Epi& E, const int wave_id) {
    unsigned ones_ = ~0u; asm volatile("" : "+v"(ones_));
    const int wid = wave_id, tid = (int)__builtin_amdgcn_mbcnt_hi(ones_, __builtin_amdgcn_mbcnt_lo(ones_, 0u)) + 64 * wave_id, lane = tid & 63, wr = wid >> 2, wc = wid & 3, fr = lane & 15, fq = lane >> 4;
    const int K = g.K, nt = K / BK;
    unsigned voffA[2], voffB[2]; int stR[2], stC[2];
#pragma unroll
    for (int i = 0; i < 2; ++i) { int R, C; stage_rc(tid * 16 + i * 8192, R, C); const int Rb = Epi::PERM ? ((R & ~31) + perm32(R & 31)) : R;
        voffA[i] = (unsigned)(R * K + C) * 2u; voffB[i] = (unsigned)(Rb * K + C) * 2u; stR[i] = R; stC[i] = C; }
    const size_t kstep = (size_t)(BK * 2);
    const size_t hstep = (size_t)HALF * K * 2;
    const size_t tstep = 2 * hstep;
    const unsigned ldsw = (unsigned)wid * 1024u;
    const int aoff = lds_byte(wr * 64 + fr, fq * 8), boff = lds_byte(wc * 32 + fr, fq * 8);
#define PG8_SA(b, h) (((b) * 2 + (h)) * HTB)
#define PG8_SB(b, h) ((4 + (b) * 2 + (h)) * HTB)
#define PG8_STAGE(bufoff, gbase, voff) do { _Pragma("unroll") for (int _i = 0; _i < 2; ++_i) \
        __builtin_amdgcn_global_load_lds((const unsigned*)((const char*)(gbase) + (voff)[_i]), (PG8_LAS unsigned*)(lds + (bufoff) + ldsw + _i * 8192), 16, 0, 0); } while (0)
#define PG8_LDA(dst, b, h) do { _Pragma("unroll") for (int m = 0; m < 4; ++m) { _Pragma("unroll") for (int k = 0; k < 2; ++k) dst[m][k] = *(const PG8_LAS bf16x8*)(lds + PG8_SA(b, h) + aoff + m * 2048 + k * 1024); if constexpr (FP8) dst##8[m] = cat8(dst[m][0], dst[m][1]); } } while (0)
#define PG8_LDB(dst, b, h) do { _Pragma("unroll") for (int n = 0; n < 2; ++n) { _Pragma("unroll") for (int k = 0; k < 2; ++k) dst[n][k] = *(const PG8_LAS bf16x8*)(lds + PG8_SB(b, h) + boff + n * 2048 + k * 1024); if constexpr (FP8) dst##8[n] = cat8(dst[n][0], dst[n][1]); } } while (0)
#define PG8_MMA(ai, bj, At, Bt) do { __builtin_amdgcn_s_setprio(1); _Pragma("unroll") for (int m = 0; m < 4; ++m) _Pragma("unroll") for (int n = 0; n < 2; ++n) { \
        if constexpr (FP8) { mfma_f8(acc[ai][bj][m][n], Bt##8[n], At##8[m]); } \
        else { _Pragma("unroll") for (int k = 0; k < 2; ++k) acc[ai][bj][m][n] = __builtin_amdgcn_mfma_f32_16x16x32_bf16(Bt[n][k], At[m][k], acc[ai][bj][m][n], 0, 0, 0); } } \
        __builtin_amdgcn_s_setprio(0); } while (0)
#define PG8_WAIT_V(n) asm volatile("s_waitcnt vmcnt(" #n ")" ::: "memory")
#define PG8_WAIT_L(n) asm volatile("s_waitcnt lgkmcnt(" #n ")" ::: "memory")
#define PG8_BAR __builtin_amdgcn_s_barrier()
#define PG8_SCHED __builtin_amdgcn_sched_barrier(0)
    Unit cur, nxt; int ui = 0;
    if (!S.next(0, cur)) return;
    f32x4 acc[2][2][4][2];
#pragma unroll
    for (int a = 0; a < 2; ++a)
#pragma unroll
        for (int b = 0; b < 2; ++b)
#pragma unroll
            for (int m = 0; m < 4; ++m)
#pragma unroll
                for (int n = 0; n < 2; ++n) acc[a][b][m][n] = (f32x4){0.f, 0.f, 0.f, 0.f};
    bf16x8 At[4][2], B0[2][2], B1[2][2]; v8i_t At8[4], B08[2], B18[2];
    const char* cA = GATHER ? (const char*)g.A : (const char*)g.A + (size_t)cur.pm * tstep; const char* cB = (const char*)g.Bt + (size_t)cur.pb * tstep;
    unsigned vC[2][2], vN[2][2];
#define PG8_GROWS(V, u_) do { _Pragma("unroll") for (int h_ = 0; h_ < 2; ++h_) _Pragma("unroll") for (int i_ = 0; i_ < 2; ++i_) V[h_][i_] = (unsigned)S.tok(u_, 128 * h_ + stR[i_]) * (unsigned)(K * 2) + (unsigned)stC[i_] * 2u; } while (0)
    if constexpr (GATHER) { PG8_GROWS(vC, cur); }
    else {
#pragma unroll
        for (int h_ = 0; h_ < 2; ++h_)
#pragma unroll
            for (int i_ = 0; i_ < 2; ++i_) vC[h_][i_] = voffA[i_] + (unsigned)(h_ * hstep); }
#pragma unroll
    for (int h_ = 0; h_ < 2; ++h_)
#pragma unroll
        for (int i_ = 0; i_ < 2; ++i_) vN[h_][i_] = vC[h_][i_];
    S.a_ready(cur);
    if constexpr (SP2) {
        PG8_STAGE(PG8_SB(0, 0), cB, voffB); PG8_STAGE(PG8_SB(0, 1), cB + hstep, voffB); PG8_STAGE(PG8_SA(0, 0), cA, vC[0]); PG8_STAGE(PG8_SA(0, 1), cA, vC[1]);
        if (wr == 1) PG8_BAR;
        PG8_WAIT_V(2); PG8_BAR;
        PG8_STAGE(PG8_SB(1, 0), cB + kstep, voffB); PG8_STAGE(PG8_SA(1, 0), cA + kstep, vC[0]); PG8_STAGE(PG8_SB(1, 1), cB + hstep + kstep, voffB);
        PG8_WAIT_V(6); PG8_BAR;
    } else {
        PG8_STAGE(PG8_SB(0, 0), cB, voffB); PG8_STAGE(PG8_SA(0, 0), cA, vC[0]); PG8_STAGE(PG8_SB(0, 1), cB + hstep, voffB); PG8_STAGE(PG8_SA(0, 1), cA, vC[1]);
        if (wr == 1) PG8_BAR;
        PG8_WAIT_V(4); PG8_BAR;
        PG8_STAGE(PG8_SB(1, 0), cB + kstep, voffB); PG8_STAGE(PG8_SA(1, 0), cA + kstep, vC[0]); PG8_STAGE(PG8_SB(1, 1), cB + hstep + kstep, voffB);
        PG8_WAIT_V(6); PG8_BAR;
    }
    for (;;) {
        const bool has_next = S.next(ui + 1, nxt);
        if constexpr (GATHER) { if (has_next) { PG8_GROWS(vN, nxt); } }
        const char* nA = has_next ? (GATHER ? (const char*)g.A : (const char*)g.A + (size_t)nxt.pm * tstep) : cA; const char* nB = has_next ? (const char*)g.Bt + (size_t)nxt.pb * tstep : cB;
        for (int t = 0; t < nt; t += 2) {
            const bool last = (t == nt - 2);
            const char* a1 = cA + (size_t)(t + 1) * kstep;
            const char* a2 = last ? nA : cA + (size_t)(t + 2) * kstep; const char* b2 = last ? nB : cB + (size_t)(t + 2) * kstep;
            const char* a3 = a2 + kstep; const char* b3 = b2 + kstep;
            unsigned vS[2][2];
#pragma unroll
            for (int h_ = 0; h_ < 2; ++h_)
#pragma unroll
                for (int i_ = 0; i_ < 2; ++i_) vS[h_][i_] = (GATHER && last) ? vN[h_][i_] : vC[h_][i_];
            if (last && has_next) S.a_ready(nxt);
            if constexpr (SP2) {
            PG8_LDB(B0, 0, 0); PG8_LDB(B1, 0, 1); PG8_SCHED; PG8_LDA(At, 0, 0); PG8_STAGE(PG8_SA(1, 1), a1, vC[1]);
            PG8_WAIT_V(8); PG8_WAIT_L(0); PG8_BAR; PG8_MMA(0, 0, At, B0); PG8_MMA(0, 1, At, B1); PG8_BAR; PG8_SCHED;
            PG8_LDA(At, 0, 1); PG8_STAGE(PG8_SB(0, 0), b2, voffB); PG8_STAGE(PG8_SB(0, 1), b2 + hstep, voffB); PG8_STAGE(PG8_SA(0, 0), a2, vS[0]);
            PG8_WAIT_V(8); PG8_WAIT_L(0); PG8_BAR; PG8_MMA(1, 0, At, B0); PG8_MMA(1, 1, At, B1); PG8_BAR; PG8_SCHED;
            PG8_LDB(B0, 1, 0); PG8_LDB(B1, 1, 1); PG8_SCHED; PG8_LDA(At, 1, 0); PG8_STAGE(PG8_SA(0, 1), a2, vS[1]);
            PG8_WAIT_V(8); PG8_WAIT_L(0); PG8_BAR; PG8_MMA(0, 0, At, B0); PG8_MMA(0, 1, At, B1); PG8_BAR; PG8_SCHED;
            PG8_LDA(At, 1, 1); PG8_STAGE(PG8_SB(1, 0), b3, voffB); PG8_STAGE(PG8_SB(1, 1), b3 + hstep, voffB); PG8_STAGE(PG8_SA(1, 0), a3, vS[0]);
            PG8_WAIT_V(8); PG8_WAIT_L(0); PG8_BAR; PG8_MMA(1, 0, At, B0); PG8_MMA(1, 1, At, B1); PG8_BAR; PG8_SCHED;
            } else {
            PG8_LDB(B0, 0, 0); PG8_SCHED; PG8_LDA(At, 0, 0); PG8_STAGE(PG8_SA(1, 1), a1, vC[1]);
            PG8_WAIT_L(8); PG8_BAR; PG8_WAIT_L(0); PG8_MMA(0, 0, At, B0); PG8_BAR; PG8_SCHED;
            PG8_LDB(B1, 0, 1); PG8_STAGE(PG8_SB(0, 0), b2, voffB);
            PG8_BAR; PG8_WAIT_L(0); PG8_MMA(0, 1, At, B1); PG8_BAR;
            PG8_LDA(At, 0, 1); PG8_STAGE(PG8_SA(0, 0), a2, vS[0]);
            PG8_BAR; PG8_WAIT_L(0); PG8_MMA(1, 0, At, B0); PG8_BAR; PG8_SCHED;
            PG8_STAGE(PG8_SB(0, 1), b2 + hstep, voffB);
            PG8_WAIT_V(6); PG8_BAR; PG8_MMA(1, 1, At, B1); PG8_BAR;
            PG8_LDB(B0, 1, 0); PG8_SCHED; PG8_LDA(At, 1, 0); PG8_STAGE(PG8_SA(0, 1), a2, vS[1]);
            PG8_WAIT_L(8); PG8_BAR; PG8_WAIT_L(0); PG8_MMA(0, 0, At, B0); PG8_BAR; PG8_SCHED;
            PG8_LDB(B1, 1, 1); PG8_STAGE(PG8_SB(1, 0), b3, voffB);
            PG8_BAR; PG8_WAIT_L(0); PG8_MMA(0, 1, At, B1); PG8_BAR;
            PG8_LDA(At, 1, 1); PG8_STAGE(PG8_SA(1, 0), a3, vS[0]);
            PG8_BAR; PG8_WAIT_L(0); PG8_MMA(1, 0, At, B0); PG8_BAR; PG8_SCHED;
            PG8_STAGE(PG8_SB(1, 1), b3 + hstep, voffB);
            PG8_WAIT_V(6); PG8_BAR; PG8_MMA(1, 1, At, B1); PG8_BAR;
            }
        }
        if constexpr (FP8) asm volatile("s_nop 15\n\ts_nop 15" ::: "memory");
        if constexpr (ALIGN_EPI) { if (wr == 0) PG8_BAR; }
        if constexpr (!Epi::AFTER_DRAIN) { E(acc, cur, wr, wc, fr, fq); S.done(cur); }
        if (!has_next) break;
#pragma unroll
        for (int a = 0; a < 2; ++a)
#pragma unroll
            for (int b = 0; b < 2; ++b)
#pragma unroll
                for (int m = 0; m < 4; ++m)
#pragma unroll
                    for (int n = 0; n < 2; ++n) acc[a][b][m][n] = (f32x4){0.f, 0.f, 0.f, 0.f};
        cur = nxt; cA = nA; cB = nB; ++ui;
        if constexpr (GATHER) {
#pragma unroll
            for (int h_ = 0; h_ < 2; ++h_)
#pragma unroll
                for (int i_ = 0; i_ < 2; ++i_) vC[h_][i_] = vN[h_][i_]; }
        if constexpr (ALIGN_EPI) { if (wr == 1) PG8_BAR; }
    }
    PG8_WAIT_V(0);
    if constexpr (!ALIGN_EPI) { if (wr == 0) PG8_BAR; }
    PG8_BAR;
    if constexpr (Epi::AFTER_DRAIN) { E.fused(acc, cur, wr, wc, fr, fq, lds, wid, lane); S.done(cur); }
#undef PG8_GROWS
#undef PG8_SA
#undef PG8_SB
#undef PG8_STAGE
#undef PG8_LDA
#undef PG8_LDB
#undef PG8_MMA
#undef PG8_WAIT_V
#undef PG8_WAIT_L
#undef PG8_BAR
#undef PG8_SCHED
}
}

constexpr int NWAVES = 8;
#ifndef MK_N_LAUNCHES
#define MK_N_LAUNCHES 1
#endif
constexpr int N_PHASES = 11;
constexpr int N_LAUNCHES = MK_N_LAUNCHES;

constexpr int NB = 4, SEQ = 4096, DM = 1024, NTOK = NB * SEQ;
constexpr int NPROJ = 4808, NPROJ_PAD = 4864, PROJ_LD = 4608;
constexpr int NEXP = 32, MAXTILES = 288;
constexpr float RMS_EPS = 1e-6f;

constexpr size_t MiB = 1u << 20;
constexpr size_t WS_CTL = 0, CTL_ZERO_BYTES = 1 * MiB;
constexpr size_t WS_WI = 2 * MiB, WS_WPA = 12 * MiB, WS_WPB = 13 * MiB, WS_WO = 14 * MiB, WS_WGU = 16 * MiB, WS_WD = 144 * MiB;
constexpr size_t WS_XN = 208 * MiB, WS_PROJ = 240 * MiB, WS_SMALLF = 384 * MiB, WS_KA = 400 * MiB, WS_VA = 402 * MiB, WS_KI = 404 * MiB, WS_WIQ = 406 * MiB;
constexpr size_t WS_OA = 408 * MiB, WS_OB = 424 * MiB, WS_MERGED = 440 * MiB, WS_SSQP = 472 * MiB;
constexpr size_t WS_TOKE = 473 * MiB, WS_TOKG = WS_TOKE + 256 * 1024, WS_TOKP = WS_TOKG + 256 * 1024, WS_LIST = 474 * MiB;
constexpr size_t WS_WRG = 478 * MiB;
constexpr size_t WS_ROPE = 479 * MiB;
constexpr size_t WS_XG = 480 * MiB, WS_ACT = 624 * MiB, WS_Y = 768 * MiB, WS_END = 912 * MiB;
constexpr int CW_TMO = 0, CW_CODE = 1;
constexpr int CW_BAR = 4096;
constexpr int CW_CNT = 8192;
constexpr int CW_QUEUE = 8448;
constexpr int CW_WDQ = 8576;
constexpr int RING_OFF = 0, RING_BYTES = 131072;
constexpr int IDX_OFF = 131072;
constexpr int HIST_OFF = 139264;
constexpr int LDSCTL_OFF = 155648, MISC_OFF = LDSCTL_OFF + 320;
constexpr int LDS_BYTES = 159744;
constexpr int MI_BAR = 8, MI_TS = 16  , MI_CNT = 64  , MI_Q = 100, MI_STAMP = 104  ;

#define GAS __attribute__((address_space(1)))
#define LAS __attribute__((address_space(3)))
typedef unsigned short bf16;
typedef unsigned v4u __attribute__((ext_vector_type(4)));
typedef float f32x4 __attribute__((ext_vector_type(4)));
typedef short bf16x8 __attribute__((ext_vector_type(8)));
typedef GAS unsigned gu32;
typedef GAS unsigned long long gu64;
#define RLX_AGENT __ATOMIC_RELAXED, __HIP_MEMORY_SCOPE_AGENT
#define LDS_WAIT() asm volatile("s_waitcnt lgkmcnt(0)" ::: "memory")
#define VM_WAIT() asm volatile("s_waitcnt vmcnt(0)" ::: "memory")
__device__ __forceinline__ unsigned long long rt() { return __builtin_amdgcn_s_memrealtime(); }
__device__ __forceinline__ unsigned f2bf(float f) { unsigned u = __builtin_bit_cast(unsigned, f); return (u + 0x7fffu + ((u >> 16) & 1u)) >> 16; }
__device__ __forceinline__ unsigned pk2(float lo, float hi) { return f2bf(lo) | (f2bf(hi) << 16); }

#define XB_TMO      128
#define XB_XCNT(j)  (256  + 64 * (j))
#define XB_XSUB(j)  (1280 + 64 * (j))
#define XB_XGEN(j)  (2304 + 64 * (j))
#define XB_TOP      3328
#define XB_TOPGEN   3392
#define XCD_BAR_WORDS 3456
#define XB_SPIN_CAP (1u << 18)

__device__ __forceinline__ unsigned xb_ld(unsigned* p)              { return __hip_atomic_load(p, __ATOMIC_RELAXED, __HIP_MEMORY_SCOPE_AGENT); }
__device__ __forceinline__ unsigned xb_add(unsigned* p, unsigned v) { return __hip_atomic_fetch_add(p, v, __ATOMIC_RELAXED, __HIP_MEMORY_SCOPE_AGENT); }
__device__ __forceinline__ unsigned xb_xcc_id() { return (unsigned)__builtin_amdgcn_s_getreg((3 << 11) | 20) & 0xFu; }
#define XB_SPIN(cond, bar) do { unsigned _sp = 0; while (cond) { __builtin_amdgcn_s_sleep(1); \
    if ((++_sp & 255u) == 0u) { if (xb_ld(&(bar)[XB_TMO])) break; if (_sp > XB_SPIN_CAP) { atomicAdd(&(bar)[XB_TMO], 1u); break; } } } } while (0)

struct XcdBarrier {
    unsigned* bar; unsigned x;
    volatile LAS unsigned* st;
};

__device__ __forceinline__ XcdBarrier xcd_barrier_post(unsigned* bar, volatile LAS unsigned* st) {
    XcdBarrier b; b.bar = bar; b.x = xb_xcc_id(); b.st = st;
    if (threadIdx.x == 0) (void)xb_add(&bar[XB_XCNT(b.x)], 1u);
    return b;
}
__device__ __forceinline__ void xcd_barrier_complete(unsigned* bar, unsigned x, unsigned& nloc, unsigned& nx) {
    const unsigned G = gridDim.x * gridDim.y * gridDim.z;
    unsigned sum, cnt, mine, sp = 0u;
    for (;;) {
        sum = 0u; cnt = 0u; mine = 0u;
#pragma unroll
        for (unsigned j = 0; j < 16; ++j) { const unsigned c = xb_ld(&bar[XB_XCNT(j)]); sum += c; cnt += (c > 0u) ? 1u : 0u; mine = (j == x) ? c : mine; }
        if (sum == G) break;
        __builtin_amdgcn_s_sleep(1);
        if ((++sp & 255u) == 0u) { if (xb_ld(&bar[XB_TMO])) break; if (sp > XB_SPIN_CAP) { atomicAdd(&bar[XB_TMO], 1u); break; } }
    }
    nloc = mine > 0u ? mine : 1u; nx = cnt > 0u ? cnt : 1u;
}

__device__ __forceinline__ void xcd_barrier(const XcdBarrier& b, const bool lead  ) {
    asm volatile("s_waitcnt vmcnt(0)" ::: "memory");
    __syncthreads();
    if (lead) {
        unsigned* bar = b.bar;
        __builtin_amdgcn_s_waitcnt(0);
        unsigned nloc = b.st[0], nx = b.st[1];
        if (nloc == 0u) { xcd_barrier_complete(bar, b.x, nloc, nx); b.st[0] = nloc; b.st[1] = nx; }
        const unsigned old = xb_add(&bar[XB_XSUB(b.x)], 1u);
        const unsigned gen = old / nloc;
        if (old + 1u == (gen + 1u) * nloc) {
            __builtin_amdgcn_fence(__ATOMIC_RELEASE, "agent");
            asm volatile("s_waitcnt vmcnt(0)" ::: "memory");
            const unsigned og = xb_add(&bar[XB_TOP], 1u);
            const unsigned tg = og / nx;
            if (og + 1u == (tg + 1u) * nx) xb_add(&bar[XB_TOPGEN], 1u);
            else XB_SPIN(xb_ld(&bar[XB_TOPGEN]) == tg, bar);
            __builtin_amdgcn_fence(__ATOMIC_ACQUIRE, "agent");
            xb_add(&bar[XB_XGEN(b.x)], 1u);
            asm volatile("s_waitcnt vmcnt(0)" ::: "memory");
        } else {
            XB_SPIN(xb_ld(&bar[XB_XGEN(b.x)]) == gen, bar);
            __builtin_amdgcn_fence(__ATOMIC_ACQUIRE, "agent");
            asm volatile("s_waitcnt vmcnt(0)" ::: "memory");
        }
    }
    __syncthreads();
}


__device__ __forceinline__ float bf2f(unsigned short b) { return __uint_as_float((unsigned)b << 16); }
__device__ __forceinline__ float bflo(unsigned w) { return __uint_as_float(w << 16); }
__device__ __forceinline__ float bfhi(unsigned w) { return __uint_as_float(w & 0xffff0000u); }

struct Args { const float* in[15]; float* out; unsigned char* ws; int ph_lo, ph_hi, rep, pad; };
struct Frame {
    const Args* a;
    LAS unsigned char* lds;
    volatile LAS unsigned* MISC;
    gu32* ctl;
    int tid, lane, wave;
    int G;
};
#define WSP(T, off) ((T*)((F.a->ws) + (off)))
#define F_WI WSP(bf16, WS_WI)
#define F_WPA WSP(bf16, WS_WPA)
#define F_WPB WSP(bf16, WS_WPB)
#define F_WO WSP(bf16, WS_WO)
#define F_WGU WSP(bf16, WS_WGU)
#define F_WD WSP(bf16, WS_WD)
#define F_XN WSP(bf16, WS_XN)
#define F_PROJ WSP(bf16, WS_PROJ)
#define F_KA WSP(bf16, WS_KA)
#define F_VA WSP(bf16, WS_VA)
#define F_KI WSP(bf16, WS_KI)
#define F_OA WSP(bf16, WS_OA)
#define F_OB WSP(bf16, WS_OB)
#define F_MERGED WSP(bf16, WS_MERGED)
#define F_XG WSP(bf16, WS_XG)
#define F_ACT WSP(bf16, WS_ACT)
#define F_Y WSP(bf16, WS_Y)
#define F_SMALLF WSP(float, WS_SMALLF)
#define F_WIQ WSP(float, WS_WIQ)
#define F_SSQP WSP(float, WS_SSQP)
#define F_TOKG WSP(float, WS_TOKG)
#define F_TOKE WSP(int, WS_TOKE)
#define F_TOKP WSP(int, WS_TOKP)
#define F_LIST WSP(int, WS_LIST)
#define F_WRG WSP(float, WS_WRG)
#define F_ROPE WSP(float, WS_ROPE)

__device__ __forceinline__ int fresh_lane() { unsigned ones_ = ~0u; asm volatile("" : "+v"(ones_)); return (int)__builtin_amdgcn_mbcnt_hi(ones_, __builtin_amdgcn_mbcnt_lo(ones_, 0u)); }
__device__ __forceinline__ float wave_sum(float v) {
#pragma unroll
    for (int o = 1; o < 64; o <<= 1) v += __shfl_xor(v, o);
    return v;
}
__device__ __forceinline__ float wave_max(float v) {
#pragma unroll
    for (int o = 1; o < 64; o <<= 1) v = fmaxf(v, __shfl_xor(v, o));
    return v;
}

__device__ __forceinline__ int wi_rowmap(int n) {
    if (n < 512) return n;
    if (n < 576) return 4608 + (n - 512);
    if (n < 640) return 4672 + (n - 576);
    if (n < 1152) return 512 + (n - 640);
    if (n < 1216) return 4736 + (n - 1152);
    if (n < 1224) return 4800 + (n - 1216);
    if (n < 1736) return 1024 + (n - 1224);
    if (n < 2248) return 1536 + (n - 1736);
    if (n < 2760) return 2048 + (n - 2248);
    if (n < 3784) return 2560 + (n - 2760);
    return 3584 + (n - 3784);
}
template <int MAP> __device__ __forceinline__ void transpose_item(const float* W, int K, int N, bf16* WT, int row_base, LAS float* scr, int item, int lane) {
    const int nblk = (N + 31) / 32, kb = item / nblk, nb = item % nblk, k0 = 64 * kb, n0 = 32 * nb;
    const int nsrc = n0 + (lane & 31); const bool ok = nsrc < N; const int ncl = ok ? nsrc : 0;
#pragma unroll 8
    for (int i = 0; i < 32; ++i) { const int kk = 2 * i + (lane >> 5); const float v = W[(size_t)(k0 + kk) * N + ncl]; scr[kk * 33 + (lane & 31)] = v; }
    LDS_WAIT(); asm volatile("" ::: "memory");
    const int c = lane & 7;
#pragma unroll
    for (int j = 0; j < 4; ++j) { const int nl = (lane >> 3) + 8 * j, n = n0 + nl; const LAS float* s = scr + (8 * c) * 33 + nl;
        if (n < N) { int dr;
            if (MAP == 0) dr = n; else if (MAP == 1) dr = wi_rowmap(n); else { const int jj = n & 1023; dr = 256 * (jj >> 7) + 128 * (n >> 10) + (jj & 127); }
            v4u o; o.x = pk2(s[0 * 33], s[1 * 33]); o.y = pk2(s[2 * 33], s[3 * 33]); o.z = pk2(s[4 * 33], s[5 * 33]); o.w = pk2(s[6 * 33], s[7 * 33]);
            *(GAS v4u*)(WT + (size_t)(row_base + dr) * K + k0 + 8 * c) = o; } }
    LDS_WAIT(); asm volatile("" ::: "memory");
}
template <int MAP> __device__ __forceinline__ void transpose_item_f8(const float* W, int K, int N, unsigned char* WT, int row_base, LAS float* scr, int item, int lane, float scale) {
    const int nblk = (N + 31) / 32, kb = item / nblk, nb = item % nblk, k0 = 64 * kb, n0 = 32 * nb;
    const int nsrc = n0 + (lane & 31); const bool ok = nsrc < N; const int ncl = ok ? nsrc : 0;
#pragma unroll 8
    for (int i = 0; i < 32; ++i) { const int kk = 2 * i + (lane >> 5); const float v = W[(size_t)(k0 + kk) * N + ncl]; scr[kk * 33 + (lane & 31)] = v; }
    LDS_WAIT(); asm volatile("" ::: "memory");
    const int c = lane & 7;
#pragma unroll
    for (int j = 0; j < 4; ++j) { const int nl = (lane >> 3) + 8 * j, n = n0 + nl; const LAS float* s = scr + (8 * c) * 33 + nl;
        if (n < N) { int dr;
            if (MAP == 0) dr = n; else { const int jj = n & 1023; dr = 256 * (jj >> 7) + 128 * (n >> 10) + (jj & 127); }
            int lo = __builtin_amdgcn_cvt_pk_fp8_f32(s[0 * 33] * scale, s[1 * 33] * scale, 0, false); lo = __builtin_amdgcn_cvt_pk_fp8_f32(s[2 * 33] * scale, s[3 * 33] * scale, lo, true);
            int hi = __builtin_amdgcn_cvt_pk_fp8_f32(s[4 * 33] * scale, s[5 * 33] * scale, 0, false); hi = __builtin_amdgcn_cvt_pk_fp8_f32(s[6 * 33] * scale, s[7 * 33] * scale, hi, true);
            typedef int i32x2 __attribute__((ext_vector_type(2)));
            *(GAS i32x2*)(WT + (size_t)(row_base + dr) * K + k0 + 8 * c) = (i32x2){lo, hi}; } }
    LDS_WAIT(); asm volatile("" ::: "memory");
}
template <int MAP> __device__ __forceinline__ void convert_item_f8(const float* W, int K, int N, unsigned char* WT, int row_base, LAS unsigned char* tile, int item, int lane, float scale) {
    const int nblk = N / 64, kb = item / nblk, nb = item % nblk, k0 = 128 * kb, n0 = 64 * nb, ng = lane & 15, ko = lane >> 4;
    const float* src = W + (size_t)(k0 + 8 * ko) * N + n0 + 4 * ng;
    typedef int i32x2 __attribute__((ext_vector_type(2)));
#pragma unroll
    for (int q = 0; q < 4; ++q) {
        f32x4 v[8];
#pragma unroll
        for (int k = 0; k < 8; ++k) v[k] = *(const GAS f32x4*)(src + (size_t)(32 * q + k) * N);
#pragma unroll
        for (int j = 0; j < 4; ++j) {
            int lo = __builtin_amdgcn_cvt_pk_fp8_f32(v[0][j] * scale, v[1][j] * scale, 0, false); lo = __builtin_amdgcn_cvt_pk_fp8_f32(v[2][j] * scale, v[3][j] * scale, lo, true);
            int hi = __builtin_amdgcn_cvt_pk_fp8_f32(v[4][j] * scale, v[5][j] * scale, 0, false); hi = __builtin_amdgcn_cvt_pk_fp8_f32(v[6][j] * scale, v[7][j] * scale, hi, true);
            *(LAS i32x2*)(tile + (4 * ng + j) * 144 + 32 * q + 8 * ko) = (i32x2){lo, hi}; }
    }
    LDS_WAIT(); asm volatile("" ::: "memory");
#pragma unroll
    for (int i = 0; i < 8; ++i) { const int rl = (lane >> 3) + 8 * i, n = n0 + rl; int dr; if (MAP == 0) dr = n; else { const int jj = n & 1023; dr = 256 * (jj >> 7) + 128 * (n >> 10) + (jj & 127); }
        const v4u w = *(const LAS v4u*)(tile + rl * 144 + 16 * (lane & 7));
        *(GAS v4u*)(WT + (size_t)(row_base + dr) * K + k0 + 16 * (lane & 7)) = w; }
    LDS_WAIT(); asm volatile("" ::: "memory");
}
template <int MAP> __device__ __forceinline__ void convert_stream_f8(const float* Wall, int N, int items_per_e, unsigned char* WT, LAS unsigned char* tile, int first, int stride, int end, int lane, float scale) {
    if (first >= end) return;
    const int ng = lane & 15, ko = lane >> 4, nblk = N / 64;
    typedef int i32x2 __attribute__((ext_vector_type(2)));
    f32x4 v[4][8];
    { const int e = first / items_per_e, item = first % items_per_e, kb = item / nblk, nb = item % nblk;
      const float* src = Wall + (size_t)e * 1024 * N + (size_t)(128 * kb + 8 * ko) * N + 64 * nb + 4 * ng;
#pragma unroll
      for (int q = 0; q < 4; ++q)
#pragma unroll
          for (int k = 0; k < 8; ++k) v[q][k] = __builtin_nontemporal_load((const GAS f32x4*)(src + (size_t)(32 * q + k) * N)); }
#pragma unroll 1
    for (int r = first; r < end; r += stride) {
        const int rn = r + stride; const bool hn = rn < end; const int rr = hn ? rn : r;
        const int en = rr / items_per_e, itn = rr % items_per_e;
        const float* nsrc = Wall + (size_t)en * 1024 * N + (size_t)(128 * (itn / nblk) + 8 * ko) * N + 64 * (itn % nblk) + 4 * ng;
#pragma unroll
        for (int q = 0; q < 4; ++q) {
#pragma unroll
            for (int j = 0; j < 4; ++j) {
                int lo = __builtin_amdgcn_cvt_pk_fp8_f32(v[q][0][j] * scale, v[q][1][j] * scale, 0, false); lo = __builtin_amdgcn_cvt_pk_fp8_f32(v[q][2][j] * scale, v[q][3][j] * scale, lo, true);
                int hi = __builtin_amdgcn_cvt_pk_fp8_f32(v[q][4][j] * scale, v[q][5][j] * scale, 0, false); hi = __builtin_amdgcn_cvt_pk_fp8_f32(v[q][6][j] * scale, v[q][7][j] * scale, hi, true);
                *(LAS i32x2*)(tile + (4 * ng + j) * 144 + 32 * q + 8 * ko) = (i32x2){lo, hi}; }
            if (hn) {
#pragma unroll
                for (int k = 0; k < 8; ++k) v[q][k] = __builtin_nontemporal_load((const GAS f32x4*)(nsrc + (size_t)(32 * q + k) * N)); }
        }
        LDS_WAIT(); asm volatile("" ::: "memory");
        const int e = r / items_per_e, item = r % items_per_e, k0 = 128 * (item / nblk), n0 = 64 * (item % nblk);
#pragma unroll
        for (int i = 0; i < 8; ++i) { const int rl = (lane >> 3) + 8 * i, n = n0 + rl; int dr; if (MAP == 0) dr = n; else { const int jj = n & 1023; dr = 256 * (jj >> 7) + 128 * (n >> 10) + (jj & 127); }
            const v4u w = *(const LAS v4u*)(tile + rl * 144 + 16 * (lane & 7));
            *(GAS v4u*)(WT + (size_t)(e * N + dr) * 1024 + k0 + 16 * (lane & 7)) = w; }
        LDS_WAIT(); asm volatile("" ::: "memory");
    }
}
constexpr int I_GU = 8 * 32, I_D = 8 * 16, NMOE_ITEMS = NEXP * (I_GU + I_D);
#ifndef MOE_P1_ITEMS
#define MOE_P1_ITEMS (NEXP * I_GU)
#endif
__device__ __forceinline__ void moe_item(Frame& F, int r, LAS float* scr) {
    if (r < NEXP * I_GU) { const int e = r / I_GU; convert_item_f8<2>((F.a->in[11]) + (size_t)e * 1024 * 2048, 1024, 2048, (unsigned char*)F_WGU, e * 2048, (LAS unsigned char*)scr, r % I_GU, F.lane, 32.0f); return; }
    r -= NEXP * I_GU;
    { const int e = r / I_D; convert_item_f8<0>((F.a->in[13]) + (size_t)e * 1024 * 1024, 1024, 1024, (unsigned char*)F_WD, e * 1024, (LAS unsigned char*)scr, r % I_D, F.lane, 32.0f); }
}
__device__ __forceinline__ void p1_convert(Frame& F, int cc, int NC, int moe_hi) {
    LAS unsigned char* scr = (LAS unsigned char*)(F.lds + RING_OFF + F.wave * 16384);
    const int w = cc * NWAVES + F.wave, nw = NC * NWAVES;
    const int hi_gu = moe_hi < NEXP * I_GU ? moe_hi : NEXP * I_GU, hi_d = moe_hi - NEXP * I_GU;
    convert_stream_f8<2>((F.a->in[11]), 2048, I_GU, (unsigned char*)F_WGU, scr, w, nw, hi_gu, F.lane, 32.0f);
    convert_stream_f8<0>((F.a->in[13]), 1024, I_D, (unsigned char*)F_WD, scr, w, nw, hi_d, F.lane, 32.0f);
}
__device__ __forceinline__ void p8_convert_wd(Frame& F, int rep) {
    LAS float* scr = (LAS float*)(F.lds + RING_OFF + F.wave * 16384);
    gu32* q = F.ctl + CW_WDQ + 64 * rep;
    unsigned nxt = 0u; if (F.lane == 0) nxt = __hip_atomic_fetch_add(q, 1u, RLX_AGENT);
    nxt = (unsigned)__builtin_amdgcn_readfirstlane((int)nxt);
    while (nxt < (unsigned)(NEXP * I_D)) {
        const int cur = (int)nxt;
        unsigned t = 0u; if (F.lane == 0) t = __hip_atomic_fetch_add(q, 1u, RLX_AGENT);
        moe_item(F, NEXP * I_GU + cur, scr);
        nxt = (unsigned)__builtin_amdgcn_readfirstlane((int)t);
    }
}
__device__ __forceinline__ void p0_prologue(Frame& F, int moe_lo) {
    LAS float* scr = (LAS float*)(F.lds + RING_OFF + F.wave * 16384);
    const int gw = blockIdx.x * NWAVES + F.wave, NGW = F.G * NWAVES;
    constexpr int I_WI = 16 * 151, I_PA = 8 * 32, I_WO = 16 * 32;
    constexpr int NITEMS = I_WI + 2 * I_PA + I_WO + NMOE_ITEMS;
    for (int it = moe_lo + gw; it < NITEMS; it += NGW) {
        int r = it;
        if (r < NMOE_ITEMS) { if (r < NEXP * I_GU) moe_item(F, r, scr); continue; } r -= NMOE_ITEMS;
        if (r < I_WI) { transpose_item<1>((F.a->in[2]), 1024, NPROJ, F_WI, 0, scr, r, F.lane); continue; } r -= I_WI;
        if (r < I_PA) { transpose_item<0>((F.a->in[5]), 512, 1024, F_WPA, 0, scr, r, F.lane); continue; } r -= I_PA;
        if (r < I_PA) { transpose_item<0>((F.a->in[6]), 512, 1024, F_WPB, 0, scr, r, F.lane); continue; } r -= I_PA;
        transpose_item<0>((F.a->in[7]), 1024, 1024, F_WO, 0, scr, r, F.lane);
    }
    { const int gt = blockIdx.x * (NWAVES * 64) + F.tid; if (gt < 7168) { v4u z = {0u, 0u, 0u, 0u}; *((GAS v4u*)(F_WI + (size_t)NPROJ * 1024) + gt) = z; } }
    { const int gt = blockIdx.x * (NWAVES * 64) + F.tid; if (gt < 1024 * 32) F_WRG[gt] = (F.a->in[8])[gt >> 5] * (F.a->in[9])[gt]; }
    { const int gt = blockIdx.x * (NWAVES * 64) + F.tid; if (gt < SEQ * 8) { const int i = gt & 7; const float inv = exp2f(-(float)i * 0.125f * 18.931568569324174f); float sn, cs; sincosf((float)(gt >> 3) * inv, &sn, &cs); F_ROPE[2 * gt] = cs; F_ROPE[2 * gt + 1] = sn; } }
    for (int m = gw; m < NTOK; m += NGW) {
        const GAS f32x4* xr = (const GAS f32x4*)((F.a->in[0]) + (size_t)m * DM) + F.lane; const GAS f32x4* gr = (const GAS f32x4*)(F.a->in[1]) + F.lane;
        f32x4 v[4]; float s = 0.f;
#pragma unroll
        for (int j = 0; j < 4; ++j) { v[j] = xr[64 * j]; s += (v[j].x * v[j].x + v[j].y * v[j].y) + (v[j].z * v[j].z + v[j].w * v[j].w); }
        const float rr = 1.0f / sqrtf(wave_sum(s) * (1.f / DM) + RMS_EPS);
        GAS unsigned long long* o8 = (GAS unsigned long long*)(F_XN + (size_t)m * DM) + F.lane;
#pragma unroll
        for (int j = 0; j < 4; ++j) { const f32x4 g = gr[64 * j]; o8[64 * j] = (unsigned long long)pk2(v[j].x * rr * g.x, v[j].y * rr * g.y) | ((unsigned long long)pk2(v[j].z * rr * g.z, v[j].w * rr * g.w) << 32); }
    }
}

__device__ __forceinline__ void rope16(float (&v)[16], const float* tab  ) {
#pragma unroll
    for (int i = 0; i < 8; ++i) { const float cs = tab[2 * i], sn = tab[2 * i + 1]; const float a = v[i], b2 = v[i + 8]; v[i] = a * cs - b2 * sn; v[i + 8] = b2 * cs + a * sn; }
}
__device__ __forceinline__ void p2_prep(Frame& F, int rep) {
    const size_t shift = rep ? (size_t)(WS_Y - WS_PROJ) / 2 : 0;
    const int gt = blockIdx.x * (NWAVES * 64) + F.tid, NGT = F.G * NWAVES * 64;
    for (int w = gt; w < NTOK * 8; w += NGT) {
        const int tk = w >> 3, h = w & 7; bf16* p = F_PROJ + (size_t)tk * PROJ_LD + h * 64; const float* g = (F.a->in[3]);
        v4u u[8]; float ss = 0.f;
#pragma unroll
        for (int c = 0; c < 8; ++c) { u[c] = *((const GAS v4u*)p + c); const float a0 = bflo(u[c].x), a1 = bfhi(u[c].x), a2 = bflo(u[c].y), a3 = bfhi(u[c].y), a4 = bflo(u[c].z), a5 = bfhi(u[c].z), a6 = bflo(u[c].w), a7 = bfhi(u[c].w);
            ss += (a0 * a0 + a1 * a1) + (a2 * a2 + a3 * a3) + (a4 * a4 + a5 * a5) + (a6 * a6 + a7 * a7); }
        const float rr = 1.0f / sqrtf(ss * (1.f / 64.f) + RMS_EPS);
        float r16[16];
#pragma unroll
        for (int c = 0; c < 2; ++c) { r16[8 * c] = bflo(u[c].x) * rr * g[8 * c]; r16[8 * c + 1] = bfhi(u[c].x) * rr * g[8 * c + 1]; r16[8 * c + 2] = bflo(u[c].y) * rr * g[8 * c + 2]; r16[8 * c + 3] = bfhi(u[c].y) * rr * g[8 * c + 3];
            r16[8 * c + 4] = bflo(u[c].z) * rr * g[8 * c + 4]; r16[8 * c + 5] = bfhi(u[c].z) * rr * g[8 * c + 5]; r16[8 * c + 6] = bflo(u[c].w) * rr * g[8 * c + 6]; r16[8 * c + 7] = bfhi(u[c].w) * rr * g[8 * c + 7]; }
        rope16(r16, F_ROPE + (size_t)(tk & (SEQ - 1)) * 16);
        const float sc = 0.125f;
#pragma unroll
        for (int c = 0; c < 8; ++c) { v4u o;
            if (c < 2) { o.x = pk2(r16[8 * c] * sc, r16[8 * c + 1] * sc); o.y = pk2(r16[8 * c + 2] * sc, r16[8 * c + 3] * sc); o.z = pk2(r16[8 * c + 4] * sc, r16[8 * c + 5] * sc); o.w = pk2(r16[8 * c + 6] * sc, r16[8 * c + 7] * sc); }
            else { const float q = rr * sc; o.x = pk2(bflo(u[c].x) * q * g[8 * c], bfhi(u[c].x) * q * g[8 * c + 1]); o.y = pk2(bflo(u[c].y) * q * g[8 * c + 2], bfhi(u[c].y) * q * g[8 * c + 3]);
                o.z = pk2(bflo(u[c].z) * q * g[8 * c + 4], bfhi(u[c].z) * q * g[8 * c + 5]); o.w = pk2(bflo(u[c].w) * q * g[8 * c + 6], bfhi(u[c].w) * q * g[8 * c + 7]); }
            *((GAS v4u*)(p + shift) + c) = o; }
    }
    {
        const int lane = F.lane, gw = blockIdx.x * NWAVES + F.wave, NGW = F.G * NWAVES;
        const float gk = (F.a->in[4])[lane];
        const size_t sk = rep ? (size_t)(WS_ACT - WS_KA) / 2 : 0, sw = rep ? (size_t)(WS_ACT - WS_WIQ) / 4 + 4 * MiB : 0;
#pragma unroll 1
        for (int tk0 = gw * 4; tk0 < NTOK; tk0 += NGW * 4) {
            float ka[4], va[4], ki[4], wv[4], cs[4], sn[4];
#pragma unroll
            for (int u = 0; u < 4; ++u) { const float* p = F_SMALLF + (size_t)(tk0 + u) * 256; ka[u] = p[lane]; va[u] = p[64 + lane]; ki[u] = p[128 + lane]; wv[u] = p[192 + (lane & 7)];
                const float* tab = F_ROPE + (size_t)((tk0 + u) & (SEQ - 1)) * 16 + 2 * (lane & 7); cs[u] = tab[0]; sn[u] = tab[1]; }
#pragma unroll
            for (int u = 0; u < 4; ++u) { const int tk = tk0 + u;
                const float rr = 1.0f / sqrtf(wave_sum(ka[u] * ka[u]) * (1.f / 64.f) + RMS_EPS);
                float x = ka[u] * rr * gk, y = ki[u];
                const float px = __shfl_xor(x, 8), py = __shfl_xor(y, 8);
                if (lane < 8) { x = x * cs[u] - px * sn[u]; y = y * cs[u] - py * sn[u]; } else if (lane < 16) { x = x * cs[u] + px * sn[u]; y = y * cs[u] + py * sn[u]; }
                (F_KA + sk)[(size_t)tk * 64 + lane] = (bf16)f2bf(x); (F_KI + sk)[(size_t)tk * 64 + lane] = (bf16)f2bf(y); (F_VA + sk)[(size_t)tk * 64 + lane] = (bf16)f2bf(va[u]);
                if (lane < 8) (F_WIQ + sw)[(size_t)tk * 8 + lane] = wv[u] * 0.044194173824159216f; }
        }
    }
}

typedef float f32x16 __attribute__((ext_vector_type(16)));
__device__ __forceinline__ void sb_item(Frame& F, int item) {
    const int bh = item >> 3, tb = item & 7, b = bh >> 3, h = bh & 7, t = tb * 512 + F.tid;
    const bf16* base = F_PROJ + (size_t)(b * SEQ) * PROJ_LD + h * 64;
    float o[64]; v4u qw[8];
    { const GAS v4u* qp = (const GAS v4u*)(base + (size_t)t * PROJ_LD + 1024);
#pragma unroll
      for (int c = 0; c < 8; ++c) qw[c] = qp[c]; }
#pragma unroll
    for (int d = 0; d < 64; ++d) o[d] = 0.f;
    float R = 0.f; int s = t - 1;
    for (;;) {
        const bool active = (s >= 0) && (R <= 104.0f);
        if (!__any(active)) break;
        if (active) {
            const GAS v4u* kp = (const GAS v4u*)(base + (size_t)s * PROJ_LD + 1536);
            const GAS v4u* vp = (const GAS v4u*)(base + (size_t)s * PROJ_LD + 2048);
            float z = 0.f;
#pragma unroll
            for (int c = 0; c < 8; ++c) { const v4u u = kp[c];
                const v4u qq = qw[c]; z += bflo(qq.x) * bflo(u.x) + bfhi(qq.x) * bfhi(u.x) + bflo(qq.y) * bflo(u.y) + bfhi(qq.y) * bfhi(u.y) + bflo(qq.z) * bflo(u.z) + bfhi(qq.z) * bfhi(u.z) + bflo(qq.w) * bflo(u.w) + bfhi(qq.w) * bfhi(u.w); }
            const float sp = fmaxf(z, 0.f) + log1pf(__expf(-fabsf(z)));
            R += sp;
            const float a = __expf(z - R);
#pragma unroll
            for (int c = 0; c < 8; ++c) { const v4u u = vp[c];
                o[8 * c] += a * bflo(u.x); o[8 * c + 1] += a * bfhi(u.x); o[8 * c + 2] += a * bflo(u.y); o[8 * c + 3] += a * bfhi(u.y); o[8 * c + 4] += a * bflo(u.z); o[8 * c + 5] += a * bfhi(u.z); o[8 * c + 6] += a * bflo(u.w); o[8 * c + 7] += a * bfhi(u.w); }
        }
        --s;
    }
    GAS v4u* op = (GAS v4u*)(F_OB + (size_t)(b * SEQ + t) * 512 + h * 64);
#pragma unroll
    for (int c = 0; c < 8; ++c) { v4u w; w.x = pk2(o[8 * c], o[8 * c + 1]); w.y = pk2(o[8 * c + 2], o[8 * c + 3]); w.z = pk2(o[8 * c + 4], o[8 * c + 5]); w.w = pk2(o[8 * c + 6], o[8 * c + 7]); op[c] = w; }
}

typedef float f32x2_t __attribute__((ext_vector_type(2))); typedef __bf16 bf16x2_t __attribute__((ext_vector_type(2)));
__device__ __forceinline__ float relu_i(float x) { const int i = __builtin_bit_cast(int, x); return __builtin_bit_cast(float, i > 0 ? i : 0); }
typedef short v4i16_t __attribute__((ext_vector_type(4)));
__device__ __forceinline__ unsigned cvtpk_s(float lo, float hi) { f32x2_t v = {lo, hi}; bf16x2_t b = __builtin_convertvector(v, bf16x2_t); return __builtin_bit_cast(unsigned, b); }
__device__ __forceinline__ v4i16_t vtr(LAS unsigned char* p) { return __builtin_amdgcn_ds_read_tr16_b64_v4i16((LAS v4i16_t*)p); }
__device__ __forceinline__ void sb_item_mfma(Frame& F, int item) {
    const int lane = F.lane, wave = F.wave, r32 = lane & 31, hb = lane >> 5;
    const int bh = item >> 4, qb = item & 15, b = bh >> 3, h = bh & 7, qt = qb * 8 + wave, t0 = qt * 32;
    const bf16* base = F_PROJ + (size_t)(b * SEQ) * PROJ_LD + h * 64;
    LAS unsigned char* vl = F.lds + RING_OFF + wave * 16384;
    bf16x8 qf[4];
#pragma unroll
    for (int ks = 0; ks < 4; ++ks) qf[ks] = *(const GAS bf16x8*)(base + (size_t)(t0 + r32) * PROJ_LD + 1024 + 16 * ks + 8 * hb);
    f32x16 o0, o1;
#pragma unroll
    for (int i = 0; i < 16; ++i) { o0[i] = 0.f; o1[i] = 0.f; }
    float R = 0.f;
    const int tg = (lane >> 4) & 1, tq = (lane & 15) >> 2, tp = lane & 3;
    LAS unsigned char* trb = vl + (4 * hb + tq) * 192 + (16 * tg + 4 * tp) * 2;
    for (int kt = qt; kt >= 0; --kt) {
        const bf16* kp = base + (size_t)(32 * kt + r32) * PROJ_LD + 1536 + 8 * hb;
        bf16x8 kf[4];
#pragma unroll
        for (int ks = 0; ks < 4; ++ks) kf[ks] = *(const GAS bf16x8*)(kp + 16 * ks);
        v4u vv[4];
#pragma unroll
        for (int i = 0; i < 4; ++i) vv[i] = *(const GAS v4u*)(base + (size_t)(32 * kt + (lane >> 3) + 8 * i) * PROJ_LD + 2048 + 8 * (lane & 7));
        f32x16 c;
#pragma unroll
        for (int i = 0; i < 16; ++i) c[i] = 0.f;
#pragma unroll
        for (int ks = 0; ks < 4; ++ks) c = __builtin_amdgcn_mfma_f32_32x32x16_bf16(kf[ks], qf[ks], c, 0, 0, 0);
#pragma unroll
        for (int i = 0; i < 4; ++i) *(LAS v4u*)(vl + ((lane >> 3) + 8 * i) * 192 + 16 * (lane & 7)) = vv[i];
        const bool diag = (kt == qt);
        float sp[16];
#pragma unroll
        for (int i = 0; i < 16; ++i) { const int kk = (i & 3) + 8 * (i >> 2) + 4 * hb; const bool msk = diag && (kk >= r32); const float z = c[i];
            const float v = fmaxf(z, 0.f) + 0.6931471805599453f * __builtin_amdgcn_logf(1.0f + __builtin_amdgcn_exp2f(-fabsf(z) * 1.4426950408889634f));
            sp[i] = msk ? 0.f : v; }
        float gs[4], pg[4];
#pragma unroll
        for (int k4 = 0; k4 < 4; ++k4) { gs[k4] = (sp[4 * k4] + sp[4 * k4 + 1]) + (sp[4 * k4 + 2] + sp[4 * k4 + 3]); pg[k4] = __shfl_xor(gs[k4], 32); }
        float off[4];
        { const float so2 = gs[3], so1 = so2 + gs[2], so0 = so1 + gs[1]; const float po2 = pg[3], po1 = po2 + pg[2], po0 = po1 + pg[1];
          off[3] = 0.f; off[2] = so2 + po2; off[1] = so1 + po1; off[0] = so0 + po0;
          if (hb == 0) { off[3] += pg[3]; off[2] += pg[2]; off[1] += pg[1]; off[0] += pg[0]; }
          const float total = (so0 + gs[0]) + (po0 + pg[0]);
#pragma unroll
          for (int k4 = 0; k4 < 4; ++k4) { float run = R + off[k4];
#pragma unroll
              for (int w = 3; w >= 0; --w) { const int i = 4 * k4 + w; const int kk = w + 8 * k4 + 4 * hb; const bool msk = diag && (kk >= r32);
                  run += sp[i]; const float a = __builtin_amdgcn_exp2f((c[i] - run) * 1.4426950408889634f); c[i] = msk ? 0.f : a; } }
          R += total; }
        bf16x8 pa[2];
#pragma unroll
        for (int s2 = 0; s2 < 2; ++s2) { v4u w4; w4.x = cvtpk_s(c[8 * s2], c[8 * s2 + 1]); w4.y = cvtpk_s(c[8 * s2 + 2], c[8 * s2 + 3]); w4.z = cvtpk_s(c[8 * s2 + 4], c[8 * s2 + 5]); w4.w = cvtpk_s(c[8 * s2 + 6], c[8 * s2 + 7]); pa[s2] = __builtin_bit_cast(bf16x8, w4); }
        LDS_WAIT(); asm volatile("" ::: "memory");
#pragma unroll
        for (int s2 = 0; s2 < 2; ++s2) {
#pragma unroll
            for (int db = 0; db < 2; ++db) {
                const v4i16_t lo = vtr(trb + (16 * s2) * 192 + db * 64), hi2 = vtr(trb + (16 * s2 + 8) * 192 + db * 64);
                const bf16x8 vf = (bf16x8){lo[0], lo[1], lo[2], lo[3], hi2[0], hi2[1], hi2[2], hi2[3]};
                if (db == 0) o0 = __builtin_amdgcn_mfma_f32_32x32x16_bf16(pa[s2], vf, o0, 0, 0, 0); else o1 = __builtin_amdgcn_mfma_f32_32x32x16_bf16(pa[s2], vf, o1, 0, 0, 0);
            } }
        LDS_WAIT(); asm volatile("" ::: "memory");
        if (__all(R > 104.0f)) break;
    }
    bf16* op = F_OB + (size_t)(b * SEQ + t0) * 512 + h * 64 + r32;
#pragma unroll
    for (int i = 0; i < 16; ++i) { const int qr = (i & 3) + 8 * (i >> 2) + 4 * hb; op[(size_t)qr * 512] = (bf16)f2bf(o0[i]); op[(size_t)qr * 512 + 32] = (bf16)f2bf(o1[i]); }
}

template <int NV> __device__ __forceinline__ bool select256_hist(const LAS unsigned* rowu, LAS int* idxl, LAS unsigned* hist  , int L, int lane) {
    unsigned kv[NV]; unsigned kmin = 0xffffffffu, kmax = 0u;
    const LAS unsigned* rp = rowu + lane; asm volatile("" : "+v"(rp));
#pragma unroll
    for (int j = 0; j < NV; ++j) { unsigned u = 0u;
        if (64 * j < L) { u = rp[64 * j]; u = (u & 0x80000000u) ? ~u : (u | 0x80000000u); kmin = u < kmin ? u : kmin; kmax = u > kmax ? u : kmax; }
        kv[j] = u; }
#pragma unroll
    for (int o = 1; o < 64; o <<= 1) { const unsigned a = (unsigned)__shfl_xor((int)kmin, o), c2 = (unsigned)__shfl_xor((int)kmax, o); kmin = a < kmin ? a : kmin; kmax = c2 > kmax ? c2 : kmax; }
    const float fmin = __uint_as_float((kmin & 0x80000000u) ? (kmin ^ 0x80000000u) : ~kmin), fmax = __uint_as_float((kmax & 0x80000000u) ? (kmax ^ 0x80000000u) : ~kmax);
    const float rng = fmax - fmin, scale = rng > 0.f ? 1023.5f / rng : 0.f;
#define SEL_BIN(kk) ({ const unsigned k_ = (kk); const float f_ = __uint_as_float((k_ & 0x80000000u) ? (k_ ^ 0x80000000u) : ~k_); int b_ = (int)((f_ - fmin) * scale); b_ = b_ > 1023 ? 1023 : b_; b_; })
#pragma unroll
    for (int i = 0; i < 2; ++i) *(LAS v4u*)(hist + 4 * (lane + 64 * i)) = (v4u){0u, 0u, 0u, 0u};
    LDS_WAIT(); asm volatile("" ::: "memory");
#pragma unroll
    for (int j = 0; j < NV; ++j) if (64 * j < L) { const int b = SEL_BIN(kv[j]); __hip_atomic_fetch_add(hist + (b >> 1), 1u << (16 * (b & 1)), __ATOMIC_RELAXED, __HIP_MEMORY_SCOPE_WORKGROUP); }
    LDS_WAIT(); asm volatile("" ::: "memory");
    int hb[16];
    { const v4u w0 = *(const LAS v4u*)(hist + 8 * lane), w1 = *(const LAS v4u*)(hist + 8 * lane + 4);
      hb[0] = w0.x & 0xffff; hb[1] = w0.x >> 16; hb[2] = w0.y & 0xffff; hb[3] = w0.y >> 16; hb[4] = w0.z & 0xffff; hb[5] = w0.z >> 16; hb[6] = w0.w & 0xffff; hb[7] = w0.w >> 16;
      hb[8] = w1.x & 0xffff; hb[9] = w1.x >> 16; hb[10] = w1.y & 0xffff; hb[11] = w1.y >> 16; hb[12] = w1.z & 0xffff; hb[13] = w1.z >> 16; hb[14] = w1.w & 0xffff; hb[15] = w1.w >> 16; }
    int S = 0;
#pragma unroll
    for (int i = 0; i < 16; ++i) S += hb[i];
    int incl = S;
#pragma unroll
    for (int o = 1; o < 64; o <<= 1) { const int v = __shfl_down(incl, o); if (lane + o < 64) incl += v; }
    const int T = incl - S;
    int bstar = -1, cA = 0, nb = 0;
    { int run = T; bool found = false;
#pragma unroll
      for (int i = 15; i >= 0; --i) { const bool here = !found && (T < 256) && (T + S >= 256) && (run + hb[i] >= 256); if (here) { bstar = 16 * lane + i; cA = run; nb = hb[i]; found = true; } run += hb[i]; } }
    { const unsigned long long mown = __ballot(bstar >= 0); const int src = (int)__ffsll((long long)mown) - 1; bstar = __shfl(bstar, src); cA = __shfl(cA, src); nb = __shfl(nb, src); }
    if (nb > 512) return false;
    const int need = 256 - cA;
    LDS_WAIT(); asm volatile("" ::: "memory");
    LAS int* cand = (LAS int*)hist;
    int base = 0, cbase = 0;
#pragma unroll
    for (int j = 0; j < NV; ++j) {
        const int b = (64 * j < L) ? SEL_BIN(kv[j]) : -1;
        const bool gt = b > bstar, eq = b == bstar;
        const unsigned long long mg = __ballot(gt), me = __ballot(eq);
        const int pg = base + (int)__builtin_amdgcn_mbcnt_hi((unsigned)(mg >> 32), __builtin_amdgcn_mbcnt_lo((unsigned)mg, 0u));
        const int pe = cbase + (int)__builtin_amdgcn_mbcnt_hi((unsigned)(me >> 32), __builtin_amdgcn_mbcnt_lo((unsigned)me, 0u));
        if (gt && pg < 256) idxl[pg] = 64 * j + lane;
        if (eq && pe < 512) cand[pe] = 64 * j + lane;
        base += __popcll(mg); cbase += __popcll(me);
    }
#undef SEL_BIN
    LDS_WAIT(); asm volatile("" ::: "memory");
    for (int i = lane; i < nb; i += 64) {
        const int ci = cand[i]; unsigned ki = rowu[ci]; ki = (ki & 0x80000000u) ? ~ki : (ki | 0x80000000u);
        int rank = 0;
        for (int j = 0; j < nb; ++j) { const int cj = cand[j]; unsigned kj = rowu[cj]; kj = (kj & 0x80000000u) ? ~kj : (kj | 0x80000000u); rank += (kj > ki || (kj == ki && cj < ci)) ? 1 : 0; }
        if (rank < need) idxl[cA + rank] = ci;
    }
    return true;
}
template <int NV> __device__ __forceinline__ void select256(const LAS unsigned* rowu, LAS int* idxl, int L, int lane) {
    unsigned kv[NV]; unsigned kmin = 0xffffffffu, kmax = 0u;
    const LAS unsigned* rp = rowu + lane; asm volatile("" : "+v"(rp));
#pragma unroll
    for (int j = 0; j < NV; ++j) { unsigned u = 0u;
        if (64 * j < L) { u = rp[64 * j]; u = (u & 0x80000000u) ? ~u : (u | 0x80000000u); kmin = u < kmin ? u : kmin; kmax = u > kmax ? u : kmax; }
        kv[j] = u; }
#pragma unroll
    for (int o = 1; o < 64; o <<= 1) { const unsigned a = (unsigned)__shfl_xor((int)kmin, o), c2 = (unsigned)__shfl_xor((int)kmax, o); kmin = a < kmin ? a : kmin; kmax = c2 > kmax ? c2 : kmax; }
    unsigned lo = kmin, hi = kmax + 1u; int chi = 0;
    while (hi - lo > 1u) {
        const unsigned mid = lo + ((hi - lo) >> 1);
        int c = 0;
#pragma unroll
        for (int j = 0; j < NV; j += 8) {
            unsigned long long mk[8];
#pragma unroll
            for (int q = 0; q < 8; ++q) mk[q] = __ballot(kv[j + q] >= mid);
            asm volatile("" : "+s"(mk[0]), "+s"(mk[1]), "+s"(mk[2]), "+s"(mk[3]), "+s"(mk[4]), "+s"(mk[5]), "+s"(mk[6]), "+s"(mk[7]));
#pragma unroll
            for (int q = 0; q < 8; ++q) c += __popcll(mk[q]);
        }
        if (c >= 256) { lo = mid; if (c == 256) { hi = mid; chi = 256; break; } } else { hi = mid; chi = c; }
    }
    const int need = 256 - chi; int base = 0, tdone = 0;
#pragma unroll
    for (int j = 0; j < NV; ++j) {
        const unsigned u = kv[j];
        const bool gt = u >= hi, eq = (u == lo) && !gt;
        const unsigned long long meq = __ballot(eq);
        const int eqrank = tdone + (int)__builtin_amdgcn_mbcnt_hi((unsigned)(meq >> 32), __builtin_amdgcn_mbcnt_lo((unsigned)meq, 0u));
        const bool sel = gt || (eq && eqrank < need);
        const unsigned long long msel = __ballot(sel);
        const int pos = base + (int)__builtin_amdgcn_mbcnt_hi((unsigned)(msel >> 32), __builtin_amdgcn_mbcnt_lo((unsigned)msel, 0u));
        if (sel && pos < 256) idxl[pos] = 64 * j + lane;
        base += __popcll(msel); tdone += __popcll(meq);
    }
}
#ifndef P3_MODE
#define P3_MODE 0
#endif
__device__ __forceinline__ void dsa_item(Frame& F, int b, int t0, int stop) {
    const int lane = F.lane, wave = F.wave;
    const int L = ((t0 >> 6) + 1) << 6;
    LAS float* sc = (LAS float*)(F.lds + RING_OFF);
    if (L > 256) {
        const int r = lane & 31, hb = lane >> 5;
        const int head = (r & 3) + 4 * ((r >> 3) & 1), qsub = ((r >> 2) & 1) + 2 * ((r >> 4) & 1);
        bf16x8 qa[2][4]; float wq[2][2][8];
#pragma unroll
        for (int j = 0; j < 2; ++j) {
            const bf16* qp = F_PROJ + (size_t)(b * SEQ + t0 + 4 * j + qsub) * PROJ_LD + 512 + head * 64 + 8 * hb;
#pragma unroll
            for (int ks = 0; ks < 4; ++ks) qa[j][ks] = *(const GAS bf16x8*)(qp + 16 * ks);
#pragma unroll
            for (int x2 = 0; x2 < 2; ++x2)
#pragma unroll
                for (int hh = 0; hh < 8; ++hh) wq[j][x2][hh] = F_WIQ[(size_t)(b * SEQ + t0 + 4 * j + hb + 2 * x2) * 8 + hh];
        }
        const int ntile = L >> 5;
        const bf16* kbase = F_KI + (size_t)(b * SEQ + r) * 64 + 8 * hb;
#define IDX_LOAD(dst, kt_) do { const bf16* kp_ = kbase + (size_t)(32 * (kt_)) * 64; _Pragma("unroll") for (int ks = 0; ks < 4; ++ks) dst[ks] = *(const GAS bf16x8*)(kp_ + 16 * ks); } while (0)
#define IDX_TILE(src, kt_) do { _Pragma("unroll") for (int j = 0; j < 2; ++j) { f32x16 c; _Pragma("unroll") for (int i = 0; i < 16; ++i) c[i] = 0.f; \
            _Pragma("unroll") for (int ks = 0; ks < 4; ++ks) c = __builtin_amdgcn_mfma_f32_32x32x16_bf16(qa[j][ks], src[ks], c, 0, 0, 0); \
            float s0 = 0.f, s1 = 0.f; _Pragma("unroll") for (int i = 0; i < 8; ++i) { s0 += wq[j][0][i] * fmaxf(c[i], 0.f); s1 += wq[j][1][i] * fmaxf(c[8 + i], 0.f); } \
            sc[(4 * j + hb) * 4096 + 32 * (kt_) + r] = s0; sc[(4 * j + hb + 2) * 4096 + 32 * (kt_) + r] = s1; } } while (0)
        for (int kt = wave; kt < ntile; kt += 32) {
            bf16x8 k4[4][4];
#pragma unroll
            for (int u = 0; u < 4; ++u) { const int ku = kt + 8 * u; IDX_LOAD(k4[u], ku < ntile ? ku : ntile - 1); }
#pragma unroll
            for (int u = 0; u < 4; ++u) { const int ku = kt + 8 * u; if (ku < ntile) IDX_TILE(k4[u], ku); }
        }
#undef IDX_LOAD
#undef IDX_TILE
    }
    __syncthreads();
    if (stop == 1) { __syncthreads(); return; }
    LAS float* row = sc + wave * 4096; LAS unsigned* rowu = (LAS unsigned*)row;
    LAS int* idxl = (LAS int*)(F.lds + IDX_OFF) + wave * 256;
    int nsel;
    if (L <= 256) { nsel = L; for (int i = lane; i < 256; i += 64) idxl[i] = (i < L) ? i : 0; }
    else {
        LAS unsigned* hist = (LAS unsigned*)(F.lds + HIST_OFF) + wave * 512;
        bool ok;
        if (L <= 1024) ok = select256_hist<16>(rowu, idxl, hist, L, lane); else if (L <= 2048) ok = select256_hist<32>(rowu, idxl, hist, L, lane); else if (L <= 3072) ok = select256_hist<48>(rowu, idxl, hist, L, lane); else ok = select256_hist<64>(rowu, idxl, hist, L, lane);
        if (!ok) select256<64>(rowu, idxl, L, lane);
        nsel = 256;
    }
    LDS_WAIT(); asm volatile("" ::: "memory");
    if (stop == 2) { __syncthreads(); return; }
    const int t = t0 + wave;
    {
        const int c16 = lane & 15, q4 = lane >> 4, tq = c16 >> 2, tp = c16 & 3;
        bf16x8 qf[2];
        { const bf16* qp = F_PROJ + (size_t)(b * SEQ + t) * PROJ_LD + (c16 & 7) * 64 + 8 * q4;
          qf[0] = *(const GAS bf16x8*)qp; qf[1] = *(const GAS bf16x8*)(qp + 32);
          if (c16 >= 8) { qf[0] = (bf16x8){0, 0, 0, 0, 0, 0, 0, 0}; qf[1] = qf[0]; } }
        f32x4 lg[16];
        const bf16* kbase = F_KA + (size_t)(b * SEQ) * 64 + 8 * q4;
#pragma unroll
        for (int g = 0; g < 16; ++g) {
            const int p = 16 * g + c16; const int key = (p < nsel) ? idxl[p] : 0;
            const bf16* kp = kbase + (size_t)key * 64;
            const bf16x8 k0 = *(const GAS bf16x8*)kp, k1 = *(const GAS bf16x8*)(kp + 32);
            f32x4 c = {0.f, 0.f, 0.f, 0.f};
            c = __builtin_amdgcn_mfma_f32_16x16x32_bf16(k0, qf[0], c, 0, 0, 0);
            c = __builtin_amdgcn_mfma_f32_16x16x32_bf16(k1, qf[1], c, 0, 0, 0);
#pragma unroll
            for (int r = 0; r < 4; ++r) if (16 * g + 4 * q4 + r >= nsel) c[r] = -INFINITY;
            lg[g] = c;
        }
        v4u vA[8], vB[8];
#pragma unroll
        for (int i = 0; i < 8; ++i) { const int p_ = (lane >> 3) + 8 * i; const int key_ = (p_ < nsel) ? idxl[p_] : 0; vA[i] = *(const GAS v4u*)(F_VA + (size_t)(b * SEQ + key_) * 64 + 8 * (lane & 7)); }
        float m = -INFINITY;
#pragma unroll
        for (int g = 0; g < 16; ++g) m = fmaxf(m, fmaxf(fmaxf(lg[g][0], lg[g][1]), fmaxf(lg[g][2], lg[g][3])));
        m = fmaxf(m, __shfl_xor(m, 16)); m = fmaxf(m, __shfl_xor(m, 32));
        float ssum = 0.f;
#pragma unroll
        for (int g = 0; g < 16; ++g)
#pragma unroll
            for (int r = 0; r < 4; ++r) { const float e = __builtin_amdgcn_exp2f((lg[g][r] - m) * 1.4426950408889634f); lg[g][r] = e; ssum += e; }
        ssum += __shfl_xor(ssum, 16); ssum += __shfl_xor(ssum, 32);
        const float inv = 1.0f / ssum;
        LAS unsigned char* vl = (LAS unsigned char*)row;
        f32x4 o[4];
#pragma unroll
        for (int db = 0; db < 4; ++db) o[db] = (f32x4){0.f, 0.f, 0.f, 0.f};
#define V_LOAD(dst, ch_) do { _Pragma("unroll") for (int i = 0; i < 8; ++i) { const int p_ = 64 * (ch_) + (lane >> 3) + 8 * i; const int key_ = (p_ < nsel) ? idxl[p_] : 0; \
            dst[i] = *(const GAS v4u*)(F_VA + (size_t)(b * SEQ + key_) * 64 + 8 * (lane & 7)); } } while (0)
#define V_STEP(cur, nxt, ch_, HAS_NEXT) do { \
            _Pragma("unroll") for (int i = 0; i < 8; ++i) *(LAS v4u*)(vl + ((lane >> 3) + 8 * i) * 160 + 16 * (lane & 7)) = cur[i]; \
            LDS_WAIT(); asm volatile("" ::: "memory"); \
            if (HAS_NEXT) V_LOAD(nxt, (ch_) + 1); \
            _Pragma("unroll") for (int ss = 0; ss < 2; ++ss) { const int s2 = 2 * (ch_) + ss; \
                v4u w4; w4.x = cvtpk_s(lg[2 * s2][0] * inv, lg[2 * s2][1] * inv); w4.y = cvtpk_s(lg[2 * s2][2] * inv, lg[2 * s2][3] * inv); \
                w4.z = cvtpk_s(lg[2 * s2 + 1][0] * inv, lg[2 * s2 + 1][1] * inv); w4.w = cvtpk_s(lg[2 * s2 + 1][2] * inv, lg[2 * s2 + 1][3] * inv); \
                const bf16x8 pa = __builtin_bit_cast(bf16x8, w4); \
                _Pragma("unroll") for (int db = 0; db < 4; ++db) { \
                    const v4i16_t lo = vtr(vl + (32 * ss + 4 * q4 + tq) * 160 + (16 * db + 4 * tp) * 2), hi2 = vtr(vl + (32 * ss + 16 + 4 * q4 + tq) * 160 + (16 * db + 4 * tp) * 2); \
                    const bf16x8 vf = (bf16x8){lo[0], lo[1], lo[2], lo[3], hi2[0], hi2[1], hi2[2], hi2[3]}; \
                    o[db] = __builtin_amdgcn_mfma_f32_16x16x32_bf16(pa, vf, o[db], 0, 0, 0); } } \
            LDS_WAIT(); asm volatile("" ::: "memory"); } while (0)
        V_STEP(vA, vB, 0, true); V_STEP(vB, vA, 1, true); V_STEP(vA, vB, 2, true); V_STEP(vB, vA, 3, false);
#undef V_LOAD
#undef V_STEP
        if (q4 < 2) { bf16* op = F_OA + (size_t)(b * SEQ + t) * 512 + (4 * q4) * 64 + c16;
#pragma unroll
            for (int db = 0; db < 4; ++db)
#pragma unroll
                for (int r = 0; r < 4; ++r) op[r * 64 + 16 * db] = (bf16)f2bf(o[db][r]); }
    }
    __syncthreads();
}
__device__ __forceinline__ int shx_i(int v, int o, int lane) { return __builtin_amdgcn_ds_bpermute((lane ^ o) << 2, v); }
__device__ __forceinline__ float shx_f(float v, int o, int lane) { return __int_as_float(__builtin_amdgcn_ds_bpermute((lane ^ o) << 2, __float_as_int(v))); }
__device__ __forceinline__ int shl_i(int v, int src) { return __builtin_amdgcn_ds_bpermute(src << 2, v); }
__device__ __forceinline__ unsigned h2key(unsigned u) { return (u & 0x8000u) ? (~u & 0xffffu) : (u | 0x8000u); }
__device__ __forceinline__ float key2val(unsigned k) { const unsigned u = (k & 0x8000u) ? (k ^ 0x8000u) : (~k & 0xffffu); return (float)__builtin_bit_cast(_Float16, (unsigned short)u); }
template <int NV> __device__ __forceinline__ void select256_b16(const LAS unsigned short* rowh, LAS unsigned short* idxl, int L, int lane) {
    unsigned kv[NV]; unsigned kmin = 0xffffffffu, kmax = 0u;
    const LAS unsigned short* rp = rowh + lane; asm volatile("" : "+v"(rp));
#pragma unroll
    for (int j = 0; j < NV; ++j) { unsigned u = 0u; if (j < NV - 16 || 64 * j < L) { u = h2key(rp[64 * j]); kmin = u < kmin ? u : kmin; kmax = u > kmax ? u : kmax; } kv[j] = u; }
#pragma unroll
    for (int o = 1; o < 64; o <<= 1) { const unsigned a = (unsigned)shx_i((int)kmin, o, lane), c2 = (unsigned)shx_i((int)kmax, o, lane); kmin = a < kmin ? a : kmin; kmax = c2 > kmax ? c2 : kmax; }
    unsigned lo = kmin, hi = kmax + 1u; int chi = 0;
    while (hi - lo > 1u) {
        const unsigned mid = lo + ((hi - lo) >> 1);
        int c = 0;
#pragma unroll
        for (int j = 0; j < NV; ++j) c += __popcll(__ballot(kv[j] >= mid));
        if (c >= 256) { lo = mid; if (c == 256) { hi = mid; chi = 256; break; } } else { hi = mid; chi = c; }
    }
    const int need = 256 - chi; int base = 0, tdone = 0;
#pragma unroll
    for (int j = 0; j < NV; ++j) {
        const unsigned u = kv[j];
        const bool gt = u >= hi, eq = (u == lo) && !gt;
        const unsigned long long meq = __ballot(eq);
        const int eqrank = tdone + (int)__builtin_amdgcn_mbcnt_hi((unsigned)(meq >> 32), __builtin_amdgcn_mbcnt_lo((unsigned)meq, 0u));
        const bool sel = gt || (eq && eqrank < need);
        const unsigned long long msel = __ballot(sel);
        const int pos = base + (int)__builtin_amdgcn_mbcnt_hi((unsigned)(msel >> 32), __builtin_amdgcn_mbcnt_lo((unsigned)msel, 0u));
        if (sel && pos < 256) idxl[pos] = (unsigned short)(64 * j + lane);
        base += __popcll(msel); tdone += __popcll(meq);
    }
}
template <int NV> __device__ __forceinline__ bool select256_h16(const LAS unsigned short* rowh, LAS unsigned short* idxl, LAS unsigned* hist  , int L, int lane) {
    float kv[NV]; float fmin = INFINITY, fmax = -INFINITY;
    const LAS _Float16* rp = (const LAS _Float16*)rowh + lane; asm volatile("" : "+v"(rp));
#pragma unroll
    for (int j = 0; j < NV; ++j) { float f = -INFINITY; if (j < NV - 16 || 64 * j < L) { f = (float)rp[64 * j]; fmin = fminf(fmin, f); fmax = fmaxf(fmax, f); } kv[j] = f; }
#pragma unroll
    for (int o = 1; o < 64; o <<= 1) { fmin = fminf(fmin, shx_f(fmin, o, lane)); fmax = fmaxf(fmax, shx_f(fmax, o, lane)); }
    const float rng = fmax - fmin, scale = rng > 0.f ? 511.5f / rng : 0.f;
#pragma unroll
    for (int i = 0; i < 2; ++i) *(LAS v4u*)(hist + 4 * (lane + 64 * i)) = (v4u){0u, 0u, 0u, 0u};
    LDS_WAIT(); asm volatile("" ::: "memory");
    int kb[NV];
#pragma unroll
    for (int j = 0; j < NV; ++j) { int bq = -1;
        if (j < NV - 16 || 64 * j < L) { bq = (int)((kv[j] - fmin) * scale); bq = bq > 511 ? 511 : bq; __hip_atomic_fetch_add(hist + bq, 1u, __ATOMIC_RELAXED, __HIP_MEMORY_SCOPE_WORKGROUP); }
        kb[j] = bq; }
    LDS_WAIT(); asm volatile("" ::: "memory");
    int hb[8];
    { const v4u w0 = *(const LAS v4u*)(hist + 8 * lane), w1 = *(const LAS v4u*)(hist + 8 * lane + 4);
      hb[0] = (int)w0.x; hb[1] = (int)w0.y; hb[2] = (int)w0.z; hb[3] = (int)w0.w; hb[4] = (int)w1.x; hb[5] = (int)w1.y; hb[6] = (int)w1.z; hb[7] = (int)w1.w; }
    int S = 0;
#pragma unroll
    for (int i = 0; i < 8; ++i) S += hb[i];
    int incl = S;
#pragma unroll
    for (int o = 1; o < 64; o <<= 1) { const int v = shl_i(incl, (lane + o) & 63); if (lane + o < 64) incl += v; }
    const int T = incl - S;
    int bstar = -1, cA = 0, nb = 0;
    { int run = T; bool found = false;
#pragma unroll
      for (int i = 7; i >= 0; --i) { const bool here = !found && (T < 256) && (T + S >= 256) && (run + hb[i] >= 256); if (here) { bstar = 8 * lane + i; cA = run; nb = hb[i]; found = true; } run += hb[i]; } }
    { const unsigned long long mown = __ballot(bstar >= 0); const int src = (int)__ffsll((long long)mown) - 1; bstar = shl_i(bstar, src); cA = shl_i(cA, src); nb = shl_i(nb, src); }
    if (nb > 512) return false;
    const int need = 256 - cA;
    LDS_WAIT(); asm volatile("" ::: "memory");
    LAS int* cand = (LAS int*)hist;
    int base = 0, cbase = 0;
#pragma unroll
    for (int j = 0; j < NV; ++j) {
        const bool gt = kb[j] > bstar, eq = kb[j] == bstar;
        const unsigned long long mg = __ballot(gt), me = __ballot(eq);
        const int pg = base + (int)__builtin_amdgcn_mbcnt_hi((unsigned)(mg >> 32), __builtin_amdgcn_mbcnt_lo((unsigned)mg, 0u));
        const int pe = cbase + (int)__builtin_amdgcn_mbcnt_hi((unsigned)(me >> 32), __builtin_amdgcn_mbcnt_lo((unsigned)me, 0u));
        if (gt && pg < 256) idxl[pg] = (unsigned short)(64 * j + lane);
        if (eq && pe < 512) cand[pe] = 64 * j + lane;
        base += __popcll(mg); cbase += __popcll(me);
    }
    LDS_WAIT(); asm volatile("" ::: "memory");
    for (int i = lane; i < nb; i += 64) {
        const int ci = cand[i]; const unsigned ki = h2key(rowh[ci]);
        int rank = 0;
        for (int j = 0; j < nb; ++j) { const int cj = cand[j]; const unsigned kj = h2key(rowh[cj]); rank += (kj > ki || (kj == ki && cj < ci)) ? 1 : 0; }
        if (rank < need) idxl[cA + rank] = (unsigned short)ci;
    }
    return true;
}
__device__ __forceinline__ void unpk8(const bf16x8& v, float (&x)[8]) { const v4u u = __builtin_bit_cast(v4u, v); x[0] = bflo(u.x); x[1] = bfhi(u.x); x[2] = bflo(u.y); x[3] = bfhi(u.y); x[4] = bflo(u.z); x[5] = bfhi(u.z); x[6] = bflo(u.w); x[7] = bfhi(u.w); }
__device__ __forceinline__ bf16x8 pk8(const float (&x)[8]) { v4u u; u.x = cvtpk_s(x[0], x[1]); u.y = cvtpk_s(x[2], x[3]); u.z = cvtpk_s(x[4], x[5]); u.w = cvtpk_s(x[6], x[7]); return __builtin_bit_cast(bf16x8, u); }
__device__ __forceinline__ void rope_frag(float (&x)[8], bool lowhalf, int pmask, int lane, const float* tab) {
#pragma unroll
    for (int i = 0; i < 8; ++i) { const float o = shx_f(x[i], pmask, lane); const float cs = tab[2 * i], sn = tab[2 * i + 1]; x[i] = lowhalf ? x[i] * cs - o * sn : x[i] * cs + o * sn; }
}
template <bool FULL> __device__ __forceinline__ void dsa_attend(Frame& F, int b, int t, int nsel_, const LAS unsigned short* idxl, LAS unsigned char* vl, int lane) {
    int nsel = FULL ? 256 : nsel_; if (!FULL) asm volatile("" : "+v"(nsel));
    const int c16 = lane & 15, q4 = lane >> 4, tq = c16 >> 2, tp = c16 & 3;
    bf16x8 qf[2];
    { const bf16* qp = F_PROJ + (size_t)(b * SEQ + t) * PROJ_LD + (c16 & 7) * 64 + 8 * q4;
      qf[0] = *(const GAS bf16x8*)qp; qf[1] = *(const GAS bf16x8*)(qp + 32);
      if (c16 >= 8) { qf[0] = (bf16x8){0, 0, 0, 0, 0, 0, 0, 0}; qf[1] = qf[0]; } }
    f32x4 lg[16];
    const bf16* kbase = F_KA + (size_t)(b * SEQ) * 64 + 8 * q4;
#pragma unroll
    for (int g = 0; g < 16; ++g) {
        const int p = 16 * g + c16; const int key = (FULL || p < nsel) ? (int)idxl[p] : 0;
        const bf16* kp = kbase + (size_t)key * 64;
        const bf16x8 k0 = *(const GAS bf16x8*)kp, k1 = *(const GAS bf16x8*)(kp + 32);
        f32x4 c = {0.f, 0.f, 0.f, 0.f};
        c = __builtin_amdgcn_mfma_f32_16x16x32_bf16(k0, qf[0], c, 0, 0, 0);
        c = __builtin_amdgcn_mfma_f32_16x16x32_bf16(k1, qf[1], c, 0, 0, 0);
        if (!FULL) {
#pragma unroll
            for (int r = 0; r < 4; ++r) if (16 * g + 4 * q4 + r >= nsel) c[r] = -INFINITY; }
        lg[g] = c;
    }
    v4u vA[8];
#define V_LOAD(dst, ch_) do { _Pragma("unroll") for (int i = 0; i < 8; ++i) { const int p_ = 64 * (ch_) + (lane >> 3) + 8 * i; const int key_ = (FULL || p_ < nsel) ? (int)idxl[p_] : 0; \
        dst[i] = *(const GAS v4u*)(F_VA + (size_t)(b * SEQ + key_) * 64 + 8 * (lane & 7)); } } while (0)
    V_LOAD(vA, 0);
    float m = -INFINITY;
#pragma unroll
    for (int g = 0; g < 16; ++g) m = fmaxf(m, fmaxf(fmaxf(lg[g][0], lg[g][1]), fmaxf(lg[g][2], lg[g][3])));
    m = fmaxf(m, shx_f(m, 16, lane)); m = fmaxf(m, shx_f(m, 32, lane));
    float ssum = 0.f;
#pragma unroll
    for (int g = 0; g < 16; ++g)
#pragma unroll
        for (int r = 0; r < 4; ++r) { const float e = __builtin_amdgcn_exp2f((lg[g][r] - m) * 1.4426950408889634f); lg[g][r] = e; ssum += e; }
    ssum += shx_f(ssum, 16, lane); ssum += shx_f(ssum, 32, lane);
    const float inv = 1.0f / ssum;
    f32x4 o[4];
#pragma unroll
    for (int db = 0; db < 4; ++db) o[db] = (f32x4){0.f, 0.f, 0.f, 0.f};
#define VSWZ(row_, chunk_) ((row_) * 128 + ((((chunk_)) ^ (2 * (((row_) >> 1) & 3))) * 16))
#define V_STEP(cur, nxt, ch_, HAS_NEXT) do { \
        _Pragma("unroll") for (int i = 0; i < 8; ++i) { const int row_ = (lane >> 3) + 8 * i; *(LAS v4u*)(vl + VSWZ(row_, lane & 7)) = cur[i]; } \
        LDS_WAIT(); asm volatile("" ::: "memory"); \
        if (HAS_NEXT) V_LOAD(nxt, (ch_) + 1); \
        _Pragma("unroll") for (int ss = 0; ss < 2; ++ss) { const int s2 = 2 * (ch_) + ss; \
            v4u w4; w4.x = cvtpk_s(lg[2 * s2][0] * inv, lg[2 * s2][1] * inv); w4.y = cvtpk_s(lg[2 * s2][2] * inv, lg[2 * s2][3] * inv); \
            w4.z = cvtpk_s(lg[2 * s2 + 1][0] * inv, lg[2 * s2 + 1][1] * inv); w4.w = cvtpk_s(lg[2 * s2 + 1][2] * inv, lg[2 * s2 + 1][3] * inv); \
            const bf16x8 pa = __builtin_bit_cast(bf16x8, w4); \
            _Pragma("unroll") for (int db = 0; db < 4; ++db) { const int r0_ = 32 * ss + 4 * q4 + tq, r1_ = r0_ + 16; \
                const v4i16_t lo = vtr(vl + VSWZ(r0_, 2 * db + (tp >> 1)) + 8 * (tp & 1)), hi2 = vtr(vl + VSWZ(r1_, 2 * db + (tp >> 1)) + 8 * (tp & 1)); \
                const bf16x8 vf = (bf16x8){lo[0], lo[1], lo[2], lo[3], hi2[0], hi2[1], hi2[2], hi2[3]}; \
                o[db] = __builtin_amdgcn_mfma_f32_16x16x32_bf16(pa, vf, o[db], 0, 0, 0); } } \
        LDS_WAIT(); asm volatile("" ::: "memory"); } while (0)
    V_STEP(vA, vA, 0, true); V_STEP(vA, vA, 1, true); V_STEP(vA, vA, 2, true); V_STEP(vA, vA, 3, false);
#undef V_LOAD
#undef V_STEP
#undef VSWZ
    if (q4 < 2) { bf16* op = F_OA + (size_t)(b * SEQ + t) * 512 + (4 * q4) * 64 + c16;
#pragma unroll
        for (int db = 0; db < 4; ++db)
#pragma unroll
            for (int r = 0; r < 4; ++r) op[r * 64 + 16 * db] = (bf16)f2bf(o[db][r]); }
}
__device__ __forceinline__ void idx_load(bf16x8 (&kb)[4], const bf16* kbase, int kt) {
    const bf16* kp = kbase + (size_t)(32 * kt) * 64;
#pragma unroll
    for (int ks = 0; ks < 4; ++ks) kb[ks] = *(const GAS bf16x8*)(kp + 16 * ks);
}
__device__ __forceinline__ f32x16 idx_chain(const bf16x8 (&q)[4], const bf16x8 (&kb)[4]) {
    f32x16 c;
#pragma unroll
    for (int i = 0; i < 16; ++i) c[i] = 0.f;
#pragma unroll
    for (int ks = 0; ks < 4; ++ks) c = __builtin_amdgcn_mfma_f32_32x32x16_bf16(q[ks], kb[ks], c, 0, 0, 0);
    return c;
}
struct IdxW { f32x4 a0, a1, b0, b1; };
__device__ __forceinline__ f32x16 idx_chain_valu(const bf16x8 (&q)[4], const bf16x8 (&kb)[4], const f32x16& co, const IdxW& w, LAS _Float16* sch, int jo, int kto, int r, int hb) {
    const f32x4 wa0 = w.a0, wa1 = w.a1, wb0 = w.b0, wb1 = w.b1;
    f32x16 c;
#pragma unroll
    for (int i = 0; i < 16; ++i) c[i] = 0.f;
#pragma unroll
    for (int ks = 0; ks < 4; ++ks) c = __builtin_amdgcn_mfma_f32_32x32x16_bf16(q[ks], kb[ks], c, 0, 0, 0);
#define RL(i_) relu_i(co[i_])
    f32x2_t a0 = (f32x2_t){wa0.x, wa0.y} * (f32x2_t){RL(0), RL(1)};
    a0 = __builtin_elementwise_fma((f32x2_t){wa0.z, wa0.w}, (f32x2_t){RL(2), RL(3)}, a0); a0 = __builtin_elementwise_fma((f32x2_t){wa1.x, wa1.y}, (f32x2_t){RL(4), RL(5)}, a0); a0 = __builtin_elementwise_fma((f32x2_t){wa1.z, wa1.w}, (f32x2_t){RL(6), RL(7)}, a0);
    f32x2_t a1 = (f32x2_t){wb0.x, wb0.y} * (f32x2_t){RL(8), RL(9)};
    a1 = __builtin_elementwise_fma((f32x2_t){wb0.z, wb0.w}, (f32x2_t){RL(10), RL(11)}, a1); a1 = __builtin_elementwise_fma((f32x2_t){wb1.x, wb1.y}, (f32x2_t){RL(12), RL(13)}, a1); a1 = __builtin_elementwise_fma((f32x2_t){wb1.z, wb1.w}, (f32x2_t){RL(14), RL(15)}, a1);
#undef RL
    const float s0 = a0.x + a0.y, s1 = a1.x + a1.y;
    sch[(4 * jo + hb) * 4096 + 32 * kto + r] = (_Float16)s0; sch[(4 * jo + hb + 2) * 4096 + 32 * kto + r] = (_Float16)s1;
#pragma unroll
    for (int g = 0; g < 4; ++g) { __builtin_amdgcn_sched_group_barrier(0x008, 1, 0); __builtin_amdgcn_sched_group_barrier(0x002, 8, 0); }
    return c;
}
__device__ __forceinline__ void dsa_item16(Frame& F, int b, int t0, int stop) {
    unsigned ones_ = ~0u; asm volatile("" : "+v"(ones_));
    const int lane = (int)__builtin_amdgcn_mbcnt_hi(ones_, __builtin_amdgcn_mbcnt_lo(ones_, 0u)), wave = F.wave;
    const int L = ((t0 >> 6) + 1) << 6;
    LAS _Float16* sch = (LAS _Float16*)(F.lds + RING_OFF);
    if (L > 256) {
        const int r = lane & 31, hb = lane >> 5;
        const int head = (r & 3) + 4 * ((r >> 3) & 1), qsub = ((r >> 2) & 1) + 2 * ((r >> 4) & 1);
        bf16x8 qa[4][4];
        LAS float* wl = (LAS float*)(F.lds + HIST_OFF) + wave * 512;
        { const f32x2_t w2 = *(const GAS f32x2_t*)(F_WIQ + (size_t)(b * SEQ + t0) * 8 + 2 * lane); *(LAS f32x2_t*)(wl + 2 * lane) = w2; }
#pragma unroll
        for (int j = 0; j < 4; ++j) {
            const bf16* qp = F_PROJ + (size_t)(b * SEQ + t0 + 4 * j + qsub) * PROJ_LD + 512 + head * 64 + 8 * hb;
#pragma unroll
            for (int ks = 0; ks < 4; ++ks) qa[j][ks] = *(const GAS bf16x8*)(qp + 16 * ks);
            { float xr[8]; unpk8(qa[j][0], xr); rope_frag(xr, hb == 0, 32, lane, F_ROPE + (size_t)(t0 + 4 * j + qsub) * 16); qa[j][0] = pk8(xr); }
        }
        LDS_WAIT(); asm volatile("" ::: "memory");
        const int ntile = L >> 5;
        const bf16* kbase = F_KI + (size_t)(b * SEQ + r) * 64 + 8 * hb;
        const int nmy = (ntile - wave + 7) >> 3;
#define IDX_CL(i_) (wave + 8 * ((i_) < nmy ? (i_) : nmy - 1))
#define IDX_STAGE(cn_, jn_, kbn_, co_, jo_, kto_) do { cn_ = idx_chain_valu(qa[jn_], kbn_, co_, W[jo_], sch, jo_, kto_, r, hb); } while (0)
        if (nmy > 0) {
            bf16x8 kbA[4], kbB[4];
            idx_load(kbA, kbase, wave);
            IdxW W[4];
#pragma unroll
            for (int j = 0; j < 4; ++j) { W[j].a0 = *(const LAS f32x4*)(wl + (4 * j + hb) * 8); W[j].a1 = *(const LAS f32x4*)(wl + (4 * j + hb) * 8 + 4); W[j].b0 = *(const LAS f32x4*)(wl + (4 * j + hb + 2) * 8); W[j].b1 = *(const LAS f32x4*)(wl + (4 * j + hb + 2) * 8 + 4); }
            f32x16 c0 = idx_chain(qa[0], kbA), c1;
            int i = 0;
#pragma unroll 1
            for (;;) {
                const int ktA = wave + 8 * i, ktB = ktA + 8;
                idx_load(kbB, kbase, IDX_CL(i + 1));
                IDX_STAGE(c1, 1, kbA, c0, 0, ktA); IDX_STAGE(c0, 2, kbA, c1, 1, ktA); IDX_STAGE(c1, 3, kbA, c0, 2, ktA); IDX_STAGE(c0, 0, kbB, c1, 3, ktA);
                if (i + 1 >= nmy) break;
                idx_load(kbA, kbase, IDX_CL(i + 2));
                IDX_STAGE(c1, 1, kbB, c0, 0, ktB); IDX_STAGE(c0, 2, kbB, c1, 1, ktB); IDX_STAGE(c1, 3, kbB, c0, 2, ktB); IDX_STAGE(c0, 0, kbA, c1, 3, ktB);
                i += 2;
                if (i >= nmy) break;
            }
        }
#undef IDX_CL
#undef IDX_STAGE
    }
    __syncthreads();
    if (stop == 1) { __syncthreads(); return; }
    LAS unsigned short* idx0 = (LAS unsigned short*)(F.lds + IDX_OFF) + wave * 512;
    LAS unsigned char* vl = (LAS unsigned char*)sch + wave * 8192;
    int nsel = 256;
    const bool early = wave < 4;
#pragma unroll 1
    for (int step = 0; step < 4; ++step) {
        const bool do_sel = early ? ((step & 1) == 0) : (step < 2);
        const int qq = early ? (step >> 1) : (step & 1);
        if (do_sel) {
            int Lq = L; asm volatile("" : "+s"(Lq));
            const LAS unsigned short* rowh = (const LAS unsigned short*)sch + (wave + 8 * qq) * 4096;
            LAS unsigned short* idxl = idx0 + 256 * qq;
            if (Lq <= 256) { nsel = Lq; for (int i = lane; i < 256; i += 64) idxl[i] = (unsigned short)((i < Lq) ? i : 0); }
            else {
                LAS unsigned* hist = (LAS unsigned*)(F.lds + HIST_OFF) + wave * 512;
                bool ok;
                if (Lq <= 1024) ok = select256_h16<16>(rowh, idxl, hist, Lq, lane); else if (Lq <= 2048) ok = select256_h16<32>(rowh, idxl, hist, Lq, lane); else if (Lq <= 3072) ok = select256_h16<48>(rowh, idxl, hist, Lq, lane); else ok = select256_h16<64>(rowh, idxl, hist, Lq, lane);
                if (!ok) select256_b16<64>(rowh, idxl, Lq, lane);
            }
            LDS_WAIT(); asm volatile("" ::: "memory");
        } else if (stop != 2) {
            if (nsel == 256) dsa_attend<true>(F, b, t0 + wave + 8 * qq, 256, idx0 + 256 * qq, vl, lane); else dsa_attend<false>(F, b, t0 + wave + 8 * qq, nsel, idx0 + 256 * qq, vl, lane);
        }
    }
    __syncthreads();
}
__device__ __forceinline__ void p3_attention(Frame& F, int rep) {
    const int stop = (rep == 1 && P3_MODE >= 2) ? P3_MODE - 1 : 0;
    if (!(rep == 1 && P3_MODE >= 2)) { for (int item = blockIdx.x; item < 512; item += F.G) sb_item_mfma(F, item);
    __syncthreads(); }
    if (rep == 1 && P3_MODE == 1) return;
    {
    gu32* qh = F.ctl + CW_QUEUE + 64 * rep;
    if (F.wave == 0 && fresh_lane() == 0) F.MISC[MI_Q] = __hip_atomic_fetch_add(qh, 1u, RLX_AGENT);
    __syncthreads();
    for (int par = 0;; par ^= 1) {
        const int it = (int)F.MISC[MI_Q + par];
        if (it >= 1024) break;
        if (F.wave == 0 && fresh_lane() == 0) F.MISC[MI_Q + (par ^ 1)] = __hip_atomic_fetch_add(qh, 1u, RLX_AGENT);
        const int chunk = 63 - (it >> 4), within = it & 15, b = within >> 2, g4 = within & 3;
        dsa_item16(F, b, chunk * 64 + g4 * 16, stop);
    }
    }
}

__device__ __forceinline__ void p6_router(Frame& F, int rep) {
    const size_t sh4 = rep ? (size_t)(WS_ACT - WS_TOKE) / 4 : 0, sh2 = rep ? (size_t)(WS_Y - WS_XN) / 2 : 0;
    const int lane = F.lane, w4 = F.wave & 3, hbk = F.wave >> 2, lt = F.tid & 255, r32 = lane & 31, hb = lane >> 5;
    LAS float* hs = (LAS float*)(F.lds + hbk * 70912);
    LAS float* red = hs;
    LAS float* lgt = hs + 32 * 516;
    LAS float* rrs = lgt + 32 * 33;
    LAS int* ent = (LAS int*)(rrs + 32);
    const float* H = (F.a->out);
    for (int tile0 = blockIdx.x * 2; tile0 < NTOK / 32; tile0 += 2 * F.G) {
        const int tok0 = (tile0 + hbk) * 32;
        f32x16 acc;
#pragma unroll
        for (int i = 0; i < 16; ++i) acc[i] = 0.f;
        f32x4 st[16];
#pragma unroll
        for (int i = 0; i < 16; ++i) { const int idx = lt + 256 * i; st[i] = *(const GAS f32x4*)(H + (size_t)(tok0 + (idx >> 7)) * DM + 4 * (idx & 127)); }
        if (lt < 32) { float ssq = 0.f;
#pragma unroll
            for (int i = 0; i < 16; ++i) ssq += F_SSQP[(size_t)(tok0 + lt) * 16 + i];
            rrs[lt] = 1.0f / sqrtf(ssq * (1.f / DM) + RMS_EPS); }
#pragma unroll 1
        for (int half = 0; half < 2; ++half) {
#pragma unroll
            for (int i = 0; i < 16; ++i) { const int idx = lt + 256 * i; *(LAS f32x4*)(hs + (idx >> 7) * 516 + 4 * (idx & 127)) = st[i]; }
            __syncthreads();
            {
                const f32x4 g4 = *((const GAS f32x4*)(F.a->in[8]) + 128 * half + (lt & 127));
#pragma unroll
                for (int i = 0; i < 16; ++i) { const int idx = lt + 256 * i, tl = idx >> 7; const float rr = rrs[tl]; const f32x4 v = st[i];
                    int pk = __builtin_amdgcn_cvt_pk_fp8_f32(v.x * rr * g4.x, v.y * rr * g4.y, 0, false); pk = __builtin_amdgcn_cvt_pk_fp8_f32(v.z * rr * g4.z, v.w * rr * g4.w, pk, true);
                    *((GAS int*)((unsigned char*)F_XN + sh2 + (size_t)(tok0 + tl) * DM + 512 * half) + (idx & 127)) = pk; }
            }
            if (half == 0) {
#pragma unroll
                for (int i = 0; i < 16; ++i) { const int idx = lt + 256 * i; st[i] = *(const GAS f32x4*)(H + (size_t)(tok0 + (idx >> 7)) * DM + 512 + 4 * (idx & 127)); } }
            {
                const int kl = w4 * 128 + 64 * hb;
                const float* wp = F_WRG + (size_t)(512 * half + kl) * 32 + r32;
                const LAS float* ap = hs + r32 * 516 + kl;
#pragma unroll
                for (int c = 0; c < 4; ++c) {
                    f32x4 a4[4]; float b1[16];
#pragma unroll
                    for (int j = 0; j < 4; ++j) a4[j] = *(const LAS f32x4*)(ap + 16 * c + 4 * j);
#pragma unroll
                    for (int j = 0; j < 16; ++j) b1[j] = wp[(size_t)(16 * c + j) * 32];
#pragma unroll
                    for (int j = 0; j < 16; ++j) acc = __builtin_amdgcn_mfma_f32_32x32x2f32(a4[j >> 2][j & 3], b1[j], acc, 0, 0, 0);
                }
            }
            __syncthreads();
        }
#pragma unroll
        for (int i = 0; i < 16; ++i) red[(w4 * 32 + (i & 3) + 8 * (i >> 2) + 4 * hb) * 33 + r32] = acc[i];
        __syncthreads();
        float sums[4];
#pragma unroll
        for (int q = 0; q < 4; ++q) { const int idx = lt + 256 * q, tk = idx >> 5, e = idx & 31; float sum = 0.f;
#pragma unroll
            for (int w2 = 0; w2 < 4; ++w2) sum += red[(w2 * 32 + tk) * 33 + e];
            sums[q] = sum; }
#pragma unroll
        for (int q = 0; q < 4; ++q) { const int idx = lt + 256 * q; lgt[(idx >> 5) * 33 + (idx & 31)] = sums[q]; }
        __syncthreads();
#pragma unroll
        for (int pass = 0; pass < 4; ++pass) {
            const int tl = 8 * w4 + 2 * pass + hb;
            float v = lgt[tl * 33 + r32] * rrs[tl] + (F.a->in[10])[r32];
            float tv[4]; int te[4];
#pragma unroll
            for (int k = 0; k < 4; ++k) { float bv = v; int be = r32;
#pragma unroll
                for (int o = 1; o < 32; o <<= 1) { const float ov = __shfl_xor(bv, o); const int oe = __shfl_xor(be, o); if (ov > bv || (ov == bv && oe < be)) { bv = ov; be = oe; } }
                tv[k] = bv; te[k] = be; if (r32 == be) v = -INFINITY; }
            float gk[4], gs = 0.f;
#pragma unroll
            for (int k = 0; k < 4; ++k) { gk[k] = __expf(tv[k] - tv[0]); gs += gk[k]; }
            const float ginv = 1.0f / gs;
            if (r32 < 4) { const int m = (tok0 + tl) * 4 + r32; const int ee = r32 == 0 ? te[0] : (r32 == 1 ? te[1] : (r32 == 2 ? te[2] : te[3])); const float gg = r32 == 0 ? gk[0] : (r32 == 1 ? gk[1] : (r32 == 2 ? gk[2] : gk[3]));
                (F_TOKE + sh4)[m] = ee; (F_TOKG + sh4)[m] = gg * ginv; ent[tl * 4 + r32] = ee; }
        }
        __syncthreads();
        if (w4 == 0) {
            const int e0 = ent[lane], e1 = ent[lane + 64];
            int mycnt = 0, r0 = 0, r1 = 0;
            for (int j = 0; j < 32; ++j) { const unsigned long long m0 = __ballot(e0 == j), m1 = __ballot(e1 == j); const int c0 = __popcll(m0);
                if (e0 == j) r0 = (int)__builtin_amdgcn_mbcnt_hi((unsigned)(m0 >> 32), __builtin_amdgcn_mbcnt_lo((unsigned)m0, 0u));
                if (e1 == j) r1 = c0 + (int)__builtin_amdgcn_mbcnt_hi((unsigned)(m1 >> 32), __builtin_amdgcn_mbcnt_lo((unsigned)m1, 0u));
                if (lane == j) mycnt = c0 + __popcll(m1); }
            int mybase = 0; if (lane < 32 && mycnt > 0) mybase = (int)__hip_atomic_fetch_add(F.ctl + CW_CNT + 64 * rep + lane, (unsigned)mycnt, RLX_AGENT);
            const int p0 = __shfl(mybase, e0) + r0, p1 = __shfl(mybase, e1) + r1;
            const int m0i = tok0 * 4 + lane, m1i = tok0 * 4 + lane + 64;
            (F_TOKP + sh4)[m0i] = p0; (F_LIST + sh4)[(size_t)e0 * NTOK + p0] = m0i;
            (F_TOKP + sh4)[m1i] = p1; (F_LIST + sh4)[(size_t)e1 * NTOK + p1] = m1i;
        }
        __syncthreads();
    }
}
__device__ __forceinline__ void compute_ts(Frame& F) {
    if (F.tid < 32) F.MISC[MI_CNT + F.tid] = __hip_atomic_load(F.ctl + CW_CNT + F.tid, RLX_AGENT);
    __syncthreads();
    if (F.tid == 0) { unsigned run = 0; for (int e = 0; e < 32; ++e) { F.MISC[MI_TS + e] = run; run += (F.MISC[MI_CNT + e] + 255u) >> 8; } F.MISC[MI_TS + 32] = run; }
    __syncthreads();
}
__device__ __forceinline__ void p7_gather(Frame& F) {
    const int gw = blockIdx.x * NWAVES + F.wave, NGW = F.G * NWAVES; const int T = (int)F.MISC[MI_TS + 32];
    for (int r = gw; r < T * 256; r += NGW) {
        const int rt = r >> 8; int e = 0; while (e < 31 && (int)F.MISC[MI_TS + e + 1] <= rt) ++e;
        const int local = r - 256 * (int)F.MISC[MI_TS + e]; const bool valid = local < (int)F.MISC[MI_CNT + e];
        v4u a = {0u, 0u, 0u, 0u};
        if (valid) { const int tok = F_LIST[(size_t)e * NTOK + local] >> 2; a = ((const GAS v4u*)((unsigned char*)F_XN + (size_t)tok * DM))[F.lane]; }
        ((GAS v4u*)((unsigned char*)F_XG + (size_t)r * DM))[F.lane] = a;
    }
}
__device__ __forceinline__ void p10_combine(Frame& F, int rep) {
    const int gw = blockIdx.x * NWAVES + F.wave, NGW = F.G * NWAVES;
    for (int tok = gw; tok < NTOK; tok += NGW) {
        float g[4]; const unsigned char* yr[4];
#pragma unroll
        for (int k = 0; k < 4; ++k) { const int m = tok * 4 + k; const int e = F_TOKE[m]; g[k] = F_TOKG[m]; yr[k] = (const unsigned char*)F_Y + (size_t)(256 * (int)F.MISC[MI_TS + e] + F_TOKP[m]) * DM; }
        GAS f32x4* hr = (GAS f32x4*)((F.a->out) + (size_t)tok * DM) + F.lane;
#pragma unroll
        for (int j = 0; j < 4; ++j) { f32x4 v = hr[64 * j];
#pragma unroll
            for (int k = 0; k < 4; ++k) { const int y = *((const GAS int*)yr[k] + 64 * j + F.lane); const f32x2_t lo = __builtin_amdgcn_cvt_pk_f32_fp8(y, false), hi = __builtin_amdgcn_cvt_pk_f32_fp8(y, true);
                v.x += g[k] * lo.x; v.y += g[k] * lo.y; v.z += g[k] * hi.x; v.w += g[k] * hi.y; }
            if (rep) ((GAS f32x4*)(WSP(float, WS_XG) + (size_t)tok * DM) + F.lane)[64 * j] = v; else hr[64 * j] = v; }
    }
}

__global__ void __launch_bounds__(NWAVES * 64, 2) mk_fwd(Args args) {
    extern __shared__ __attribute__((aligned(16))) unsigned char lds[];
    Frame F;
    F.lds = (LAS unsigned char*)lds;
    F.MISC = (volatile LAS unsigned*)(F.lds + MISC_OFF);
    F.tid = threadIdx.x; F.lane = F.tid & 63; F.wave = __builtin_amdgcn_readfirstlane(F.tid >> 6);
    F.G = gridDim.x;
    F.a = &args;
    F.ctl = (gu32*)(args.ws + WS_CTL);
    for (int u = F.tid; u < (LDS_BYTES - LDSCTL_OFF) / 4; u += NWAVES * 64) ((LAS unsigned*)(F.lds + LDSCTL_OFF))[u] = 0u;
    __syncthreads();
    XcdBarrier bar; bar.bar = (unsigned*)(F.ctl + CW_BAR); bar.x = 0; bar.st = nullptr;
    if (N_LAUNCHES == 1) bar = xcd_barrier_post((unsigned*)(F.ctl + CW_BAR), F.MISC + MI_BAR);
    const int lo = args.ph_lo, hi = args.ph_hi;
#ifdef PHASE_ONLY
#define IN(k) ((k) == PHASE_ONLY && lo <= (k) && (k) < hi)
#else
#define IN(k) (lo <= (k) && (k) < hi)
#endif
#ifndef REPEAT_PHASE
#define REPEAT_PHASE -1
#endif
#define REFRESH() do { F.lane = fresh_lane(); F.tid = F.lane + 64 * F.wave; } while (0)
#ifndef P1_MODE
#define P1_MODE 0
#endif
#ifndef DOUBLE_BAR
#define DOUBLE_BAR 0
#endif
#define SEAM(k) do { if (IN(k) && IN((k) + 1)) { xcd_barrier(bar, F.wave == 0 && fresh_lane() == 0); if (DOUBLE_BAR) xcd_barrier(bar, F.wave == 0 && fresh_lane() == 0); } } while (0)
    const bool split = (F.G & 31) == 0 && F.G >= 64;
    const int NCV = split ? F.G / 4 : 0;
    if (IN(0)) { REFRESH(); p0_prologue(F, split ? MOE_P1_ITEMS : 0); __syncthreads(); } SEAM(0);
    if (IN(1)) { REFRESH(); pg8::Gemm g{F_XN, F_WI, NTOK, NPROJ_PAD, DM}; pg8::StaticOrder S; S.init(NTOK, NPROJ_PAD, F.G, (int)blockIdx.x);
        if (split) { const int slot = (int)blockIdx.x >> 3, xcd = (int)blockIdx.x & 7;
            if ((slot & 3) == 3) { const int cc = (slot >> 2) * 8 + xcd; if (!(P1_MODE == 1 && args.rep)) p1_convert(F, cc, NCV, MOE_P1_ITEMS); __syncthreads(); S.G = NCV; S.c = S.nwg - NCV + cc; }
            else { S.G = F.G - NCV; S.c = (slot - (slot >> 2)) * 8 + xcd; S.lim = S.nwg - NCV; } }
        if (P1_MODE == 2 && args.rep) S.lim = 0;
        pg8::EpiProj E{F_PROJ, F_SMALLF}; pg8::gemm_phase<pg8::EpiProj, pg8::StaticOrder, true, true>(F.lds + RING_OFF, g, S, E, F.wave); } SEAM(1);
    if (IN(2)) { REFRESH(); p2_prep(F, args.rep); } SEAM(2);
    if (IN(3)) { REFRESH(); p3_attention(F, args.rep); } SEAM(3);
    if (IN(4)) { REFRESH(); pg8::StaticOrder S; S.init(NTOK, DM, F.G, (int)blockIdx.x);
        { pg8::Gemm g{F_OA, F_WPA, NTOK, DM, 512}; pg8::EpiGate<true> E{F_PROJ, 2560, F_MERGED}; pg8::gemm_phase<pg8::EpiGate<true>, pg8::StaticOrder, true, true>(F.lds + RING_OFF, g, S, E, F.wave); }
        { pg8::Gemm g{F_OB, F_WPB, NTOK, DM, 512}; pg8::EpiGate<false> E{F_PROJ, 3584, F_MERGED}; pg8::gemm_phase<pg8::EpiGate<false>, pg8::StaticOrder, true, true>(F.lds + RING_OFF, g, S, E, F.wave); } } SEAM(4);
    if (IN(5)) { REFRESH(); pg8::Gemm g{F_MERGED, F_WO, NTOK, DM, DM}; pg8::StaticOrder S; S.init(NTOK, DM, F.G, (int)blockIdx.x);
        pg8::EpiOut E{(F.a->in[0]), (F.a->out), F_SSQP}; pg8::gemm_phase<pg8::EpiOut, pg8::StaticOrder, true, true>(F.lds + RING_OFF, g, S, E, F.wave); } SEAM(5);
    if (IN(6)) { REFRESH(); p6_router(F, args.rep); } SEAM(6);
    REFRESH();
    if (hi > 7) compute_ts(F);
    if (IN(8)) { REFRESH(); pg8::Gemm g{F_XN, F_WGU, 0, 2048, DM / 2}; pg8::MoeOrder S; S.init((const volatile LAS int*)(F.MISC + MI_TS), (const volatile LAS int*)(F.MISC + MI_CNT), F_LIST, 8, F.G, (int)blockIdx.x);
        pg8::EpiAct E{(F.a->in[12]), (unsigned char*)F_ACT}; pg8::gemm_phase<pg8::EpiAct, pg8::MoeOrder, true, true, true, true>(F.lds + RING_OFF, g, S, E, F.wave);
        __syncthreads(); REFRESH(); p8_convert_wd(F, args.rep); } SEAM(8);
    if (IN(9)) { REFRESH(); pg8::Gemm g{F_ACT, F_WD, 0, DM, DM / 2}; pg8::MoeOrder S; S.init((const volatile LAS int*)(F.MISC + MI_TS), (const volatile LAS int*)(F.MISC + MI_CNT), F_LIST, 4, F.G, (int)blockIdx.x);
        pg8::EpiDown E{(F.a->in[14]), (unsigned char*)F_Y}; pg8::gemm_phase<pg8::EpiDown, pg8::MoeOrder, true, true, true>(F.lds + RING_OFF, g, S, E, F.wave); } SEAM(9);
    if (IN(10)) { REFRESH(); p10_combine(F, args.rep);
        if (N_LAUNCHES == 1) {
            const unsigned bad = __hip_atomic_load((gu32*)((unsigned*)(F.ctl + CW_BAR) + XB_TMO), RLX_AGENT);
            if (bad) { const float q = __builtin_nanf(""); for (size_t i = (size_t)blockIdx.x * 512 + F.tid; i < (size_t)NTOK * DM; i += (size_t)F.G * 512) (F.a->out)[i] = q; } } }
#undef IN
#undef SEAM
}

extern "C" void kernel_launch(void* const* d_in, const int* in_sizes, int n_in, void* d_out, int out_size, void* d_ws, size_t ws_size, hipStream_t stream) {
    static int grid = 0;
    if (grid == 0) {
        if (n_in != 15 || in_sizes[0] != NTOK * DM || out_size != NTOK * DM || ws_size < WS_END) { fprintf(stderr, "kernel_launch: unexpected shapes / workspace (n_in %d, in0 %d, out %d, ws %zu); nothing launched\n", n_in, n_in > 0 ? in_sizes[0] : -1, out_size, ws_size); grid = -1; return; }
        int dev = 0, cus = 0, per_cu = 0;
        if (hipGetDevice(&dev) != hipSuccess || hipDeviceGetAttribute(&cus, hipDeviceAttributeMultiprocessorCount, dev) != hipSuccess) { fprintf(stderr, "kernel_launch: device query failed\n"); grid = -1; return; }
        if (hipFuncSetAttribute((const void*)mk_fwd, hipFuncAttributeMaxDynamicSharedMemorySize, LDS_BYTES) != hipSuccess) { fprintf(stderr, "kernel_launch: hipFuncSetAttribute failed\n"); grid = -1; return; }
        if (hipOccupancyMaxActiveBlocksPerMultiprocessor(&per_cu, (const void*)mk_fwd, NWAVES * 64, LDS_BYTES) != hipSuccess || per_cu < 1) { fprintf(stderr, "kernel_launch: occupancy query says %d workgroups per CU; nothing launched\n", per_cu); (void)hipGetLastError(); grid = -1; return; }
        grid = cus;
    }
    if (grid < 0) return;
    if (hipMemsetAsync((char*)d_ws + WS_CTL, 0, CTL_ZERO_BYTES, stream) != hipSuccess) { fprintf(stderr, "kernel_launch: hipMemsetAsync failed\n"); return; }
    Args a{};
    for (int i = 0; i < 15; ++i) a.in[i] = (const float*)d_in[i];
    a.out = (float*)d_out; a.ws = (unsigned char*)d_ws;
    for (int li = 0; li < N_LAUNCHES; ++li) {
        a.ph_lo = (N_LAUNCHES == 1) ? 0 : li; a.ph_hi = (N_LAUNCHES == 1) ? N_PHASES : li + 1;
        for (int rep = 0; rep < ((N_LAUNCHES != 1 && li == REPEAT_PHASE) ? 2 : 1); ++rep) {
            a.rep = rep;
            hipLaunchKernelGGL(mk_fwd, dim3(grid), dim3(NWAVES * 64), LDS_BYTES, stream, a);
            const hipError_t le = hipPeekAtLastError();
            if (le != hipSuccess) { fprintf(stderr, "kernel_launch: launch %d failed: %s\n", li, hipGetErrorName(le)); return; }
        }
    }
}
```
